# Optimizing an MI355X kernel written in HIP

```python
import jax
import jax.numpy as jnp
from jax import lax
import numpy as np


D_MODEL = 2048
BATCH = 4
SEQ = 2048
DEPTH = 4

CTX_LEN = 256
GRID_W = 64
RMS_EPS = 1e-6
N_BRANCH = 3
BRANCH_DIM = 1024

POOL_WINDOWS = (2, 4, 8, 16)
N_POOL_GROUPS = len(POOL_WINDOWS)
POOL_DIM = BRANCH_DIM
POOL_GROUP = POOL_DIM // N_POOL_GROUPS

MLA_HEADS = 8
MLA_Q_LORA = 512
MLA_KV_LORA = 512
MLA_NOPE = 128
MLA_ROPE = 64
MLA_V = BRANCH_DIM // MLA_HEADS
MLA_QK = MLA_NOPE + MLA_ROPE
ROPE_BASE = 10000.0
Q_BLOCK = 128

GLA_HEADS = 4
GLA_DK = 256
GLA_DV = BRANCH_DIM // GLA_HEADS
GLA_GATE_RANK = 16
GLA_GATE_TAU = 16.0
GLA_CHUNK = 64

FFN_HIDDEN = -(-8 * D_MODEL // (3 * 256)) * 256

KV_SPLITS = (MLA_KV_LORA, MLA_ROPE, GLA_HEADS * GLA_DK, GLA_HEADS * GLA_DV, GLA_GATE_RANK, GLA_GATE_RANK)
Q_SPLITS = (MLA_Q_LORA, GLA_HEADS * GLA_DK, GLA_HEADS * GLA_DV, POOL_DIM, N_BRANCH * D_MODEL)
KV_COLS = sum(KV_SPLITS)
IN_COLS = KV_COLS + sum(Q_SPLITS)

kernel_name = "hybrid_pool_mla_gla_dit_block"


def rms_norm(x, g):
    xf = x.astype(jnp.float32)
    y = xf * lax.rsqrt(jnp.mean(xf * xf, axis=-1, keepdims=True) + RMS_EPS)
    return (y * g.astype(jnp.float32)).astype(x.dtype)


def modulate(h, shift, scale):
    return h * (1.0 + scale) + shift


def split_cols(z, sizes):
    return jnp.split(z, [int(i) for i in np.cumsum(sizes)[:-1]], axis=-1)


def to_heads(t, n_heads):
    b, s, _ = t.shape
    return t.reshape(b, s, n_heads, -1).transpose(0, 2, 1, 3)


def from_heads(t):
    b, h, s, d = t.shape
    return t.transpose(0, 2, 1, 3).reshape(b, s, h * d)


def flip_seq(t):
    return jnp.flip(t, axis=2)


def axial_rope_tables(n_rows, dtype):
    half = MLA_ROPE // 2
    inv_freq = 1.0 / (ROPE_BASE ** (jnp.arange(0, half, 2, dtype=jnp.float32) / half))
    row = jnp.repeat(jnp.arange(n_rows), GRID_W).astype(jnp.float32)
    col = jnp.tile(jnp.arange(GRID_W), n_rows).astype(jnp.float32)
    ang_r = row[:, None] * inv_freq[None, :]
    ang_c = col[:, None] * inv_freq[None, :]
    return tuple(t.astype(dtype)[None, :, None, :] for t in
                 (jnp.cos(ang_r), jnp.sin(ang_r), jnp.cos(ang_c), jnp.sin(ang_c)))


def rotate(x, cos, sin):
    x1, x2 = jnp.split(x, 2, axis=-1)
    return jnp.concatenate([x1 * cos - x2 * sin, x2 * cos + x1 * sin], axis=-1)


def apply_axial_rope(t, rope):
    cos_r, sin_r, cos_c, sin_c = rope
    t_nope, t_row, t_col = split_cols(t, (MLA_NOPE, MLA_ROPE // 2, MLA_ROPE // 2))
    return jnp.concatenate([t_nope, rotate(t_row, cos_r, sin_r), rotate(t_col, cos_c, sin_c)], axis=-1)


def mla_queries(cq, q_norm_g, w_q_up, q_head_g, rope):
    b, s, _ = cq.shape
    q = (rms_norm(cq, q_norm_g) @ w_q_up).reshape(b, s, MLA_HEADS, MLA_QK)
    q = rms_norm(q, q_head_g)
    if rope is not None:
        q = apply_axial_rope(q, rope)
    return q.transpose(0, 2, 1, 3)


def mla_keys_values(ckv, krope, kv_norm_g, w_kv_up, k_head_g, rope):
    b, s, _ = ckv.shape
    kv = (rms_norm(ckv, kv_norm_g) @ w_kv_up).reshape(b, s, MLA_HEADS, MLA_NOPE + MLA_V)
    k_nope, v = kv[..., :MLA_NOPE], kv[..., MLA_NOPE:]
    k_rope = jnp.broadcast_to(krope[:, :, None, :], (b, s, MLA_HEADS, MLA_ROPE))
    k = rms_norm(jnp.concatenate([k_nope, k_rope], axis=-1), k_head_g)
    if rope is not None:
        k = apply_axial_rope(k, rope)
    return k.transpose(0, 2, 1, 3), v.transpose(0, 2, 1, 3)


def block_attention(q, k, v):
    b, h, s, dh = q.shape
    nb = s // Q_BLOCK
    scale = dh ** -0.5
    qb = q.reshape(b, h, nb, Q_BLOCK, dh).transpose(2, 0, 1, 3, 4)

    def attend(qi):
        sc = jnp.einsum('bhqd,bhkd->bhqk', qi, k).astype(jnp.float32) * scale
        p = jax.nn.softmax(sc, axis=-1).astype(v.dtype)
        return jnp.einsum('bhqk,bhkd->bhqd', p, v)

    o = lax.map(attend, qb)
    return o.transpose(1, 2, 0, 3, 4).reshape(b, h, s, v.shape[-1])


def gla_chunk_scan(q, k, v, log_a, s0):
    b, h, s, dk = q.shape
    dv = v.shape[-1]
    n = s // GLA_CHUNK

    def chunks(t):
        return t.reshape(b, h, n, GLA_CHUNK, t.shape[-1]).transpose(2, 0, 1, 3, 4)

    causal = jnp.tril(jnp.ones((GLA_CHUNK, GLA_CHUNK), dtype=bool))[:, :, None]

    def step(state, inp):
        qc, kc, vc, ac = inp
        cum = jnp.cumsum(ac, axis=2)
        inter = jnp.einsum('bhtd,bhde->bhte', qc * jnp.exp(cum), state)
        rel = jnp.where(causal, cum[:, :, :, None, :] - cum[:, :, None, :, :], -jnp.inf)
        scores = jnp.einsum('bhtd,bhsd,bhtsd->bhts', qc, kc, jnp.exp(rel))
        intra = jnp.einsum('bhts,bhse->bhte', scores, vc)
        last = cum[:, :, -1:, :]
        new_state = state * jnp.exp(last).swapaxes(-1, -2) + jnp.einsum(
            'bhsd,bhse->bhde', kc * jnp.exp(last - cum), vc)
        return new_state.astype(state.dtype), inter + intra

    s_fin, o = lax.scan(step, s0, (chunks(q), chunks(k), chunks(v), chunks(log_a)))
    return s_fin, o.transpose(1, 2, 0, 3, 4).reshape(b, h, s, dv)


def gla_final_state(k, v, log_a):
    cum = jnp.cumsum(log_a, axis=2)
    return jnp.einsum('bhsd,bhse->bhde', k * jnp.exp(cum[:, :, -1:, :] - cum), v)


def gla_output(o, gg, out_norm_g):
    b, h, s, dv = o.shape
    on = rms_norm(o.transpose(0, 2, 1, 3), out_norm_g)
    return on.reshape(b, s, h * dv) * jax.nn.silu(gg)


def multiscale_pool(u):
    b, s, _ = u.shape
    uf = u.astype(jnp.float32).reshape(b, s, N_POOL_GROUPS, POOL_GROUP)
    cs = jnp.concatenate([jnp.zeros_like(uf[:, :1]), jnp.cumsum(uf, axis=1)], axis=1)
    t = jnp.arange(s)
    outs = []
    for gi, w in enumerate(POOL_WINDOWS):
        lo = jnp.clip(t - w // 2, 0, s - 1)
        hi = jnp.clip(t + w // 2 - 1, 0, s - 1)
        win_sum = cs[:, hi + 1, gi] - cs[:, lo, gi]
        cnt = (hi - lo + 1).astype(jnp.float32)[None, :, None]
        outs.append(win_sum / cnt - uf[:, :, gi])
    return jnp.stack(outs, axis=2).astype(u.dtype)


def pool_branch(u, pool_w, pool_scale):
    y = jnp.einsum('btgc,gcd->btgd', multiscale_pool(u), pool_w)
    return y.reshape(u.shape) * pool_scale


def merge_branches(pool_o, mla_o, gla_o, gate_logits, w_branch, w_out):
    b, s, _ = pool_o.shape
    br = jnp.stack([pool_o, mla_o, gla_o], axis=2)
    proj = jnp.einsum('btnc,ncd->btnd', br, w_branch)
    gates = jax.nn.sigmoid(gate_logits.reshape(b, s, N_BRANCH, D_MODEL))
    return jnp.sum(gates * proj, axis=2) @ w_out


def swiglu(h, w1, w3, w2):
    return (jax.nn.silu(h @ w1) * (h @ w3)) @ w2


def hybrid_mixer(h_lat, h_ctx, need_ctx_out, rope, w_in, mla_q_norm_g, mla_w_q_up, mla_kv_norm_g,
                 mla_w_kv_up, mla_q_head_g, mla_k_head_g, gla_w_gate_up, gla_b_gate, gla_out_norm_g,
                 pool_w, pool_scale, w_branch, w_out):
    z_lat = h_lat @ w_in
    z_ctx = h_ctx @ (w_in if need_ctx_out else w_in[:, :KV_COLS])
    ckv_l, kr_l, gk_l, gv_l, lrf_l, lrb_l = split_cols(z_lat[..., :KV_COLS], KV_SPLITS)
    cq_l, gq_l, gg_l, pin_l, gate_l = split_cols(z_lat[..., KV_COLS:], Q_SPLITS)
    ckv_c, kr_c, gk_c, gv_c, lrf_c, lrb_c = split_cols(z_ctx[..., :KV_COLS], KV_SPLITS)

    k_l, v_l = mla_keys_values(ckv_l, kr_l, mla_kv_norm_g, mla_w_kv_up, mla_k_head_g, rope)
    k_c, v_c = mla_keys_values(ckv_c, kr_c, mla_kv_norm_g, mla_w_kv_up, mla_k_head_g, None)
    q_l = mla_queries(cq_l, mla_q_norm_g, mla_w_q_up, mla_q_head_g, rope)
    mla_l = from_heads(block_attention(q_l, jnp.concatenate([k_c, k_l], axis=2),
                                       jnp.concatenate([v_c, v_l], axis=2)))

    def log_decay(lr, d):
        return to_heads(jax.nn.log_sigmoid(lr @ gla_w_gate_up[d] + gla_b_gate[d]) / GLA_GATE_TAU, GLA_HEADS)

    q_scale = GLA_DK ** -0.5
    kg_c, vg_c = to_heads(gk_c, GLA_HEADS), to_heads(gv_c, GLA_HEADS)
    laf_c, lab_c = log_decay(lrf_c, 0), log_decay(lrb_c, 1)
    if need_ctx_out:
        cq_c, gq_c, gg_c, pin_c, gate_c = split_cols(z_ctx[..., KV_COLS:], Q_SPLITS)
        qg_c = to_heads(gq_c, GLA_HEADS) * q_scale
        zero = jnp.zeros(kg_c.shape[:2] + (GLA_DK, GLA_DV), vg_c.dtype)
        s_cf, o_cf = gla_chunk_scan(qg_c, kg_c, vg_c, laf_c, zero)
        s_cb, o_cb = gla_chunk_scan(flip_seq(qg_c), flip_seq(kg_c), flip_seq(vg_c), flip_seq(lab_c), zero)
        gla_c = gla_output(o_cf + flip_seq(o_cb), gg_c, gla_out_norm_g)
    else:
        s_cf = gla_final_state(kg_c, vg_c, laf_c)
        s_cb = gla_final_state(flip_seq(kg_c), flip_seq(vg_c), flip_seq(lab_c))
    qg_l = to_heads(gq_l, GLA_HEADS) * q_scale
    kg_l, vg_l = to_heads(gk_l, GLA_HEADS), to_heads(gv_l, GLA_HEADS)
    _, o_lf = gla_chunk_scan(qg_l, kg_l, vg_l, log_decay(lrf_l, 0), s_cf)
    _, o_lb = gla_chunk_scan(flip_seq(qg_l), flip_seq(kg_l), flip_seq(vg_l),
                             flip_seq(log_decay(lrb_l, 1)), s_cb)
    gla_l = gla_output(o_lf + flip_seq(o_lb), gg_l, gla_out_norm_g)

    pool_l = pool_branch(pin_l, pool_w, pool_scale)
    y_lat = merge_branches(pool_l, mla_l, gla_l, gate_l, w_branch, w_out)
    if not need_ctx_out:
        return y_lat, None

    q_c = mla_queries(cq_c, mla_q_norm_g, mla_w_q_up, mla_q_head_g, None)
    mla_c = from_heads(block_attention(q_c, k_c, v_c))
    pool_c = pool_branch(pin_c, pool_w, pool_scale)
    y_ctx = merge_branches(pool_c, mla_c, gla_c, gate_c, w_branch, w_out)
    return y_lat, y_ctx


def setup_inputs(seed: int = 0) -> dict:
    key = jax.random.key(seed)
    ks = jax.random.split(key, 32)
    f32 = jnp.float32
    D, L = D_MODEL, DEPTH

    def nrm(k, shape, fan_in, gain=1.0):
        return gain * fan_in ** -0.5 * jax.random.normal(k, shape, f32)

    def ones_noise(k, shape):
        return 1.0 + 0.02 * jax.random.normal(k, shape, f32)

    return {
        "x": jax.random.normal(ks[0], (BATCH, SEQ, D), f32),
        "c": jax.random.normal(ks[1], (BATCH, D), f32),
        "ctx": jax.random.normal(ks[2], (BATCH, CTX_LEN, D), f32),
        "c_ctx": jax.random.normal(ks[3], (D,), f32),
        "w_mod": nrm(ks[4], (L, D, 6 * D), D, 0.5),
        "b_mod": 0.01 * jax.random.normal(ks[5], (L, 6 * D), f32),
        "norm1_g": ones_noise(ks[6], (L, D)),
        "norm2_g": ones_noise(ks[7], (L, D)),
        "w_in": nrm(ks[8], (L, D, IN_COLS), D),
        "mla_q_norm_g": ones_noise(ks[9], (L, MLA_Q_LORA)),
        "mla_w_q_up": nrm(ks[10], (L, MLA_Q_LORA, MLA_HEADS * MLA_QK), MLA_Q_LORA),
        "mla_kv_norm_g": ones_noise(ks[11], (L, MLA_KV_LORA)),
        "mla_w_kv_up": nrm(ks[12], (L, MLA_KV_LORA, MLA_HEADS * (MLA_NOPE + MLA_V)), MLA_KV_LORA),
        "mla_q_head_g": ones_noise(ks[13], (L, MLA_QK)),
        "mla_k_head_g": ones_noise(ks[14], (L, MLA_QK)),
        "gla_w_gate_up": nrm(ks[15], (L, 2, GLA_GATE_RANK, GLA_HEADS * GLA_DK), GLA_GATE_RANK),
        "gla_b_gate": 0.1 * jax.random.normal(ks[16], (L, 2, GLA_HEADS * GLA_DK), f32),
        "gla_out_norm_g": ones_noise(ks[17], (L, GLA_DV)),
        "pool_w": nrm(ks[18], (L, N_POOL_GROUPS, POOL_GROUP, POOL_GROUP), POOL_GROUP),
        "pool_scale": 1.0 + 0.1 * jax.random.normal(ks[19], (L, POOL_DIM), f32),
        "w_branch": nrm(ks[20], (L, N_BRANCH, BRANCH_DIM, D), BRANCH_DIM),
        "w_out": nrm(ks[21], (L, D, D), D),
        "ffn_w1": nrm(ks[22], (L, D, FFN_HIDDEN), D),
        "ffn_w3": nrm(ks[23], (L, D, FFN_HIDDEN), D),
        "ffn_w2": nrm(ks[24], (L, FFN_HIDDEN, D), FFN_HIDDEN),
    }


def reference(x, c, ctx, c_ctx, w_mod, b_mod, norm1_g, norm2_g, w_in, mla_q_norm_g, mla_w_q_up,
              mla_kv_norm_g, mla_w_kv_up, mla_q_head_g, mla_k_head_g, gla_w_gate_up, gla_b_gate,
              gla_out_norm_g, pool_w, pool_scale, w_branch, w_out, ffn_w1, ffn_w3, ffn_w2):
    ROWS = x.shape[1] // GRID_W
    rope = axial_rope_tables(ROWS, x.dtype)
    silu_c = jax.nn.silu(c)
    silu_cc = jax.nn.silu(c_ctx)
    xc = ctx
    for l in range(DEPTH):
        last = l == DEPTH - 1
        mod = silu_c @ w_mod[l] + b_mod[l]
        sh1, sc1, g1, sh2, sc2, g2 = jnp.split(mod[:, None, :], 6, axis=-1)
        n_mod = 2 if last else 6
        mods_c = jnp.split(silu_cc @ w_mod[l][:, :n_mod * D_MODEL] + b_mod[l][:n_mod * D_MODEL], n_mod)

        h_lat = modulate(rms_norm(x, norm1_g[l]), sh1, sc1)
        h_ctx = modulate(rms_norm(xc, norm1_g[l]), mods_c[0], mods_c[1])
        y_lat, y_ctx = hybrid_mixer(h_lat, h_ctx, not last, rope, w_in[l], mla_q_norm_g[l], mla_w_q_up[l],
                                    mla_kv_norm_g[l], mla_w_kv_up[l], mla_q_head_g[l], mla_k_head_g[l],
                                    gla_w_gate_up[l], gla_b_gate[l], gla_out_norm_g[l], pool_w[l],
                                    pool_scale[l], w_branch[l], w_out[l])
        x = x + g1 * y_lat
        x = x + g2 * swiglu(modulate(rms_norm(x, norm2_g[l]), sh2, sc2), ffn_w1[l], ffn_w3[l], ffn_w2[l])
        if not last:
            xc = xc + mods_c[2] * y_ctx
            xc = xc + mods_c[5] * swiglu(modulate(rms_norm(xc, norm2_g[l]), mods_c[3], mods_c[4]),
                                         ffn_w1[l], ffn_w3[l], ffn_w2[l])
    return x
```

```cpp
#include <hip/hip_runtime.h>
#include <cstdio>
#include <cstdint>

#ifndef MK_SINGLE
#define MK_SINGLE 0
#endif

#define LAS __attribute__((address_space(3)))
#define GAS __attribute__((address_space(1)))
typedef unsigned short bf16_t;
typedef short bf16x8 __attribute__((ext_vector_type(8)));
typedef short s16x4 __attribute__((ext_vector_type(4)));
typedef float f32x4 __attribute__((ext_vector_type(4)));
typedef float f32x16 __attribute__((ext_vector_type(16)));
typedef unsigned u32x4 __attribute__((ext_vector_type(4)));
typedef unsigned u32x2 __attribute__((ext_vector_type(2)));

constexpr int DM = 2048, NB = 4, SEQ = 2048, NLAYER = 4, CTXL = 256;
constexpr int ML = NB * SEQ, MC = NB * CTXL, MT = ML + MC;
constexpr int NZB = 12288, NZ = 12544;
constexpr int ZC_CQ = 0, ZC_CKV = 512, ZC_GK = 1024, ZC_GV = 2048, ZC_GQ = 3072, ZC_GG = 4096, ZC_PIN = 5120, ZC_GATE = 6144;
constexpr int ZT_KR = 0, ZT_LR = 64;
constexpr int FF = 5632, NQKV = 3584;
constexpr int KPOS = CTXL + SEQ;
constexpr int NCH = KPOS / 64;
constexpr int NGU = NB * 4 * 2 * NCH;
constexpr float RMS_EPS = 1e-6f;
constexpr int IN_COLS = 12384;

constexpr size_t al256(size_t x) { return (x + 255) / 256 * 256; }
constexpr size_t WS_CTL = 0, CTL_BYTES = 1u << 20;
constexpr size_t W_IN = 0, W_QKV = W_IN + (size_t)NZ * DM * 2, W_P = W_QKV + (size_t)NQKV * 512 * 2, W_B = W_P + (size_t)1024 * 256 * 2,
                 W_O = W_B + (size_t)3 * 2048 * 1024 * 2, W_13 = W_O + (size_t)DM * DM * 2, W_2 = W_13 + (size_t)2 * FF * DM * 2, W_LAYER = W_2 + (size_t)DM * FF * 2;
constexpr size_t WS_W = WS_CTL + CTL_BYTES;
constexpr size_t WS_MODS = WS_W + NLAYER * W_LAYER;
constexpr size_t WS_X = al256(WS_MODS + (size_t)NLAYER * 5 * 12288 * 4);
constexpr size_t WS_H = WS_X + (size_t)MT * DM * 4;
constexpr size_t WS_Z = WS_H + (size_t)MT * DM * 2;
constexpr size_t WS_ZT = WS_Z + (size_t)MT * NZB * 2;
constexpr size_t WS_QKVR = WS_ZT + (size_t)MT * 256 * 4;
constexpr size_t WS_QF = WS_QKVR + (size_t)MT * NQKV * 2;
constexpr size_t WS_KF = WS_QF + (size_t)NB * 8 * KPOS * 192 * 2;
constexpr size_t WS_VF = WS_KF + (size_t)NB * 8 * KPOS * 192 * 2;
constexpr size_t WS_GQ = WS_VF + (size_t)NB * 8 * KPOS * 128 * 2;
constexpr size_t WS_GKT = WS_GQ + (size_t)NGU * 64 * 256 * 2;
constexpr size_t WS_GVT = WS_GKT + (size_t)NGU * 64 * 256 * 2;
constexpr size_t WS_GP = WS_GVT + (size_t)NGU * 64 * 256 * 2;
constexpr size_t WS_GD = WS_GP + (size_t)NGU * 64 * 64 * 2;
constexpr size_t WS_OF = WS_GD + (size_t)NGU * 256 * 4;
constexpr size_t WS_BR = WS_OF + (size_t)2 * MT * 1024 * 4;
constexpr size_t WS_POOLED = WS_BR + (size_t)3 * MT * 1024 * 2;
constexpr size_t WS_MERGED = WS_POOLED + (size_t)MT * 1024 * 2;
constexpr size_t WS_END = WS_MERGED + (size_t)MT * DM * 2;
constexpr size_t WS_MP = WS_GQ, WS_ACT = WS_Z;
static_assert((size_t)MT * DM * 4 <= (size_t)2 * NGU * 64 * 256 * 2, "MP overlay fits");
static_assert((size_t)MT * FF * 2 <= (size_t)MT * NZB * 2, "ACT overlay fits");

constexpr int RING_BYTES = 131072;
constexpr int MISC_OFF = RING_BYTES;
constexpr int LDS_BYTES = 147456;

__device__ __forceinline__ unsigned cvt_pk_bf16(float lo, float hi) { unsigned r; asm("v_cvt_pk_bf16_f32 %0, %1, %2" : "=v"(r) : "v"(lo), "v"(hi)); return r; }
__device__ __forceinline__ float bf2f(unsigned short b) { return __uint_as_float(((unsigned)b) << 16); }
__device__ __forceinline__ float bflo(unsigned w) { return __uint_as_float(w << 16); }
__device__ __forceinline__ float bfhi(unsigned w) { return __uint_as_float(w & 0xffff0000u); }
__device__ __forceinline__ bf16_t f2bf(float f) { return (bf16_t)(cvt_pk_bf16(f, 0.f) & 0xffffu); }
__device__ __forceinline__ float wave_sum(float v) {
#pragma unroll
    for (int o = 1; o < 64; o <<= 1) v += __shfl_xor(v, o);
    return v;
}
__device__ __forceinline__ float fast_sigmoid(float x) { return __builtin_amdgcn_rcpf(1.0f + __builtin_amdgcn_exp2f(-1.4426950408889634f * x)); }
__device__ __forceinline__ float fast_silu(float x) { return x * fast_sigmoid(x); }
#define LDS_WAIT() asm volatile("s_waitcnt lgkmcnt(0)" ::: "memory")
#define VM_WAIT() asm volatile("s_waitcnt vmcnt(0)" ::: "memory")

#define XB_TMO      128
#define XB_XCNT(j)  (256  + 64 * (j))
#define XB_XSUB(j)  (1280 + 64 * (j))
#define XB_XGEN(j)  (2304 + 64 * (j))
#define XB_TOP      3328
#define XB_TOPGEN   3392
#define XCD_BAR_WORDS 3456
#define XB_SPIN_CAP (1u << 18)
__device__ __forceinline__ unsigned xb_ld(unsigned* p)              { return __hip_atomic_load(p, __ATOMIC_RELAXED, __HIP_MEMORY_SCOPE_AGENT); }
__device__ __forceinline__ unsigned xb_add(unsigned* p, unsigned v) { return __hip_atomic_fetch_add(p, v, __ATOMIC_RELAXED, __HIP_MEMORY_SCOPE_AGENT); }
__device__ __forceinline__ unsigned xb_xcc_id() { return (unsigned)__builtin_amdgcn_s_getreg((3 << 11) | 20) & 0xFu; }
#define XB_SPIN(cond, bar) do { unsigned _sp = 0; while (cond) { __builtin_amdgcn_s_sleep(1); \
    if ((++_sp & 255u) == 0u) { if (xb_ld(&(bar)[XB_TMO])) break; if (_sp > XB_SPIN_CAP) { atomicAdd(&(bar)[XB_TMO], 1u); break; } } } } while (0)
struct XcdBarrier { unsigned* bar; unsigned x; volatile LAS unsigned* st; };
__device__ __forceinline__ XcdBarrier xcd_barrier_post(unsigned* bar, volatile LAS unsigned* st) {
    XcdBarrier b; b.bar = bar; b.x = xb_xcc_id(); b.st = st;
    if (threadIdx.x == 0) (void)xb_add(&bar[XB_XCNT(b.x)], 1u);
    return b;
}
__device__ __forceinline__ void xcd_barrier_complete(unsigned* bar, unsigned x, unsigned& nloc, unsigned& nx) {
    const unsigned G = gridDim.x * gridDim.y * gridDim.z;
    unsigned sum, cnt, mine, sp = 0u;
    for (;;) {
        sum = 0u; cnt = 0u; mine = 0u;
#pragma unroll
        for (unsigned j = 0; j < 16; ++j) { const unsigned c = xb_ld(&bar[XB_XCNT(j)]); sum += c; cnt += (c > 0u) ? 1u : 0u; mine = (j == x) ? c : mine; }
        if (sum == G) break;
        __builtin_amdgcn_s_sleep(1);
        if ((++sp & 255u) == 0u) { if (xb_ld(&bar[XB_TMO])) break; if (sp > XB_SPIN_CAP) { atomicAdd(&bar[XB_TMO], 1u); break; } }
    }
    nloc = mine > 0u ? mine : 1u; nx = cnt > 0u ? cnt : 1u;
}
__device__ __forceinline__ void xcd_barrier(const XcdBarrier& b) {
    asm volatile("s_waitcnt vmcnt(0)" ::: "memory");
    __syncthreads();
    if (threadIdx.x == 0) {
        unsigned* bar = b.bar;
        __builtin_amdgcn_s_waitcnt(0);
        unsigned nloc = b.st[0], nx = b.st[1];
        if (nloc == 0u) { xcd_barrier_complete(bar, b.x, nloc, nx); b.st[0] = nloc; b.st[1] = nx; }
        const unsigned old = xb_add(&bar[XB_XSUB(b.x)], 1u);
        const unsigned gen = old / nloc;
        if (old + 1u == (gen + 1u) * nloc) {
            __builtin_amdgcn_fence(__ATOMIC_RELEASE, "agent");
            asm volatile("s_waitcnt vmcnt(0)" ::: "memory");
            const unsigned og = xb_add(&bar[XB_TOP], 1u);
            const unsigned tg = og / nx;
            if (og + 1u == (tg + 1u) * nx) xb_add(&bar[XB_TOPGEN], 1u);
            else XB_SPIN(xb_ld(&bar[XB_TOPGEN]) == tg, bar);
            __builtin_amdgcn_fence(__ATOMIC_ACQUIRE, "agent");
            xb_add(&bar[XB_XGEN(b.x)], 1u);
            asm volatile("s_waitcnt vmcnt(0)" ::: "memory");
        } else {
            XB_SPIN(xb_ld(&bar[XB_XGEN(b.x)]) == gen, bar);
            __builtin_amdgcn_fence(__ATOMIC_ACQUIRE, "agent");
            asm volatile("s_waitcnt vmcnt(0)" ::: "memory");
        }
    }
    __syncthreads();
}

namespace pg8 {
constexpr int BM = 256, BK = 64, HALF = 128, HTB = HALF * BK * 2, STAGE_BYTES = 8 * HTB, NXCD = 8, WGM = 8;
__host__ __device__ __forceinline__ int lds_byte(int r, int c) { const int st = (r >> 4) * 2 + (c >> 5), rr = r & 15, cc = c & 31, ob = rr * 64 + cc * 2; return st * 1024 + (ob ^ (((ob >> 9) & 1) << 5)); }
__host__ __device__ __forceinline__ void stage_rc(int b, int& R, int& C) { const int st = b / 1024, sb = b % 1024, swz = sb ^ (((sb >> 9) & 1) << 5); R = (st >> 1) * 16 + swz / 64; C = (st & 1) * 32 + (swz % 64) / 2; }
__host__ __device__ __forceinline__ int perm32(int rho) { const int n = rho >> 4, i = rho & 15; return 8 * (i >> 2) + 4 * n + (i & 3); }

struct Unit { int pm, pn, ka; };
struct Gemm { const bf16_t* A; const bf16_t* Bt; int lda, K; };

__device__ __forceinline__ void tile_of(int L, int nM, int nN, int& pm, int& pn) {
    const int nwg = nM * nN; int wgid = L;
    { const int q = nwg / NXCD, r = nwg % NXCD, xcd = wgid % NXCD, off = wgid / NXCD; wgid = (xcd < r ? xcd * (q + 1) : r * (q + 1) + (xcd - r) * q) + off; }
    const int nig = WGM * nN, gid = wgid / nig, fm = gid * WGM, gsz = (nM - fm) < WGM ? (nM - fm) : WGM;
    pm = fm + ((wgid % nig) % gsz); pn = (wgid % nig) / gsz;
}
struct SchedPlain {
    int nM, nN, G, c, mode;
    __device__ __forceinline__ bool next(int i, Unit& u) const {
        const int L = i * G + c; if (L >= nM * nN) return false;
        tile_of(L, nM, nN, u.pm, u.pn);
        u.ka = (mode == 1) ? (u.pn < 6 ? ZC_CQ : ZC_CKV) : (mode == 2 ? ZC_PIN * 0 + 256 * u.pn : 0);
        return true;
    }
    __device__ __forceinline__ void a_ready(const Unit&) const {}
    __device__ __forceinline__ void done(const Unit&) const {}
};
struct SchedMerge {
    int G, c;
    __device__ __forceinline__ bool next(int i, Unit& u) const {
        const int T = (i / 3) * G + c, seg = i % 3; if (T >= 36 * 8) return false;
        int pm, pn; tile_of(T, 36, 8, pm, pn);
        u.pm = seg * 36 + pm; u.pn = seg * 8 + pn; u.ka = 0; return true;
    }
    __device__ __forceinline__ void a_ready(const Unit&) const {}
    __device__ __forceinline__ void done(const Unit&) const {}
};

struct EpiZ {
    static constexpr bool PERM = true, AFTER_DRAIN = false;
    bf16_t* Z; float* ZT;
    __device__ __forceinline__ void operator()(const f32x4 (&acc)[2][2][4][2], const Unit& u, int wr, int wc, int fr, int fq) const {
        const int row0 = u.pm * BM + wr * 64 + fr, cw = wc * 32 + 8 * fq;
        if (u.pn < 48) {
#pragma unroll
            for (int ai = 0; ai < 2; ++ai)
#pragma unroll
                for (int m = 0; m < 4; ++m) { bf16_t* rowp = Z + (size_t)(row0 + ai * HALF + m * 16) * NZB + u.pn * BM + cw;
#pragma unroll
                    for (int bj = 0; bj < 2; ++bj) { const f32x4 v0 = acc[ai][bj][m][0], v1 = acc[ai][bj][m][1];
                        u32x4 w; w.x = cvt_pk_bf16(v0[0], v0[1]); w.y = cvt_pk_bf16(v0[2], v0[3]); w.z = cvt_pk_bf16(v1[0], v1[1]); w.w = cvt_pk_bf16(v1[2], v1[3]);
                        *(u32x4*)(rowp + bj * HALF) = w; } }
        } else {
#pragma unroll
            for (int ai = 0; ai < 2; ++ai)
#pragma unroll
                for (int m = 0; m < 4; ++m) { float* rowp = ZT + (size_t)(row0 + ai * HALF + m * 16) * 256 + cw;
#pragma unroll
                    for (int bj = 0; bj < 2; ++bj) { *(f32x4*)(rowp + bj * HALF) = acc[ai][bj][m][0]; *(f32x4*)(rowp + bj * HALF + 4) = acc[ai][bj][m][1]; } }
        }
    }
};
struct EpiBf16 {
    static constexpr bool PERM = true, AFTER_DRAIN = false;
    bf16_t* O; int ldc;
    __device__ __forceinline__ void operator()(const f32x4 (&acc)[2][2][4][2], const Unit& u, int wr, int wc, int fr, int fq) const {
        const int row0 = u.pm * BM + wr * 64 + fr, col0 = u.pn * BM + wc * 32 + 8 * fq;
#pragma unroll
        for (int ai = 0; ai < 2; ++ai)
#pragma unroll
            for (int m = 0; m < 4; ++m) { bf16_t* rowp = O + (size_t)(row0 + ai * HALF + m * 16) * ldc + col0;
#pragma unroll
                for (int bj = 0; bj < 2; ++bj) { const f32x4 v0 = acc[ai][bj][m][0], v1 = acc[ai][bj][m][1];
                    u32x4 w; w.x = cvt_pk_bf16(v0[0], v0[1]); w.y = cvt_pk_bf16(v0[2], v0[3]); w.z = cvt_pk_bf16(v1[0], v1[1]); w.w = cvt_pk_bf16(v1[2], v1[3]);
                    *(u32x4*)(rowp + bj * HALF) = w; } }
    }
};
struct EpiSwiGLU {
    static constexpr bool PERM = true, AFTER_DRAIN = false;
    bf16_t* ACT;
    __device__ __forceinline__ void operator()(const f32x4 (&acc)[2][2][4][2], const Unit& u, int wr, int wc, int fr, int fq) const {
        const int row0 = u.pm * BM + wr * 64 + fr, col0 = u.pn * HALF + wc * 32 + 8 * fq;
#pragma unroll
        for (int ai = 0; ai < 2; ++ai)
#pragma unroll
            for (int m = 0; m < 4; ++m) {
                float o[8];
#pragma unroll
                for (int n = 0; n < 2; ++n)
#pragma unroll
                    for (int j = 0; j < 4; ++j) o[4 * n + j] = fast_silu(acc[ai][0][m][n][j]) * acc[ai][1][m][n][j];
                u32x4 w; w.x = cvt_pk_bf16(o[0], o[1]); w.y = cvt_pk_bf16(o[2], o[3]); w.z = cvt_pk_bf16(o[4], o[5]); w.w = cvt_pk_bf16(o[6], o[7]);
                *(u32x4*)(ACT + (size_t)(row0 + ai * HALF + m * 16) * FF + col0) = w; }
    }
};
struct EpiResid {
    static constexpr bool PERM = true, AFTER_DRAIN = false;
    float* X; float* OUT; const float* gate;
    __device__ __forceinline__ void operator()(const f32x4 (&acc)[2][2][4][2], const Unit& u, int wr, int wc, int fr, int fq) const {
        const int row0 = u.pm * BM + wr * 64 + fr, col0 = u.pn * BM + wc * 32 + 8 * fq;
        const int mr = u.pm < 32 ? (u.pm >> 3) : 4;
        const float* gp = gate + (size_t)mr * 12288 + col0;
        float* dst = (OUT != nullptr && u.pm < 32) ? OUT : X;
        f32x4 g[2][2];
#pragma unroll
        for (int bj = 0; bj < 2; ++bj)
#pragma unroll
            for (int n = 0; n < 2; ++n) g[bj][n] = *(const f32x4*)(gp + bj * HALF + 4 * n);
#pragma unroll
        for (int ai = 0; ai < 2; ++ai)
#pragma unroll
            for (int m = 0; m < 4; ++m) { const size_t off = (size_t)(row0 + ai * HALF + m * 16) * DM + col0;
#pragma unroll
                for (int bj = 0; bj < 2; ++bj)
#pragma unroll
                    for (int n = 0; n < 2; ++n) { const f32x4 x = *(const f32x4*)(X + off + bj * HALF + 4 * n);
                        *(f32x4*)(dst + off + bj * HALF + 4 * n) = x + g[bj][n] * acc[ai][bj][m][n]; } }
    }
};
struct EpiMerge {
    static constexpr bool PERM = true, AFTER_DRAIN = false;
    const bf16_t* Z; float* MP; bf16_t* MERGED;
    __device__ __forceinline__ void operator()(const f32x4 (&acc)[2][2][4][2], const Unit& u, int wr, int wc, int fr, int fq) const {
        const int seg = u.pm / 36, pm = u.pm - seg * 36, pn = u.pn - seg * 8;
        const int row0 = pm * BM + wr * 64 + fr, col0 = pn * BM + wc * 32 + 8 * fq;
#pragma unroll
        for (int ai = 0; ai < 2; ++ai)
#pragma unroll
            for (int m = 0; m < 4; ++m) { const int row = row0 + ai * HALF + m * 16;
#pragma unroll
                for (int bj = 0; bj < 2; ++bj) {
                    const u32x4 gw = *(const u32x4*)(Z + (size_t)row * NZB + ZC_GATE + seg * DM + col0 + bj * HALF);
                    f32x4 g0, g1;
                    g0[0] = fast_sigmoid(bflo(gw.x)); g0[1] = fast_sigmoid(bfhi(gw.x)); g0[2] = fast_sigmoid(bflo(gw.y)); g0[3] = fast_sigmoid(bfhi(gw.y));
                    g1[0] = fast_sigmoid(bflo(gw.z)); g1[1] = fast_sigmoid(bfhi(gw.z)); g1[2] = fast_sigmoid(bflo(gw.w)); g1[3] = fast_sigmoid(bfhi(gw.w));
                    f32x4 v0 = g0 * acc[ai][bj][m][0], v1 = g1 * acc[ai][bj][m][1];
                    float* mp = MP + (size_t)row * DM + col0 + bj * HALF;
                    if (seg > 0) { v0 += *(const f32x4*)mp; v1 += *(const f32x4*)(mp + 4); }
                    if (seg < 2) { *(f32x4*)mp = v0; *(f32x4*)(mp + 4) = v1; }
                    else { u32x4 w; w.x = cvt_pk_bf16(v0[0], v0[1]); w.y = cvt_pk_bf16(v0[2], v0[3]); w.z = cvt_pk_bf16(v1[0], v1[1]); w.w = cvt_pk_bf16(v1[2], v1[3]);
                        *(u32x4*)(MERGED + (size_t)row * DM + col0 + bj * HALF) = w; } } }
    }
};

template <class Epi, class Sched, bool ALIGN_EPI = true>
__device__ __forceinline__ void gemm_phase(LAS unsigned char* lds, const Gemm g, const Sched& S, const Epi& E) {
    int tid = threadIdx.x; asm volatile("" : "+v"(tid));
    const int wid = __builtin_amdgcn_readfirstlane(tid >> 6), lane = tid & 63, wr = wid >> 2, wc = wid & 3, fr = lane & 15, fq = lane >> 4;
    int K = g.K, lda = g.lda; asm volatile("" : "+s"(K), "+s"(lda));
    const int nt = K / BK;
    unsigned voffA[2], voffB[2];
#pragma unroll
    for (int i = 0; i < 2; ++i) { int R, C; stage_rc(tid * 16 + i * 8192, R, C); const int Rb = Epi::PERM ? ((R & ~31) + perm32(R & 31)) : R;
        voffA[i] = (unsigned)(R * lda + C) * 2u; voffB[i] = (unsigned)(Rb * K + C) * 2u; }
    const size_t kstep = (size_t)(BK * 2);
    const size_t hstepA = (size_t)HALF * lda * 2, hstepB = (size_t)HALF * K * 2;
    const size_t tstepA = 2 * hstepA, tstepB = 2 * hstepB;
    const unsigned ldsw = (unsigned)wid * 1024u;
    const int aoff = lds_byte(wr * 64 + fr, fq * 8), boff = lds_byte(wc * 32 + fr, fq * 8);
#define PG8_SA(b, h) (((b) * 2 + (h)) * HTB)
#define PG8_SB(b, h) ((4 + (b) * 2 + (h)) * HTB)
#define PG8_STAGE(bufoff, gbase, voff) do { _Pragma("unroll") for (int _i = 0; _i < 2; ++_i) \
        __builtin_amdgcn_global_load_lds((const unsigned*)((const char*)(gbase) + (voff)[_i]), (LAS unsigned*)(lds + (bufoff) + ldsw + _i * 8192), 16, 0, 0); } while (0)
#define PG8_LDA(dst, b, h) do { _Pragma("unroll") for (int m = 0; m < 4; ++m) _Pragma("unroll") for (int k = 0; k < 2; ++k) dst[m][k] = *(const LAS bf16x8*)(lds + PG8_SA(b, h) + aoff + m * 2048 + k * 1024); } while (0)
#define PG8_LDB(dst, b, h) do { _Pragma("unroll") for (int n = 0; n < 2; ++n) _Pragma("unroll") for (int k = 0; k < 2; ++k) dst[n][k] = *(const LAS bf16x8*)(lds + PG8_SB(b, h) + boff + n * 2048 + k * 1024); } while (0)
#define PG8_MMA(ai, bj, At, Bt) do { __builtin_amdgcn_s_setprio(1); _Pragma("unroll") for (int m = 0; m < 4; ++m) _Pragma("unroll") for (int n = 0; n < 2; ++n) _Pragma("unroll") for (int k = 0; k < 2; ++k) \
        acc[ai][bj][m][n] = __builtin_amdgcn_mfma_f32_16x16x32_bf16(Bt[n][k], At[m][k], acc[ai][bj][m][n], 0, 0, 0); __builtin_amdgcn_s_setprio(0); } while (0)
#define PG8_WAIT_V(n) asm volatile("s_waitcnt vmcnt(" #n ")" ::: "memory")
#define PG8_WAIT_L(n) asm volatile("s_waitcnt lgkmcnt(" #n ")" ::: "memory")
#define PG8_BAR __builtin_amdgcn_s_barrier()
#define PG8_SCHED __builtin_amdgcn_sched_barrier(0)
    Unit cur, nxt; int ui = 0;
    if (!S.next(0, cur)) return;
    f32x4 acc[2][2][4][2];
#pragma unroll
    for (int a = 0; a < 2; ++a)
#pragma unroll
        for (int b = 0; b < 2; ++b)
#pragma unroll
            for (int m = 0; m < 4; ++m)
#pragma unroll
                for (int n = 0; n < 2; ++n) acc[a][b][m][n] = (f32x4){0.f, 0.f, 0.f, 0.f};
    bf16x8 At[4][2], B0[2][2], B1[2][2];
    const char* cA = (const char*)g.A + (size_t)cur.pm * tstepA + (size_t)cur.ka * 2; const char* cB = (const char*)g.Bt + (size_t)cur.pn * tstepB;
    S.a_ready(cur);
    PG8_STAGE(PG8_SB(0, 0), cB, voffB); PG8_STAGE(PG8_SB(0, 1), cB + hstepB, voffB); PG8_STAGE(PG8_SA(0, 0), cA, voffA); PG8_STAGE(PG8_SA(0, 1), cA + hstepA, voffA);
    if (wr == 1) PG8_BAR;
    PG8_WAIT_V(2); PG8_BAR;
    PG8_STAGE(PG8_SB(1, 0), cB + kstep, voffB); PG8_STAGE(PG8_SA(1, 0), cA + kstep, voffA); PG8_STAGE(PG8_SB(1, 1), cB + hstepB + kstep, voffB);
    PG8_WAIT_V(6); PG8_BAR;
    for (;;) {
        const bool has_next = S.next(ui + 1, nxt);
        const char* nA = has_next ? (const char*)g.A + (size_t)nxt.pm * tstepA + (size_t)nxt.ka * 2 : cA; const char* nB = has_next ? (const char*)g.Bt + (size_t)nxt.pn * tstepB : cB;
        for (int t = 0; t < nt; t += 2) {
            const bool last = (t == nt - 2);
            const char* a1 = cA + (size_t)(t + 1) * kstep;
            const char* a2 = last ? nA : cA + (size_t)(t + 2) * kstep; const char* b2 = last ? nB : cB + (size_t)(t + 2) * kstep;
            const char* a3 = a2 + kstep; const char* b3 = b2 + kstep;
            if (last && has_next) S.a_ready(nxt);
            PG8_LDB(B0, 0, 0); PG8_LDB(B1, 0, 1); PG8_SCHED; PG8_LDA(At, 0, 0); PG8_STAGE(PG8_SA(1, 1), a1 + hstepA, voffA);
            PG8_WAIT_V(8); PG8_WAIT_L(0); PG8_BAR; PG8_MMA(0, 0, At, B0); PG8_MMA(0, 1, At, B1); PG8_BAR; PG8_SCHED;
            PG8_LDA(At, 0, 1); PG8_STAGE(PG8_SB(0, 0), b2, voffB); PG8_STAGE(PG8_SB(0, 1), b2 + hstepB, voffB); PG8_STAGE(PG8_SA(0, 0), a2, voffA);
            PG8_WAIT_V(8); PG8_WAIT_L(0); PG8_BAR; PG8_MMA(1, 0, At, B0); PG8_MMA(1, 1, At, B1); PG8_BAR; PG8_SCHED;
            PG8_LDB(B0, 1, 0); PG8_LDB(B1, 1, 1); PG8_SCHED; PG8_LDA(At, 1, 0); PG8_STAGE(PG8_SA(0, 1), a2 + hstepA, voffA);
            PG8_WAIT_V(8); PG8_WAIT_L(0); PG8_BAR; PG8_MMA(0, 0, At, B0); PG8_MMA(0, 1, At, B1); PG8_BAR; PG8_SCHED;
            PG8_LDA(At, 1, 1); PG8_STAGE(PG8_SB(1, 0), b3, voffB); PG8_STAGE(PG8_SB(1, 1), b3 + hstepB, voffB); PG8_STAGE(PG8_SA(1, 0), a3, voffA);
            PG8_WAIT_V(8); PG8_WAIT_L(0); PG8_BAR; PG8_MMA(1, 0, At, B0); PG8_MMA(1, 1, At, B1); PG8_BAR; PG8_SCHED;
        }
        if constexpr (ALIGN_EPI) { if (wr == 0) PG8_BAR; }
        E(acc, cur, wr, wc, fr, fq); S.done(cur);
        if (!has_next) break;
#pragma unroll
        for (int a = 0; a < 2; ++a)
#pragma unroll
            for (int b = 0; b < 2; ++b)
#pragma unroll
                for (int m = 0; m < 4; ++m)
#pragma unroll
                    for (int n = 0; n < 2; ++n) acc[a][b][m][n] = (f32x4){0.f, 0.f, 0.f, 0.f};
        cur = nxt; cA = nA; cB = nB; ++ui;
        if constexpr (ALIGN_EPI) { if (wr == 1) PG8_BAR; }
    }
    PG8_WAIT_V(0);
    if constexpr (!ALIGN_EPI) { if (wr == 0) PG8_BAR; }
    PG8_BAR;
#undef PG8_SA
#undef PG8_SB
#undef PG8_STAGE
#undef PG8_LDA
#undef PG8_LDB
#undef PG8_MMA
#undef PG8_WAIT_V
#undef PG8_WAIT_L
#undef PG8_BAR
#undef PG8_SCHED
}
}

namespace att {
constexpr int DQ = 192, DV = 128, NW = 8, QBLK = 32, KVBLK = 64;
constexpr float SCALE = 0.07216878364870322f;
constexpr float THR = 8.f;
constexpr int SHM_V = KVBLK * DV * 2, SHM_K = KVBLK * DQ * 2, SHM_ATTN = 2 * SHM_V + 2 * SHM_K + NW * 64 * 4;
#define KSWZ(row, colB) ((row) * 384 + ((colB) ^ (((row) & 7) << 4)))
#define SBAR() __builtin_amdgcn_sched_barrier(0)
__device__ __forceinline__ int crow(int r, int hi) { return (r & 3) + 8 * (r >> 2) + 4 * hi; }
__device__ __forceinline__ unsigned cvtpk(float lo, float hi) { unsigned r; asm volatile("v_cvt_pk_bf16_f32 %0, %1, %2" : "=v"(r) : "v"(lo), "v"(hi)); return r; }
__device__ __forceinline__ void partialSM(f32x16& p0, f32x16& p1, float& m_reg, float& mn, float& alpha) {
    constexpr float C = SCALE * 1.4426950408889634f;
    float pmax = p0[0];
#pragma unroll
    for (int r = 1; r < 16; ++r) pmax = fmaxf(pmax, p0[r]);
#pragma unroll
    for (int r = 0; r < 16; ++r) pmax = fmaxf(pmax, p1[r]);
    { auto rr = __builtin_amdgcn_permlane32_swap(__float_as_uint(pmax), __float_as_uint(pmax), false, false);
      pmax = fmaxf(__uint_as_float(rr[0]), __uint_as_float(rr[1])); }
    if (__builtin_expect(__all(pmax - m_reg <= THR / SCALE), 1)) { mn = m_reg; alpha = 1.f; }
    else { mn = fmaxf(m_reg, pmax); alpha = __builtin_amdgcn_exp2f((m_reg - mn) * C); m_reg = mn; }
    const float mnC = -mn * C;
#pragma unroll
    for (int r = 0; r < 16; ++r) p0[r] = fmaf(p0[r], C, mnC);
#pragma unroll
    for (int r = 0; r < 16; ++r) p1[r] = fmaf(p1[r], C, mnC);
#pragma unroll
    for (int r = 0; r < 16; ++r) p0[r] = __builtin_amdgcn_exp2f(p0[r]);
}
__device__ __forceinline__ void finishSM(f32x16& p0, f32x16& p1, float alpha, float& l_reg, bf16x8& pa0, bf16x8& pa1, bf16x8& pa2, bf16x8& pa3) {
#pragma unroll
    for (int r = 0; r < 16; ++r) p1[r] = __builtin_amdgcn_exp2f(p1[r]);
    float ps = 0;
#pragma unroll
    for (int r = 0; r < 16; ++r) ps += p0[r];
#pragma unroll
    for (int r = 0; r < 16; ++r) ps += p1[r];
    { auto rr = __builtin_amdgcn_permlane32_swap(__float_as_uint(ps), __float_as_uint(ps), false, false);
      ps = __uint_as_float(rr[0]) + __uint_as_float(rr[1]); }
    l_reg = l_reg * alpha + ps;
#define PK4(P, BASE, OUT) do { unsigned a0 = cvtpk(P[BASE + 0], P[BASE + 1]), a1 = cvtpk(P[BASE + 2], P[BASE + 3]);   \
    unsigned b0 = cvtpk(P[BASE + 4], P[BASE + 5]), b1 = cvtpk(P[BASE + 6], P[BASE + 7]);                              \
    auto r0 = __builtin_amdgcn_permlane32_swap(a0, b0, false, false); auto r1 = __builtin_amdgcn_permlane32_swap(a1, b1, false, false); \
    u32x4 w = {r0[0], r1[0], r0[1], r1[1]}; OUT = *reinterpret_cast<bf16x8*>(&w); } while (0)
    PK4(p0, 0, pa0); PK4(p0, 8, pa1); PK4(p1, 0, pa2); PK4(p1, 8, pa3);
#undef PK4
}
__device__ __forceinline__ void qkt(f32x16& p0, f32x16& p1, const char* Ks, const bf16x8* qr, int r32, int hi) {
    p0 = f32x16{}; p1 = f32x16{};
#pragma unroll
    for (int d0 = 0; d0 < DQ / 16; ++d0) { const int cb = (d0 * 16 + hi * 8) * 2;
        const bf16x8 b0 = *reinterpret_cast<const bf16x8*>(Ks + KSWZ(r32, cb));
        const bf16x8 b1 = *reinterpret_cast<const bf16x8*>(Ks + KSWZ(32 + r32, cb));
        p0 = __builtin_amdgcn_mfma_f32_32x32x16_bf16(b0, qr[d0], p0, 0, 0, 0);
        p1 = __builtin_amdgcn_mfma_f32_32x32x16_bf16(b1, qr[d0], p1, 0, 0, 0); }
}
__device__ __forceinline__ int v_st(int k, int c) { const int kk = (k & ~0xC) | ((k & 4) << 1) | ((k & 8) >> 1); return ((kk >> 3) * 4 + (c >> 5)) * 512 + ((kk & 7) * 32 + (c & 31)) * 2; }
__device__ __forceinline__ int v_rd_base(int lane) { return ((lane & 3) << 3) | (((lane >> 2) & 3) << 6) | (((lane >> 4) & 1) << 5) | (((lane >> 5) & 1) << 8); }
constexpr int v_rd_off(int d0, int ks, int half) { return d0 * 512 + ks * 4096 + half * 2048; }
template <int OFF> __device__ __forceinline__ s16x4 tr_read(int vb) {
    s16x4 r; asm volatile("ds_read_b64_tr_b16 %0, %1 offset:%2" : "=&v"(r) : "v"(vb), "i"(OFF) : "memory"); return r;
}
template <int D0> __device__ __forceinline__ void pv_one(f32x16& od, int vb, bf16x8 pa0, bf16x8 pa1, bf16x8 pa2, bf16x8 pa3) {
    const s16x4 l0 = tr_read<v_rd_off(D0, 0, 0)>(vb), h0 = tr_read<v_rd_off(D0, 0, 1)>(vb), l1 = tr_read<v_rd_off(D0, 1, 0)>(vb), h1 = tr_read<v_rd_off(D0, 1, 1)>(vb);
    const s16x4 l2 = tr_read<v_rd_off(D0, 2, 0)>(vb), h2 = tr_read<v_rd_off(D0, 2, 1)>(vb), l3 = tr_read<v_rd_off(D0, 3, 0)>(vb), h3 = tr_read<v_rd_off(D0, 3, 1)>(vb);
    asm volatile("s_waitcnt lgkmcnt(0)" ::: "memory"); SBAR();
#define PK(L, H) (bf16x8){L[0], L[1], L[2], L[3], H[0], H[1], H[2], H[3]}
    od = __builtin_amdgcn_mfma_f32_32x32x16_bf16(pa0, PK(l0, h0), od, 0, 0, 0);
    od = __builtin_amdgcn_mfma_f32_32x32x16_bf16(pa1, PK(l1, h1), od, 0, 0, 0);
    od = __builtin_amdgcn_mfma_f32_32x32x16_bf16(pa2, PK(l2, h2), od, 0, 0, 0);
    od = __builtin_amdgcn_mfma_f32_32x32x16_bf16(pa3, PK(l3, h3), od, 0, 0, 0);
#undef PK
}
__device__ __forceinline__ void pv_d0(f32x16* o, int vb, bf16x8 pa0, bf16x8 pa1, bf16x8 pa2, bf16x8 pa3) {
    pv_one<0>(o[0], vb, pa0, pa1, pa2, pa3); pv_one<1>(o[1], vb, pa0, pa1, pa2, pa3); pv_one<2>(o[2], vb, pa0, pa1, pa2, pa3); pv_one<3>(o[3], vb, pa0, pa1, pa2, pa3);
}
__device__ __forceinline__ void attn_body(const bf16_t* __restrict__ Qb, const bf16_t* __restrict__ Kh, const bf16_t* __restrict__ Vh, bf16_t* __restrict__ Ob, int ldo, int seq, char* lds) {
    int tid = threadIdx.x; asm volatile("" : "+v"(tid));
    const int wid = tid >> 6, lane = tid & 63, r32 = lane & 31, hi = lane >> 5;
    char* V_lds = lds; char* K_lds = lds + 2 * SHM_V;
    float* ws = (float*)(lds + 2 * SHM_V + 2 * SHM_K) + wid * 64; float* li_l = ws; float* al_l = ws + 32;
    float m_reg = -1e30f, l_reg = 0; f32x16 o[4] = {}; bf16x8 qr[DQ / 16];
    const bf16_t* Qw = Qb + (size_t)(wid * QBLK + r32) * DQ + hi * 8;
#pragma unroll
    for (int d0 = 0; d0 < DQ / 16; ++d0) qr[d0] = *reinterpret_cast<const bf16x8*>(Qw + d0 * 16);
    const int sr = tid >> 4, sc = (tid & 15) * 8, vst0 = v_st(sr, sc), vst1 = v_st(32 + sr, sc);
    const int krow = tid >> 3, kseg = (tid & 7) * 16;
    const int kgo = krow * 384 + kseg, klo = krow * 384 + (kseg ^ ((krow & 7) << 4));
    const int vb0 = (int)(uintptr_t)V_lds + v_rd_base(lane);
    bf16x8 vs0, vs1, ks0, ks1, ks2;
#define SLOAD(k0) do { vs0 = *reinterpret_cast<const bf16x8*>(&Vh[(size_t)((k0) + sr) * DV + sc]); vs1 = *reinterpret_cast<const bf16x8*>(&Vh[(size_t)((k0) + 32 + sr) * DV + sc]); \
    { const char* kp_ = (const char*)Kh + (size_t)(k0) * 384 + kgo; ks0 = *reinterpret_cast<const bf16x8*>(kp_); ks1 = *reinterpret_cast<const bf16x8*>(kp_ + 128); ks2 = *reinterpret_cast<const bf16x8*>(kp_ + 256); } } while (0)
#define SWRITE(b) do { *(bf16x8*)(V_lds + (b) * SHM_V + vst0) = vs0; *(bf16x8*)(V_lds + (b) * SHM_V + vst1) = vs1; \
    *(bf16x8*)(K_lds + (b) * SHM_K + klo) = ks0; *(bf16x8*)(K_lds + (b) * SHM_K + klo + 128) = ks1; *(bf16x8*)(K_lds + (b) * SHM_K + klo + 256) = ks2; } while (0)
#define SWAIT() asm volatile("s_waitcnt vmcnt(0)" ::: "memory")
#define RESC(a) do { if (__any((a) < 1.f)) { if (hi == 0) al_l[r32] = (a); asm volatile("s_waitcnt lgkmcnt(0)" ::: "memory"); \
    _Pragma("unroll") for (int d = 0; d < 4; ++d) _Pragma("unroll") for (int r = 0; r < 16; ++r) o[d][r] *= al_l[crow(r, hi)]; } } while (0)
    f32x16 p0, p1; float mn, al; bf16x8 pa0, pa1, pa2, pa3; const int NT = seq / KVBLK;
    SLOAD(0); SWAIT(); SWRITE(0); __syncthreads();
#pragma unroll 1
    for (int j = 0; j < NT; ++j) {
        const int bsel = j & 1;
        if (j + 1 < NT) SLOAD((j + 1) * KVBLK);
        SBAR(); qkt(p0, p1, K_lds + bsel * SHM_K, qr, r32, hi);
        partialSM(p0, p1, m_reg, mn, al);
        RESC(al);
        finishSM(p0, p1, al, l_reg, pa0, pa1, pa2, pa3); SBAR();
        pv_d0(o, vb0 + bsel * SHM_V, pa0, pa1, pa2, pa3);
        if (j + 1 < NT) { SWAIT(); SWRITE(bsel ^ 1); }
        __syncthreads();
    }
    if (hi == 0) li_l[r32] = l_reg; asm volatile("s_waitcnt lgkmcnt(0)" ::: "memory");
    float rli[16];
#pragma unroll
    for (int r = 0; r < 16; ++r) rli[r] = __builtin_amdgcn_rcpf(li_l[crow(r, hi)]);
    bf16_t* Ow = Ob + (size_t)(wid * QBLK) * ldo;
#pragma unroll
    for (int r = 0; r < 16; ++r) { const int orow = crow(r, hi);
#pragma unroll
        for (int d0 = 0; d0 < 4; ++d0) Ow[(size_t)orow * ldo + d0 * 32 + r32] = f2bf(o[d0][r] * rli[r]); }
    __syncthreads();
#undef SLOAD
#undef SWRITE
#undef SWAIT
#undef RESC
}
}

struct Args { const float* in[25]; float* out; unsigned char* ws; int q_lo, q_hi, single, pad; };
enum { I_X = 0, I_C, I_CTX, I_CCTX, I_WMOD, I_BMOD, I_N1G, I_N2G, I_WIN, I_QNG, I_WQUP, I_KVNG, I_WKVUP, I_QHG, I_KHG, I_GWG, I_GBG, I_GONG, I_PW, I_PS, I_WBR, I_WOUT, I_W1, I_W3, I_W2 };
constexpr int NPH = 11;

struct Frame {
    LAS unsigned char* lds; unsigned char* ldsg;
    int tid, lane, wave, G, c;
    const float* const* in; float* out; unsigned char* ws;
};

__device__ __forceinline__ void refresh_lane(Frame& F) { int t = threadIdx.x; asm volatile("" : "+v"(t)); F.tid = t; F.lane = t & 63; }
__device__ __forceinline__ int mod_row(int row) { return row < ML ? (row >> 11) : 4; }

__device__ __forceinline__ void transpose_item(const float* src, int ldsrc, int c0, int k0, bf16_t* dst, int lddst, int r0, const float* kscale, const float* nscale, LAS float* scr, int lane) {
#pragma unroll 8
    for (int i = 0; i < 32; ++i) { const int kk = 2 * i + (lane >> 5); scr[kk * 33 + (lane & 31)] = src[(size_t)(k0 + kk) * ldsrc + c0 + (lane & 31)]; }
    LDS_WAIT(); asm volatile("" ::: "memory");
    const int c = lane & 7;
    float ks[8];
#pragma unroll
    for (int i = 0; i < 8; ++i) ks[i] = kscale ? kscale[k0 + 8 * c + i] : 1.0f;
#pragma unroll
    for (int j = 0; j < 4; ++j) { const int n = (lane >> 3) + 8 * j; const LAS float* s = scr + (8 * c) * 33 + n; const float ns = nscale ? nscale[n] : 1.0f;
        u32x4 o; o.x = cvt_pk_bf16(s[0 * 33] * ks[0] * ns, s[1 * 33] * ks[1] * ns); o.y = cvt_pk_bf16(s[2 * 33] * ks[2] * ns, s[3 * 33] * ks[3] * ns);
        o.z = cvt_pk_bf16(s[4 * 33] * ks[4] * ns, s[5 * 33] * ks[5] * ns); o.w = cvt_pk_bf16(s[6 * 33] * ks[6] * ns, s[7 * 33] * ks[7] * ns);
        *(u32x4*)(dst + (size_t)(r0 + n) * lddst + k0 + 8 * c) = o; }
    LDS_WAIT(); asm volatile("" ::: "memory");
}
__device__ __forceinline__ int win_dst_row(int n) {
    if (n < 512) return ZC_CKV + n;
    if (n < 576) return NZB + ZT_KR + (n - 512);
    if (n < 1600) return ZC_GK + (n - 576);
    if (n < 2624) return ZC_GV + (n - 1600);
    if (n < 2656) return NZB + ZT_LR + (n - 2624);
    if (n < 3168) return ZC_CQ + (n - 2656);
    if (n < 4192) return ZC_GQ + (n - 3168);
    if (n < 5216) return ZC_GG + (n - 4192);
    if (n < 6240) return ZC_PIN + (n - 5216);
    return ZC_GATE + (n - 6240);
}
constexpr int IT_IN = 32 * 387, IT_Q = 8 * 48, IT_KV = 8 * 64, IT_P = 4 * 4 * 8, IT_B = 3 * 16 * 64, IT_O = 32 * 64, IT_1 = 32 * 176, IT_2 = 88 * 64;
constexpr int IT_LAYER = IT_IN + IT_Q + IT_KV + IT_P + IT_B + IT_O + 2 * IT_1 + IT_2;
__device__ __forceinline__ void prologue_item(const Frame& F, int it, LAS float* scr) {
    const int l = it / IT_LAYER; int r = it % IT_LAYER;
    bf16_t* wl = (bf16_t*)(F.ws + WS_W + (size_t)l * W_LAYER);
    if (r < IT_IN) { const int kb = r / 387, nb = r % 387;
        transpose_item(F.in[I_WIN] + (size_t)l * DM * IN_COLS, IN_COLS, 32 * nb, 64 * kb, wl + W_IN / 2, DM, win_dst_row(32 * nb), nullptr, nullptr, scr, F.lane); return; } r -= IT_IN;
    if (r < IT_Q) { const int kb = r / 48, nb = r % 48;
        transpose_item(F.in[I_WQUP] + (size_t)l * 512 * 1536, 1536, 32 * nb, 64 * kb, wl + W_QKV / 2, 512, 32 * nb, F.in[I_QNG] + l * 512, nullptr, scr, F.lane); return; } r -= IT_Q;
    if (r < IT_KV) { const int kb = r / 64, nb = r % 64;
        transpose_item(F.in[I_WKVUP] + (size_t)l * 512 * 2048, 2048, 32 * nb, 64 * kb, wl + W_QKV / 2, 512, 1536 + 32 * nb, F.in[I_KVNG] + l * 512, nullptr, scr, F.lane); return; } r -= IT_KV;
    if (r < IT_P) { const int g = r / 32, kb = (r % 32) / 8, nb = r % 8;
        transpose_item(F.in[I_PW] + ((size_t)l * 4 + g) * 65536, 256, 32 * nb, 64 * kb, wl + W_P / 2, 256, g * 256 + 32 * nb, nullptr, F.in[I_PS] + l * 1024 + g * 256 + 32 * nb, scr, F.lane); return; } r -= IT_P;
    if (r < IT_B) { const int n = r / 1024, kb = (r % 1024) / 64, nb = r % 64;
        transpose_item(F.in[I_WBR] + ((size_t)l * 3 + n) * 1024 * 2048, 2048, 32 * nb, 64 * kb, wl + W_B / 2, 1024, n * 2048 + 32 * nb, nullptr, nullptr, scr, F.lane); return; } r -= IT_B;
    if (r < IT_O) { const int kb = r / 64, nb = r % 64;
        transpose_item(F.in[I_WOUT] + (size_t)l * DM * DM, DM, 32 * nb, 64 * kb, wl + W_O / 2, DM, 32 * nb, nullptr, nullptr, scr, F.lane); return; } r -= IT_O;
    if (r < 2 * IT_1) { const int which = r / IT_1; r %= IT_1; const int kb = r / 176, nb = r % 176, n0 = 32 * nb;
        transpose_item(F.in[which ? I_W3 : I_W1] + (size_t)l * DM * FF, FF, n0, 64 * kb, wl + W_13 / 2, DM, (n0 >> 7) * 256 + which * 128 + (n0 & 127), nullptr, nullptr, scr, F.lane); return; } r -= 2 * IT_1;
    { const int kb = r / 64, nb = r % 64;
        transpose_item(F.in[I_W2] + (size_t)l * FF * DM, DM, 32 * nb, 64 * kb, wl + W_2 / 2, FF, 32 * nb, nullptr, nullptr, scr, F.lane); }
}
__device__ __forceinline__ void phase_prologue(const Frame& F) {
    { LAS float* scr = (LAS float*)(F.lds + F.wave * 8448);
      const int gw = F.c * 8 + F.wave, NGW = F.G * 8;
      for (int it = gw; it < NLAYER * IT_LAYER; it += NGW) prologue_item(F, it, scr);
      const int gt = F.c * 512 + F.tid, NT = F.G * 512;
      for (int i = gt; i < NLAYER * 160 * (DM / 8); i += NT) { const int l = i / (160 * 256), rr = (i % (160 * 256)) / 256, cc = i % 256;
          *(u32x4*)((bf16_t*)(F.ws + WS_W + (size_t)l * W_LAYER + W_IN) + (size_t)(IN_COLS + rr) * DM + cc * 8) = (u32x4){0u, 0u, 0u, 0u}; } }
    __syncthreads();
    { float* sc = (float*)F.ldsg;
      float* red = (float*)(F.ldsg + 40960);
      for (int i = F.tid; i < 5 * DM; i += 512) { const int r = i >> 11, k = i & 2047; const float v = r < 4 ? F.in[I_C][r * DM + k] : F.in[I_CCTX][k]; sc[i] = v / (1.0f + __expf(-v)); }
      __syncthreads();
      float* mods = (float*)(F.ws + WS_MODS);
      for (int wb = F.c; wb < 256; wb += F.G) {
          const int l = wb >> 6, col0 = (wb & 63) * 192;
          const int cg = F.tid % 48, ksl = F.tid / 48;
          if (ksl < 10) {
              f32x4 a[5];
#pragma unroll
              for (int r = 0; r < 5; ++r) a[r] = (f32x4){0.f, 0.f, 0.f, 0.f};
              const float* wp = F.in[I_WMOD] + (size_t)l * DM * 12288 + col0 + 4 * cg;
#pragma unroll 8
              for (int k = ksl; k < DM; k += 10) { const f32x4 w = *(const f32x4*)(wp + (size_t)k * 12288);
#pragma unroll
                  for (int r = 0; r < 5; ++r) a[r] += w * sc[r * DM + k]; }
#pragma unroll
              for (int r = 0; r < 5; ++r) *(f32x4*)(red + (ksl * 5 + r) * 192 + 4 * cg) = a[r];
          }
          __syncthreads();
          for (int i = F.tid; i < 960; i += 512) { const int r = i / 192, j = i % 192; float s = F.in[I_BMOD][l * 12288 + col0 + j];
#pragma unroll
              for (int q = 0; q < 10; ++q) s += red[(q * 5 + r) * 192 + j];
              mods[((size_t)l * 5 + r) * 12288 + col0 + j] = s; }
          __syncthreads();
      } }
    { const int gt = F.c * 512 + F.tid, NT = F.G * 512; f32x4* X = (f32x4*)(F.ws + WS_X);
      const f32x4* x = (const f32x4*)F.in[I_X]; const f32x4* cx = (const f32x4*)F.in[I_CTX];
      for (int i = gt; i < ML * DM / 4; i += NT) X[i] = x[i];
      for (int i = gt; i < MC * DM / 4; i += NT) X[ML * DM / 4 + i] = cx[i]; }
}

__device__ __forceinline__ void phase_norm(const Frame& F, const float* ng, const float* mods_l, int ch_shift, int ch_scale) {
    const float* X = (const float*)(F.ws + WS_X); bf16_t* H = (bf16_t*)(F.ws + WS_H);
    for (int row = F.c * 8 + F.wave; row < MT; row += F.G * 8) {
        const f32x4* xr = (const f32x4*)(X + (size_t)row * DM) + F.lane;
        f32x4 v[8]; float s = 0.f;
#pragma unroll
        for (int j = 0; j < 8; ++j) { v[j] = xr[64 * j]; s += (v[j][0] * v[j][0] + v[j][1] * v[j][1]) + (v[j][2] * v[j][2] + v[j][3] * v[j][3]); }
        const float rstd = rsqrtf(wave_sum(s) * (1.0f / DM) + RMS_EPS);
        const float* mp = mods_l + (size_t)mod_row(row) * 12288;
#pragma unroll
        for (int j = 0; j < 8; ++j) { const int col = 4 * (F.lane + 64 * j);
            const f32x4 g = *(const f32x4*)(ng + col), sh = *(const f32x4*)(mp + ch_shift * DM + col), sc = *(const f32x4*)(mp + ch_scale * DM + col);
            const f32x4 h = (v[j] * rstd * g) * (sc + 1.0f) + sh;
            u32x2 w; w.x = cvt_pk_bf16(h[0], h[1]); w.y = cvt_pk_bf16(h[2], h[3]);
            *(u32x2*)(H + (size_t)row * DM + col) = w; }
    }
}

__device__ __forceinline__ int gla_row(int b, int dir, int n, int p) {
    if (n < 4) { const int s = 64 * n + p, t = dir ? (CTXL - 1 - s) : s; return ML + b * CTXL + t; }
    const int s = 64 * (n - 4) + p, t = dir ? (SEQ - 1 - s) : s; return b * SEQ + t;
}
__device__ __forceinline__ void gla_prep_unit(const Frame& F, int layer, int u) {
    const int n = u % NCH, cd = u / NCH, dir = cd & 1, bh = cd >> 1, h = bh & 3, b = bh >> 2;
    bf16_t* Ql = (bf16_t*)F.ldsg; bf16_t* Kl = (bf16_t*)(F.ldsg + 64 * 264 * 2); float* lrs = (float*)(F.ldsg + 2 * 64 * 264 * 2); float* hs = lrs + 1024;
    const bf16_t* Z = (const bf16_t*)(F.ws + WS_Z); const float* ZT = (const float*)(F.ws + WS_ZT);
    bf16_t* GQ = (bf16_t*)(F.ws + WS_GQ) + (size_t)u * 16384; bf16_t* GKT = (bf16_t*)(F.ws + WS_GKT) + (size_t)u * 16384; bf16_t* GVT = (bf16_t*)(F.ws + WS_GVT) + (size_t)u * 16384;
    bf16_t* GP = (bf16_t*)(F.ws + WS_GP) + (size_t)u * 4096; float* GD = (float*)(F.ws + WS_GD) + (size_t)u * 256;
    const int tid = F.tid;
    if (tid < 256) { const int p = tid >> 2, q4 = tid & 3; const int row = gla_row(b, dir, n, p);
        *(f32x4*)(lrs + p * 16 + q4 * 4) = *(const f32x4*)(ZT + (size_t)row * 256 + ZT_LR + dir * 16 + q4 * 4); }
    const int d = tid & 255, hf = tid >> 8, col = h * 256 + d;
    float w[16];
#pragma unroll
    for (int r = 0; r < 16; ++r) w[r] = F.in[I_GWG][((size_t)(layer * 2 + dir) * 16 + r) * 1024 + col];
    const float bias = F.in[I_GBG][(layer * 2 + dir) * 1024 + col];
    __syncthreads();
    float cum[32]; float run = 0.f;
#pragma unroll
    for (int i = 0; i < 32; ++i) { const int p = 32 * hf + i; float lg = bias;
#pragma unroll
        for (int r = 0; r < 16; ++r) lg += lrs[p * 16 + r] * w[r];
        const float ls = fminf(lg, 0.f) - log1pf(expf(-fabsf(lg)));
        run += ls * (1.0f / 16.0f); cum[i] = run; }
    hs[hf * 256 + d] = run; __syncthreads();
    const float tot0 = hs[d], tot1 = hs[256 + d], last = tot0 + tot1, off = hf ? tot0 : 0.f;
    unsigned khp[16], vvp[16];
#pragma unroll
    for (int i = 0; i < 32; i += 2) {
        float kh2[2]; unsigned short vv2[2];
#pragma unroll
        for (int e = 0; e < 2; ++e) { const int p = 32 * hf + i + e; const size_t rb = (size_t)gla_row(b, dir, n, p) * NZB; const float cc = cum[i + e] + off;
            const float q = bf2f(Z[rb + ZC_GQ + col]), k = bf2f(Z[rb + ZC_GK + col]); vv2[e] = Z[rb + ZC_GV + col];
            const bf16_t qt = f2bf(q * 0.0625f * expf(cc)), kt = f2bf(k * expf(-cc));
            kh2[e] = k * expf(last - cc);
            Ql[p * 264 + d] = qt; Kl[p * 264 + d] = kt; GQ[p * 256 + d] = qt; }
        khp[i >> 1] = cvt_pk_bf16(kh2[0], kh2[1]); vvp[i >> 1] = (unsigned)vv2[0] | ((unsigned)vv2[1] << 16); }
#pragma unroll
    for (int q = 0; q < 4; ++q) { *(u32x4*)(GKT + d * 64 + 32 * hf + 8 * q) = (u32x4){khp[4 * q], khp[4 * q + 1], khp[4 * q + 2], khp[4 * q + 3]};
                                  *(u32x4*)(GVT + d * 64 + 32 * hf + 8 * q) = (u32x4){vvp[4 * q], vvp[4 * q + 1], vvp[4 * q + 2], vvp[4 * q + 3]}; }
    if (hf == 0) GD[d] = expf(last);
    __syncthreads();
    { const int l15 = F.lane & 15, l4 = F.lane >> 4, tb = F.wave >> 1;
#pragma unroll
      for (int q = 0; q < 2; ++q) { const int sb = 2 * (F.wave & 1) + q; f32x4 acc = (f32x4){0.f, 0.f, 0.f, 0.f};
          if (sb <= tb) {
#pragma unroll
              for (int kk = 0; kk < 8; ++kk) { const bf16x8 a = *(const bf16x8*)(Kl + (sb * 16 + l15) * 264 + kk * 32 + 8 * l4), bq = *(const bf16x8*)(Ql + (tb * 16 + l15) * 264 + kk * 32 + 8 * l4);
                  acc = __builtin_amdgcn_mfma_f32_16x16x32_bf16(a, bq, acc, 0, 0, 0); } }
          const int t = tb * 16 + l15, s0 = sb * 16 + 4 * l4;
          float o[4];
#pragma unroll
          for (int j = 0; j < 4; ++j) o[j] = (s0 + j <= t) ? acc[j] : 0.f;
          u32x2 wv; wv.x = cvt_pk_bf16(o[0], o[1]); wv.y = cvt_pk_bf16(o[2], o[3]);
          *(u32x2*)(GP + t * 64 + s0) = wv; } }
    __syncthreads();
}

__device__ __forceinline__ void gla_scan_unit(const Frame& F, int unit) {
    const int es = unit & 7, cd = unit >> 3, dir = cd & 1, bh = cd >> 1, h = bh & 3, b = bh >> 2;
    const int u0 = cd * NCH;
    const int l15 = F.lane & 15, l4 = F.lane >> 4, w = F.wave, tb = w >> 1, ebo = w & 1;
    const unsigned oq = (unsigned)(l15 * 256 + 8 * l4) * 2u, o64 = (unsigned)(l15 * 64 + 8 * l4) * 2u, od = (unsigned)(4 * l4) * 4u;
    f32x4 S00 = (f32x4){0.f, 0.f, 0.f, 0.f}, S01 = S00, S10 = S00, S11 = S00;
    bf16x8 qA0, qA1, qA2, qA3, qA4, qA5, qA6, qA7, pA0, pA1, vA00, vA01, vA10, vA11, kA00, kA01, kA10, kA11; f32x4 dA0, dA1;
    bf16x8 qB0, qB1, qB2, qB3, qB4, qB5, qB6, qB7, pB0, pB1, vB00, vB01, vB10, vB11, kB00, kB01, kB10, kB11; f32x4 dB0, dB1;
#define SCAN_LOAD(X, u) do { \
    const char* gq_ = (const char*)(F.ws + WS_GQ) + ((size_t)(u) * 16384 + tb * 16 * 256) * 2 + oq; \
    q##X##0 = *(const bf16x8*)(gq_); q##X##1 = *(const bf16x8*)(gq_ + 64); q##X##2 = *(const bf16x8*)(gq_ + 128); q##X##3 = *(const bf16x8*)(gq_ + 192); \
    q##X##4 = *(const bf16x8*)(gq_ + 256); q##X##5 = *(const bf16x8*)(gq_ + 320); q##X##6 = *(const bf16x8*)(gq_ + 384); q##X##7 = *(const bf16x8*)(gq_ + 448); \
    const char* gp_ = (const char*)(F.ws + WS_GP) + ((size_t)(u) * 4096 + tb * 16 * 64) * 2 + o64; \
    p##X##0 = *(const bf16x8*)(gp_); p##X##1 = *(const bf16x8*)(gp_ + 64); \
    const char* gv_ = (const char*)(F.ws + WS_GVT) + ((size_t)(u) * 16384 + es * 32 * 64) * 2 + o64; \
    v##X##00 = *(const bf16x8*)(gv_); v##X##01 = *(const bf16x8*)(gv_ + 64); v##X##10 = *(const bf16x8*)(gv_ + 2048); v##X##11 = *(const bf16x8*)(gv_ + 2048 + 64); \
    const char* gk_ = (const char*)(F.ws + WS_GKT) + ((size_t)(u) * 16384 + 32 * w * 64) * 2 + o64; \
    k##X##00 = *(const bf16x8*)(gk_); k##X##01 = *(const bf16x8*)(gk_ + 64); k##X##10 = *(const bf16x8*)(gk_ + 2048); k##X##11 = *(const bf16x8*)(gk_ + 2048 + 64); \
    const char* gd_ = (const char*)(F.ws + WS_GD) + ((size_t)(u) * 256 + 32 * w) * 4 + od; \
    d##X##0 = *(const f32x4*)(gd_); d##X##1 = *(const f32x4*)(gd_ + 64); } while (0)
#define MF16(a, b, c) __builtin_amdgcn_mfma_f32_16x16x32_bf16(a, b, c, 0, 0, 0)
#define SCAN_STEP(X, n) do { \
    bf16_t* Sl = (bf16_t*)(F.ldsg + ((n) & 1) * (32 * 264 * 2)); \
      \
    { u32x2 wv; bf16_t* sp = Sl + l15 * 264 + 32 * w + 4 * l4; \
      wv.x = cvt_pk_bf16(S00[0], S00[1]); wv.y = cvt_pk_bf16(S00[2], S00[3]); *(u32x2*)(sp) = wv; \
      wv.x = cvt_pk_bf16(S01[0], S01[1]); wv.y = cvt_pk_bf16(S01[2], S01[3]); *(u32x2*)(sp + 16 * 264) = wv; \
      wv.x = cvt_pk_bf16(S10[0], S10[1]); wv.y = cvt_pk_bf16(S10[2], S10[3]); *(u32x2*)(sp + 16) = wv; \
      wv.x = cvt_pk_bf16(S11[0], S11[1]); wv.y = cvt_pk_bf16(S11[2], S11[3]); *(u32x2*)(sp + 16 * 264 + 16) = wv; } \
    __syncthreads(); \
      \
    { const bf16_t* sr_ = Sl + (ebo * 16 + l15) * 264 + 8 * l4; f32x4 o = (f32x4){0.f, 0.f, 0.f, 0.f}; \
      o = MF16(q##X##0, *(const bf16x8*)(sr_), o); o = MF16(q##X##1, *(const bf16x8*)(sr_ + 32), o); o = MF16(q##X##2, *(const bf16x8*)(sr_ + 64), o); o = MF16(q##X##3, *(const bf16x8*)(sr_ + 96), o); \
      o = MF16(q##X##4, *(const bf16x8*)(sr_ + 128), o); o = MF16(q##X##5, *(const bf16x8*)(sr_ + 160), o); o = MF16(q##X##6, *(const bf16x8*)(sr_ + 192), o); o = MF16(q##X##7, *(const bf16x8*)(sr_ + 224), o); \
      o = MF16(p##X##0, ebo ? v##X##10 : v##X##00, o); o = MF16(p##X##1, ebo ? v##X##11 : v##X##01, o); \
      float* OF = (float*)(F.ws + WS_OF) + (size_t)dir * MT * 1024 + h * 256 + es * 32 + ebo * 16 + l15; \
      _Pragma("unroll") for (int j = 0; j < 4; ++j) OF[(size_t)gla_row(b, dir, (n), tb * 16 + 4 * l4 + j) * 1024] = o[j]; } \
      \
    S00 = S00 * d##X##0; S01 = S01 * d##X##0; S10 = S10 * d##X##1; S11 = S11 * d##X##1; \
    S00 = MF16(k##X##00, v##X##00, S00); S00 = MF16(k##X##01, v##X##01, S00); \
    S01 = MF16(k##X##00, v##X##10, S01); S01 = MF16(k##X##01, v##X##11, S01); \
    S10 = MF16(k##X##10, v##X##00, S10); S10 = MF16(k##X##11, v##X##01, S10); \
    S11 = MF16(k##X##10, v##X##10, S11); S11 = MF16(k##X##11, v##X##11, S11); } while (0)
    SCAN_LOAD(A, u0);
#pragma unroll 1
    for (int n = 0; n < NCH; n += 2) {
        SCAN_LOAD(B, u0 + n + 1);
        SCAN_STEP(A, n);
        if (n + 2 < NCH) SCAN_LOAD(A, u0 + n + 2);
        SCAN_STEP(B, n + 1);
    }
    __syncthreads();
#undef SCAN_LOAD
#undef SCAN_STEP
#undef MF16
}

__device__ __forceinline__ void pool_rows(const Frame& F) {
    const bf16_t* Z = (const bf16_t*)(F.ws + WS_Z); bf16_t* P = (bf16_t*)(F.ws + WS_POOLED);
    const int gt = F.c * 512 + F.tid, NT = F.G * 512;
    for (int idx = gt; idx < MT * 128; idx += NT) {
        const int row = idx >> 7, c0 = (idx & 127) * 8, gi = c0 >> 8, hw = 1 << gi;
        int base, t, L;
        if (row < ML) { base = row & ~(SEQ - 1); t = row & (SEQ - 1); L = SEQ; } else { const int r = row - ML; base = ML + (r & ~(CTXL - 1)); t = r & (CTXL - 1); L = CTXL; }
        const int lo = max(t - hw, 0), hi = min(t + hw - 1, L - 1);
        float s[8];
#pragma unroll
        for (int j = 0; j < 8; ++j) s[j] = 0.f;
        for (int i = lo; i <= hi; ++i) { const u32x4 v = *(const u32x4*)(Z + (size_t)(base + i) * NZB + ZC_PIN + c0);
            s[0] += bflo(v.x); s[1] += bfhi(v.x); s[2] += bflo(v.y); s[3] += bfhi(v.y); s[4] += bflo(v.z); s[5] += bfhi(v.z); s[6] += bflo(v.w); s[7] += bfhi(v.w); }
        const u32x4 v = *(const u32x4*)(Z + (size_t)row * NZB + ZC_PIN + c0);
        const float ic = 1.0f / (float)(hi - lo + 1);
        u32x4 o; o.x = cvt_pk_bf16(s[0] * ic - bflo(v.x), s[1] * ic - bfhi(v.x)); o.y = cvt_pk_bf16(s[2] * ic - bflo(v.y), s[3] * ic - bfhi(v.y));
        o.z = cvt_pk_bf16(s[4] * ic - bflo(v.z), s[5] * ic - bfhi(v.z)); o.w = cvt_pk_bf16(s[6] * ic - bflo(v.w), s[7] * ic - bfhi(v.w));
        *(u32x4*)(P + (size_t)row * 1024 + c0) = o;
    }
}

__device__ __forceinline__ float rope_apply(float x, float ang, int lane) {
    const float cs = cosf(ang), sn = sinf(ang); const float pr = __shfl_xor(x, 16);
    return (lane & 16) ? (x * cs + pr * sn) : (x * cs - pr * sn);
}
__device__ __forceinline__ void post_up_rows(const Frame& F, int layer) {
    const bf16_t* Z = (const bf16_t*)(F.ws + WS_Z); const float* ZT = (const float*)(F.ws + WS_ZT); const bf16_t* R = (const bf16_t*)(F.ws + WS_QKVR);
    bf16_t* QF = (bf16_t*)(F.ws + WS_QF); bf16_t* KF = (bf16_t*)(F.ws + WS_KF); bf16_t* VF = (bf16_t*)(F.ws + WS_VF);
    const float* qhg = F.in[I_QHG] + layer * 192; const float* khg = F.in[I_KHG] + layer * 192;
    const int lane = F.lane;
    const float invf = 1.0f / powf(10000.0f, (float)(2 * (lane & 15)) / 32.0f);
    float gq[3], gk[3];
#pragma unroll
    for (int j = 0; j < 3; ++j) { gq[j] = qhg[lane + 64 * j]; gk[j] = khg[lane + 64 * j]; }
    for (int row = F.c * 8 + F.wave; row < MT; row += F.G * 8) {
        int b, pos; bool lat = row < ML; float ang = 0.f;
        if (lat) { b = row >> 11; const int t = row & (SEQ - 1); pos = CTXL + t; ang = (float)((lane < 32) ? (t >> 6) : (t & 63)) * invf; }
        else { const int r = row - ML; b = r >> 8; pos = r & (CTXL - 1); }
        float sq = 0.f, skv = 0.f;
        { const u32x4 a = *(const u32x4*)(Z + (size_t)row * NZB + ZC_CQ + 8 * lane), c = *(const u32x4*)(Z + (size_t)row * NZB + ZC_CKV + 8 * lane);
          const unsigned aw[4] = {a.x, a.y, a.z, a.w}, cw[4] = {c.x, c.y, c.z, c.w};
#pragma unroll
          for (int j = 0; j < 4; ++j) { sq += bflo(aw[j]) * bflo(aw[j]) + bfhi(aw[j]) * bfhi(aw[j]); skv += bflo(cw[j]) * bflo(cw[j]) + bfhi(cw[j]) * bfhi(cw[j]); } }
        const float rq = rsqrtf(wave_sum(sq) * (1.0f / 512.0f) + RMS_EPS), rkv = rsqrtf(wave_sum(skv) * (1.0f / 512.0f) + RMS_EPS);
        const float kr = ZT[(size_t)row * 256 + ZT_KR + lane]; const float kr2 = wave_sum(kr * kr);
        const bf16_t* rr = R + (size_t)row * NQKV;
#pragma unroll 2
        for (int h = 0; h < 8; ++h) {
            const size_t ob = ((size_t)(b * 8 + h) * KPOS + pos);
            float q[3]; float ss = 0.f;
#pragma unroll
            for (int j = 0; j < 3; ++j) { q[j] = bf2f(rr[h * 192 + lane + 64 * j]) * rq; ss += q[j] * q[j]; }
            const float rh = rsqrtf(wave_sum(ss) * (1.0f / 192.0f) + RMS_EPS);
#pragma unroll
            for (int j = 0; j < 3; ++j) q[j] *= rh * gq[j];
            if (lat) q[2] = rope_apply(q[2], ang, lane);
#pragma unroll
            for (int j = 0; j < 3; ++j) QF[ob * 192 + lane + 64 * j] = f2bf(q[j]);
            float k[3], v[2]; float sk = 0.f;
#pragma unroll
            for (int j = 0; j < 2; ++j) { k[j] = bf2f(rr[1536 + h * 256 + lane + 64 * j]) * rkv; v[j] = bf2f(rr[1536 + h * 256 + 128 + lane + 64 * j]) * rkv; sk += k[j] * k[j]; }
            const float rk = rsqrtf((wave_sum(sk) + kr2) * (1.0f / 192.0f) + RMS_EPS);
            k[0] *= rk * gk[0]; k[1] *= rk * gk[1]; k[2] = kr * rk * gk[2];
            if (lat) k[2] = rope_apply(k[2], ang, lane);
#pragma unroll
            for (int j = 0; j < 3; ++j) KF[ob * 192 + lane + 64 * j] = f2bf(k[j]);
#pragma unroll
            for (int j = 0; j < 2; ++j) VF[ob * 128 + lane + 64 * j] = f2bf(v[j]);
        }
    }
}

__device__ __forceinline__ void gla_out_rows(const Frame& F, int layer) {
    const float* OF = (const float*)(F.ws + WS_OF); const bf16_t* Z = (const bf16_t*)(F.ws + WS_Z); bf16_t* O = (bf16_t*)(F.ws + WS_BR) + (size_t)2 * MT * 1024;
    const f32x4 g = *(const f32x4*)(F.in[I_GONG] + layer * 256 + 4 * F.lane);
    for (int row = F.c * 8 + F.wave; row < MT; row += F.G * 8) {
#pragma unroll
        for (int h = 0; h < 4; ++h) { const size_t off = (size_t)row * 1024 + h * 256 + 4 * F.lane;
            const f32x4 o = *(const f32x4*)(OF + off) + *(const f32x4*)(OF + (size_t)MT * 1024 + off);
            const float r = rsqrtf(wave_sum((o[0] * o[0] + o[1] * o[1]) + (o[2] * o[2] + o[3] * o[3])) * (1.0f / 256.0f) + RMS_EPS);
            const u32x2 gw = *(const u32x2*)(Z + (size_t)row * NZB + ZC_GG + h * 256 + 4 * F.lane);
            const float g0 = bflo(gw.x), g1 = bfhi(gw.x), g2 = bflo(gw.y), g3 = bfhi(gw.y);
            u32x2 w; w.x = cvt_pk_bf16(o[0] * r * g[0] * fast_silu(g0), o[1] * r * g[1] * fast_silu(g1)); w.y = cvt_pk_bf16(o[2] * r * g[2] * fast_silu(g2), o[3] * r * g[3] * fast_silu(g3));
            *(u32x2*)(O + off) = w; }
    }
}

__global__ void __launch_bounds__(512, 2) fwd(Args args) {
    extern __shared__ __attribute__((aligned(16))) unsigned char lds[];
    Frame F;
    F.lds = (LAS unsigned char*)lds; F.ldsg = lds;
    F.tid = threadIdx.x; F.lane = F.tid & 63; F.wave = __builtin_amdgcn_readfirstlane(F.tid >> 6);
    F.G = gridDim.x; F.c = blockIdx.x; F.in = args.in; F.out = args.out; F.ws = args.ws;
    volatile LAS unsigned* MISC = (volatile LAS unsigned*)(F.lds + MISC_OFF);
    if (F.tid < 64) MISC[F.tid] = 0u;
    __syncthreads();
    XcdBarrier bar; bar.bar = (unsigned*)(F.ws + WS_CTL) + 4096; bar.x = 0; bar.st = nullptr;
    const bool single = args.single != 0;
    if (single) bar = xcd_barrier_post((unsigned*)(F.ws + WS_CTL) + 4096, MISC + 8);
    const int q_lo = args.q_lo, q_hi = args.q_hi;
#ifndef ONLY_PHASE
#define ONLY_PHASE -1
#endif
#define PEN(k) (ONLY_PHASE < 0 || ONLY_PHASE == (k))
#define IN(q) (q_lo <= (q) && (q) < q_hi)
#define SEAM(q) do { if (single && (q) + 1 < q_hi) xcd_barrier(bar); } while (0)

    if (PEN(0) && IN(0)) { refresh_lane(F); phase_prologue(F); SEAM(0); }

    for (int layer = 0; layer < NLAYER; ++layer) {
        const int qb = 1 + layer * NPH;
        if (qb + NPH <= q_lo || qb >= q_hi) continue;
        const bf16_t* wl = (const bf16_t*)(F.ws + WS_W + (size_t)layer * W_LAYER);
        const float* mods_l = (const float*)(F.ws + WS_MODS) + (size_t)layer * 5 * 12288;
        const bool lastl = layer == NLAYER - 1;

        if (PEN(1) && IN(qb + 0)) { refresh_lane(F); phase_norm(F, F.in[I_N1G] + layer * DM, mods_l, 0, 1); SEAM(qb + 0); }
        if (PEN(2) && IN(qb + 1)) { refresh_lane(F);
            pg8::Gemm g{(const bf16_t*)(F.ws + WS_H), wl + W_IN / 2, DM, DM}; pg8::SchedPlain S{36, 49, F.G, F.c, 0};
            pg8::EpiZ E{(bf16_t*)(F.ws + WS_Z), (float*)(F.ws + WS_ZT)};
            pg8::gemm_phase<pg8::EpiZ, pg8::SchedPlain>(F.lds, g, S, E);
            SEAM(qb + 1);
        }
        if (PEN(3) && IN(qb + 2)) { refresh_lane(F);
            { pg8::Gemm g{(const bf16_t*)(F.ws + WS_Z), wl + W_QKV / 2, NZB, 512}; pg8::SchedPlain S{36, 14, F.G, F.c, 1};
              pg8::EpiBf16 E{(bf16_t*)(F.ws + WS_QKVR), NQKV};
              pg8::gemm_phase<pg8::EpiBf16, pg8::SchedPlain>(F.lds, g, S, E); }
            __syncthreads();
            refresh_lane(F);
            for (int u = F.c; u < NGU; u += F.G) gla_prep_unit(F, layer, u);
            pool_rows(F);
            SEAM(qb + 2);
        }
        if (PEN(4) && IN(qb + 3)) { refresh_lane(F);
            post_up_rows(F, layer);
            __syncthreads();
            { pg8::Gemm g{(const bf16_t*)(F.ws + WS_POOLED), wl + W_P / 2, 1024, 256}; pg8::SchedPlain S{36, 4, F.G, F.G - 1 - F.c, 2};
              pg8::EpiBf16 E{(bf16_t*)(F.ws + WS_BR), 1024};
              pg8::gemm_phase<pg8::EpiBf16, pg8::SchedPlain>(F.lds, g, S, E); }
            SEAM(qb + 3);
        }
        if (PEN(5) && IN(qb + 4)) { refresh_lane(F);
            const bf16_t* QF = (const bf16_t*)(F.ws + WS_QF); const bf16_t* KF = (const bf16_t*)(F.ws + WS_KF); const bf16_t* VF = (const bf16_t*)(F.ws + WS_VF);
            bf16_t* O = (bf16_t*)(F.ws + WS_BR) + (size_t)MT * 1024;
            for (int i = F.c; i < 256 + 32; i += F.G) {
                int b, h, qpos, orow, seq;
                if (i < 256) { b = i >> 6; h = (i >> 3) & 7; const int qblk = i & 7; qpos = CTXL + qblk * 256; orow = b * SEQ + qblk * 256; seq = KPOS; }
                else { const int j = i - 256; b = j >> 3; h = j & 7; qpos = 0; orow = ML + b * CTXL; seq = CTXL; }
                const size_t hb = (size_t)(b * 8 + h) * KPOS;
                att::attn_body(QF + (hb + qpos) * 192, KF + hb * 192, VF + hb * 128, O + (size_t)orow * 1024 + h * 128, 1024, seq, (char*)lds);
            }
            for (int u = F.c; u < 256; u += F.G) gla_scan_unit(F, u);
            SEAM(qb + 4);
        }
        if (PEN(6) && IN(qb + 5)) { refresh_lane(F); gla_out_rows(F, layer); SEAM(qb + 5); }
        if (PEN(7) && IN(qb + 6)) { refresh_lane(F);
            pg8::Gemm g{(const bf16_t*)(F.ws + WS_BR), wl + W_B / 2, 1024, 1024}; pg8::SchedMerge S{F.G, F.c};
            pg8::EpiMerge E{(const bf16_t*)(F.ws + WS_Z), (float*)(F.ws + WS_MP), (bf16_t*)(F.ws + WS_MERGED)};
            pg8::gemm_phase<pg8::EpiMerge, pg8::SchedMerge>(F.lds, g, S, E);
            SEAM(qb + 6);
        }
        if (PEN(8) && IN(qb + 7)) { refresh_lane(F);
            pg8::Gemm g{(const bf16_t*)(F.ws + WS_MERGED), wl + W_O / 2, DM, DM}; pg8::SchedPlain S{36, 8, F.G, F.c, 0};
            pg8::EpiResid E{(float*)(F.ws + WS_X), nullptr, mods_l + 2 * DM};
            pg8::gemm_phase<pg8::EpiResid, pg8::SchedPlain>(F.lds, g, S, E);
            SEAM(qb + 7);
        }
        if (PEN(9) && IN(qb + 8)) { refresh_lane(F); phase_norm(F, F.in[I_N2G] + layer * DM, mods_l, 3, 4); SEAM(qb + 8); }
        if (PEN(10) && IN(qb + 9)) { refresh_lane(F);
            pg8::Gemm g{(const bf16_t*)(F.ws + WS_H), wl + W_13 / 2, DM, DM}; pg8::SchedPlain S{36, 44, F.G, F.c, 0};
            pg8::EpiSwiGLU E{(bf16_t*)(F.ws + WS_ACT)};
            pg8::gemm_phase<pg8::EpiSwiGLU, pg8::SchedPlain>(F.lds, g, S, E);
            SEAM(qb + 9);
        }
        if (PEN(11) && IN(qb + 10)) { refresh_lane(F);
            pg8::Gemm g{(const bf16_t*)(F.ws + WS_ACT), wl + W_2 / 2, FF, FF}; pg8::SchedPlain S{36, 8, F.G, F.c, 0};
            pg8::EpiResid E{(float*)(F.ws + WS_X), lastl ? F.out : nullptr, mods_l + 5 * DM};
            pg8::gemm_phase<pg8::EpiResid, pg8::SchedPlain>(F.lds, g, S, E);
            SEAM(qb + 10);
        }
    }
#undef IN
#undef SEAM
}

extern "C" void kernel_launch(void* const* d_in, const int* in_sizes, int n_in, void* d_out, int out_size, void* d_ws, size_t ws_size, hipStream_t stream) {
    static int grid = 0;
    if (grid == 0) {
        if (n_in != 25 || out_size != ML * DM || ws_size < WS_END) {
            fprintf(stderr, "kernel_launch: built for 25 inputs, out of %d floats, >= %zu bytes of workspace; got n_in %d, out %d, ws %zu; nothing launched\n", ML * DM, (size_t)WS_END, n_in, out_size, ws_size);
            grid = -1; return; }
        int dev = 0, cus = 0, per_cu = 0;
        if (hipGetDevice(&dev) != hipSuccess || hipDeviceGetAttribute(&cus, hipDeviceAttributeMultiprocessorCount, dev) != hipSuccess) { grid = -1; return; }
        if (hipFuncSetAttribute((const void*)fwd, hipFuncAttributeMaxDynamicSharedMemorySize, LDS_BYTES) != hipSuccess) { fprintf(stderr, "kernel_launch: hipFuncSetAttribute failed\n"); grid = -1; return; }
        if (hipOccupancyMaxActiveBlocksPerMultiprocessor(&per_cu, (const void*)fwd, 512, LDS_BYTES) != hipSuccess || per_cu < 1)
            fprintf(stderr, "kernel_launch: note: occupancy query reports %d workgroups per CU\n", per_cu);
        (void)hipGetLastError();
        grid = cus;
    }
    if (grid < 0) return;
    if (hipMemsetAsync((char*)d_ws + WS_CTL, 0, CTL_BYTES, stream) != hipSuccess) return;
    Args a{};
    for (int i = 0; i < 25; ++i) a.in[i] = (const float*)d_in[i];
    a.out = (float*)d_out; a.ws = (unsigned char*)d_ws; a.pad = 0;
    const int NQ = 1 + NLAYER * NPH;
#if MK_SINGLE
    a.q_lo = 0; a.q_hi = NQ; a.single = 1;
    hipLaunchKernelGGL(fwd, dim3(grid), dim3(512), LDS_BYTES, stream, a);
#else
    for (int q = 0; q < NQ; ++q) { a.q_lo = q; a.q_hi = q + 1; a.single = 0;
        hipLaunchKernelGGL(fwd, dim3(grid), dim3(512), LDS_BYTES, stream, a); }
#endif
    const hipError_t le = hipPeekAtLastError();
    if (le != hipSuccess) fprintf(stderr, "kernel_launch: launch failed: %s\n", hipGetErrorName(le));
}
```

```cpp
#include <hip/hip_runtime.h>
#include <cstdio>
#include <cstdint>

#ifndef MK_SINGLE
#define MK_SINGLE 1
#endif

#define LAS __attribute__((address_space(3)))
#define GAS __attribute__((address_space(1)))
typedef unsigned short bf16_t;
typedef short bf16x8 __attribute__((ext_vector_type(8)));
typedef short s16x4 __attribute__((ext_vector_type(4)));
typedef float f32x4 __attribute__((ext_vector_type(4)));
typedef float f32x16 __attribute__((ext_vector_type(16)));
typedef unsigned u32x4 __attribute__((ext_vector_type(4)));
typedef unsigned u32x2 __attribute__((ext_vector_type(2)));

constexpr int DM = 2048, NB = 4, SEQ = 2048, NLAYER = 4, CTXL = 256;
constexpr int ML = NB * SEQ, MC = NB * CTXL, MT = ML + MC;
constexpr int NZB = 12288, NZ = 12544;
constexpr int ZC_CQ = 0, ZC_CKV = 512, ZC_GK = 1024, ZC_GV = 2048, ZC_GQ = 3072, ZC_GG = 4096, ZC_PIN = 5120, ZC_GATE = 6144;
constexpr int ZT_KR = 0, ZT_LR = 64;
constexpr int FF = 5632, NQKV = 3584;
constexpr int KPOS = CTXL + SEQ;
constexpr int NCH = KPOS / 64;
constexpr int NGU = NB * 4 * 2 * NCH;
constexpr float RMS_EPS = 1e-6f;
constexpr int IN_COLS = 12384;

constexpr size_t al256(size_t x) { return (x + 255) / 256 * 256; }
constexpr size_t WS_CTL = 0, CTL_BYTES = 1u << 20;
constexpr size_t W_IN = 0, W_QKV = W_IN + (size_t)NZ * DM * 2, W_P = W_QKV + (size_t)NQKV * 512 * 2, W_B = W_P + (size_t)1024 * 256 * 2,
                 W_O = W_B + (size_t)3 * 2048 * 1024 * 2, W_13 = W_O + (size_t)DM * DM * 2, W_2 = W_13 + (size_t)2 * FF * DM * 2, W_LAYER = W_2 + (size_t)DM * FF * 2;
constexpr size_t WS_W = WS_CTL + CTL_BYTES;
constexpr size_t WS_MODS = WS_W + NLAYER * W_LAYER;
constexpr size_t WS_X = al256(WS_MODS + (size_t)NLAYER * 5 * 12288 * 4);
constexpr size_t WS_H = WS_X + (size_t)MT * DM * 4;
constexpr size_t WS_Z = WS_H + (size_t)MT * DM * 2;
constexpr size_t WS_ZT = WS_Z + (size_t)MT * NZB * 2;
constexpr size_t WS_QKVR = WS_ZT + (size_t)MT * 256 * 4;
constexpr size_t WS_QF = WS_QKVR + (size_t)MT * NQKV * 2;
constexpr size_t WS_KF = WS_QF + (size_t)NB * 8 * KPOS * 192 * 2;
constexpr size_t WS_VF = WS_KF + (size_t)NB * 8 * KPOS * 192 * 2;
constexpr size_t WS_GQ = WS_VF + (size_t)NB * 8 * KPOS * 128 * 2;
constexpr size_t WS_GKT = WS_GQ + (size_t)NGU * 64 * 256 * 2;
constexpr size_t WS_GVT = WS_GKT + (size_t)NGU * 64 * 256 * 2;
constexpr size_t WS_GP = WS_GVT + (size_t)NGU * 64 * 256 * 2;
constexpr size_t WS_GD = WS_GP + (size_t)NGU * 64 * 64 * 2;
constexpr size_t WS_SN = WS_GD + (size_t)NGU * 256 * 4;
constexpr size_t WS_BR = WS_SN + (size_t)NGU * 65536 * 2;
constexpr size_t WS_POOLED = WS_BR + (size_t)3 * MT * 1024 * 2;
constexpr size_t WS_MERGED = WS_POOLED + (size_t)MT * 1024 * 2;
constexpr size_t WS_RSLAB = WS_MERGED + (size_t)MT * DM * 2;
constexpr size_t WS_MSLAB = WS_RSLAB + (size_t)8 * MC * DM * 4;
constexpr size_t WS_ROPE = WS_MSLAB + (size_t)6 * MC * DM * 4;
constexpr size_t WS_END = WS_ROPE + 96 * 16 * 2 * 4;
constexpr size_t WS_MP = WS_GQ, WS_ACT = WS_Z;
static_assert((size_t)MT * DM * 4 <= (size_t)2 * NGU * 64 * 256 * 2, "MP overlay fits");
static_assert((size_t)MT * FF * 2 <= (size_t)MT * NZB * 2, "ACT overlay fits");

constexpr int RING_BYTES = 131072;
constexpr int MISC_OFF = RING_BYTES;
constexpr int LDS_BYTES = 147456;

__device__ __forceinline__ unsigned cvt_pk_bf16(float lo, float hi) { unsigned r; asm("v_cvt_pk_bf16_f32 %0, %1, %2" : "=v"(r) : "v"(lo), "v"(hi)); return r; }
__device__ __forceinline__ float bf2f(unsigned short b) { return __uint_as_float(((unsigned)b) << 16); }
__device__ __forceinline__ float bflo(unsigned w) { return __uint_as_float(w << 16); }
__device__ __forceinline__ float bfhi(unsigned w) { return __uint_as_float(w & 0xffff0000u); }
__device__ __forceinline__ bf16_t f2bf(float f) { return (bf16_t)(cvt_pk_bf16(f, 0.f) & 0xffffu); }
__device__ __forceinline__ float wave_sum(float v) {
#pragma unroll
    for (int o = 1; o < 64; o <<= 1) v += __shfl_xor(v, o);
    return v;
}
__device__ __forceinline__ float fast_sigmoid(float x) { return __builtin_amdgcn_rcpf(1.0f + __builtin_amdgcn_exp2f(-1.4426950408889634f * x)); }
__device__ __forceinline__ float fast_silu(float x) { return x * fast_sigmoid(x); }
__device__ __forceinline__ void atomic_add_f32(float* p, float v) { (void)__builtin_amdgcn_global_atomic_fadd_f32((GAS float*)p, v); }
#define LDS_WAIT() asm volatile("s_waitcnt lgkmcnt(0)" ::: "memory")
#define VM_WAIT() asm volatile("s_waitcnt vmcnt(0)" ::: "memory")

#define XB_TMO      128
#define XB_XCNT(j)  (256  + 64 * (j))
#define XB_XSUB(j)  (1280 + 64 * (j))
#define XB_XGEN(j)  (2304 + 64 * (j))
#define XB_TOP      3328
#define XB_TOPGEN   3392
#define XCD_BAR_WORDS 3456
#define XB_SPIN_CAP (1u << 18)
__device__ __forceinline__ unsigned xb_ld(unsigned* p)              { return __hip_atomic_load(p, __ATOMIC_RELAXED, __HIP_MEMORY_SCOPE_AGENT); }
__device__ __forceinline__ unsigned xb_add(unsigned* p, unsigned v) { return __hip_atomic_fetch_add(p, v, __ATOMIC_RELAXED, __HIP_MEMORY_SCOPE_AGENT); }
__device__ __forceinline__ unsigned xb_xcc_id() { return (unsigned)__builtin_amdgcn_s_getreg((3 << 11) | 20) & 0xFu; }
#define XB_SPIN(cond, bar) do { unsigned _sp = 0; while (cond) { __builtin_amdgcn_s_sleep(1); \
    if ((++_sp & 255u) == 0u) { if (xb_ld(&(bar)[XB_TMO])) break; if (_sp > XB_SPIN_CAP) { atomicAdd(&(bar)[XB_TMO], 1u); break; } } } } while (0)
struct XcdBarrier { unsigned* bar; unsigned x; volatile LAS unsigned* st; };
__device__ __forceinline__ XcdBarrier xcd_barrier_post(unsigned* bar, volatile LAS unsigned* st) {
    XcdBarrier b; b.bar = bar; b.x = xb_xcc_id(); b.st = st;
    if (threadIdx.x == 0) (void)xb_add(&bar[XB_XCNT(b.x)], 1u);
    return b;
}
__device__ __forceinline__ void xcd_barrier_complete(unsigned* bar, unsigned x, unsigned& nloc, unsigned& nx) {
    const unsigned G = gridDim.x * gridDim.y * gridDim.z;
    unsigned sum, cnt, mine, sp = 0u;
    for (;;) {
        sum = 0u; cnt = 0u; mine = 0u;
#pragma unroll
        for (unsigned j = 0; j < 16; ++j) { const unsigned c = xb_ld(&bar[XB_XCNT(j)]); sum += c; cnt += (c > 0u) ? 1u : 0u; mine = (j == x) ? c : mine; }
        if (sum == G) break;
        __builtin_amdgcn_s_sleep(1);
        if ((++sp & 255u) == 0u) { if (xb_ld(&bar[XB_TMO])) break; if (sp > XB_SPIN_CAP) { atomicAdd(&bar[XB_TMO], 1u); break; } }
    }
    nloc = mine > 0u ? mine : 1u; nx = cnt > 0u ? cnt : 1u;
}
__device__ __forceinline__ void xcd_barrier(const XcdBarrier& b) {
    asm volatile("s_waitcnt vmcnt(0)" ::: "memory");
    __syncthreads();
    if (threadIdx.x == 0) {
        unsigned* bar = b.bar;
        __builtin_amdgcn_s_waitcnt(0);
        unsigned nloc = b.st[0], nx = b.st[1];
        if (nloc == 0u) { xcd_barrier_complete(bar, b.x, nloc, nx); b.st[0] = nloc; b.st[1] = nx; }
        const unsigned old = xb_add(&bar[XB_XSUB(b.x)], 1u);
        const unsigned gen = old / nloc;
        if (old + 1u == (gen + 1u) * nloc) {
            __builtin_amdgcn_fence(__ATOMIC_RELEASE, "agent");
            asm volatile("s_waitcnt vmcnt(0)" ::: "memory");
            const unsigned og = xb_add(&bar[XB_TOP], 1u);
            const unsigned tg = og / nx;
            if (og + 1u == (tg + 1u) * nx) xb_add(&bar[XB_TOPGEN], 1u);
            else XB_SPIN(xb_ld(&bar[XB_TOPGEN]) == tg, bar);
            __builtin_amdgcn_fence(__ATOMIC_ACQUIRE, "agent");
            xb_add(&bar[XB_XGEN(b.x)], 1u);
            asm volatile("s_waitcnt vmcnt(0)" ::: "memory");
        } else {
            XB_SPIN(xb_ld(&bar[XB_XGEN(b.x)]) == gen, bar);
            __builtin_amdgcn_fence(__ATOMIC_ACQUIRE, "agent");
            asm volatile("s_waitcnt vmcnt(0)" ::: "memory");
        }
    }
    __syncthreads();
}

namespace pg8 {
constexpr int BM = 256, BK = 64, HALF = 128, HTB = HALF * BK * 2, STAGE_BYTES = 8 * HTB, NXCD = 8, WGM = 8;
__host__ __device__ __forceinline__ int lds_byte(int r, int c) { const int st = (r >> 4) * 2 + (c >> 5), rr = r & 15, cc = c & 31, ob = rr * 64 + cc * 2; return st * 1024 + (ob ^ (((ob >> 9) & 1) << 5)); }
__host__ __device__ __forceinline__ void stage_rc(int b, int& R, int& C) { const int st = b / 1024, sb = b % 1024, swz = sb ^ (((sb >> 9) & 1) << 5); R = (st >> 1) * 16 + swz / 64; C = (st & 1) * 32 + (swz % 64) / 2; }
__host__ __device__ __forceinline__ int perm32(int rho) { const int n = rho >> 4, i = rho & 15; return 8 * (i >> 2) + 4 * n + (i & 3); }

struct Unit { int pm, pn, ka, kb, nt, fl; };
struct Gemm { const bf16_t* A; const bf16_t* Bt; int lda, K; };

__device__ __forceinline__ void tile_of(int L, int nM, int nN, int& pm, int& pn) {
    const int nwg = nM * nN; int wgid = L;
    { const int q = nwg / NXCD, r = nwg % NXCD, xcd = wgid % NXCD, off = wgid / NXCD; wgid = (xcd < r ? xcd * (q + 1) : r * (q + 1) + (xcd - r) * q) + off; }
    const int nig = WGM * nN, gid = wgid / nig, fm = gid * WGM, gsz = (nM - fm) < WGM ? (nM - fm) : WGM;
    pm = fm + ((wgid % nig) % gsz); pn = (wgid % nig) / gsz;
}
struct SchedPlain {
    int nM, nN, G, c, mode, nt;
    __device__ __forceinline__ bool next(int i, Unit& u) const {
        const int L = i * G + c; if (L >= nM * nN) return false;
        tile_of(L, nM, nN, u.pm, u.pn);
        u.ka = (mode == 1) ? (u.pn < 6 ? ZC_CQ : ZC_CKV) : (mode == 2 ? 256 * u.pn : 0);
        u.kb = 0; u.nt = nt; u.fl = 0;
        return true;
    }
    __device__ __forceinline__ void a_ready(const Unit&) const {}
    __device__ __forceinline__ void done(const Unit&) const {}
};
struct SchedTail {
    int G, c, ntf; bool ctx;
    __device__ __forceinline__ bool next(int i, Unit& u) const {
        const bool fast = (G == 256), sub = fast && (i == 1);
        const int nM = fast ? 32 : (ctx ? 36 : 32), L = fast ? c : i * G + c;
        const bool ok = fast ? (i == 0 || (i == 1 && ctx)) : (L < nM * 8);
        int pm, pn; tile_of(ok ? L : 0, nM, 8, pm, pn);
        const int tile = c >> 3, j = c & 7, base = ntf >> 3, odd = base & 1;
        const int snt = odd ? (j < 4 ? base + 1 : base - 1) : base;
        const int skt = odd ? (j < 4 ? j * (base + 1) : 4 * (base + 1) + (j - 4) * (base - 1)) : j * base;
        Unit r; r.pm = sub ? 32 + (tile >> 3) : pm; r.pn = sub ? (tile & 7) : pn; r.ka = 0; r.kb = sub ? 64 * skt : 0; r.nt = sub ? snt : ntf; r.fl = sub ? 1 + j : 0;
        u = r; return ok;
    }
    __device__ __forceinline__ void a_ready(const Unit&) const {}
    __device__ __forceinline__ void done(const Unit&) const {}
};
struct SchedMerge {
    int G, c; bool ctx;
    __device__ __forceinline__ bool next(int i, Unit& u) const {
        const bool fast = (G == 256), sub = fast && (i == 3);
        const int nM = fast ? 32 : (ctx ? 36 : 32), T = fast ? c : (i / 3) * G + c;
        const bool ok = fast ? (i < 3 || (i == 3 && ctx && c < 192)) : (T < nM * 8);
        int pm, pn; tile_of(ok ? T : 0, nM, 8, pm, pn);
        const int tile = c / 6, rr = c - 6 * tile, sseg = rr >> 1, half = rr & 1;
        const int seg = sub ? sseg : (i % 3);
        Unit r; r.pm = seg * 36 + (sub ? 32 + (tile >> 3) : pm); r.pn = seg * 8 + (sub ? (tile & 7) : pn); r.ka = 0; r.kb = sub ? half * 512 : 0; r.nt = sub ? 8 : 16; r.fl = sub ? (4 | seg | (half << 3)) : seg;
        u = r; return ok;
    }
    __device__ __forceinline__ void a_ready(const Unit&) const {}
    __device__ __forceinline__ void done(const Unit&) const {}
};

struct EpiZ {
    static constexpr bool PERM = true, AFTER_DRAIN = false;
    __device__ __forceinline__ bool keep(const Unit&) const { return false; }
    bf16_t* Z; float* ZT;
    __device__ __forceinline__ void operator()(const f32x4 (&acc)[2][2][4][2], const Unit& u, int wr, int wc, int fr, int fq) const {
        const int row0 = u.pm * BM + wr * 64 + fr, cw = wc * 32 + 8 * fq;
        if (u.pn < 48) {
#pragma unroll
            for (int ai = 0; ai < 2; ++ai)
#pragma unroll
                for (int m = 0; m < 4; ++m) { bf16_t* rowp = Z + (size_t)(row0 + ai * HALF + m * 16) * NZB + u.pn * BM + cw;
#pragma unroll
                    for (int bj = 0; bj < 2; ++bj) { f32x4 v0 = acc[ai][bj][m][0], v1 = acc[ai][bj][m][1];
                        if (u.pn >= ZC_GATE / BM) {
#pragma unroll
                            for (int j = 0; j < 4; ++j) { v0[j] = fast_sigmoid(v0[j]); v1[j] = fast_sigmoid(v1[j]); } }
                        u32x4 w; w.x = cvt_pk_bf16(v0[0], v0[1]); w.y = cvt_pk_bf16(v0[2], v0[3]); w.z = cvt_pk_bf16(v1[0], v1[1]); w.w = cvt_pk_bf16(v1[2], v1[3]);
                        *(u32x4*)(rowp + bj * HALF) = w; } }
        } else {
#pragma unroll
            for (int ai = 0; ai < 2; ++ai)
#pragma unroll
                for (int m = 0; m < 4; ++m) { float* rowp = ZT + (size_t)(row0 + ai * HALF + m * 16) * 256 + cw;
#pragma unroll
                    for (int bj = 0; bj < 2; ++bj) { *(f32x4*)(rowp + bj * HALF) = acc[ai][bj][m][0]; *(f32x4*)(rowp + bj * HALF + 4) = acc[ai][bj][m][1]; } }
        }
    }
};
struct EpiBf16 {
    static constexpr bool PERM = true, AFTER_DRAIN = false;
    __device__ __forceinline__ bool keep(const Unit&) const { return false; }
    bf16_t* O; int ldc;
    __device__ __forceinline__ void operator()(const f32x4 (&acc)[2][2][4][2], const Unit& u, int wr, int wc, int fr, int fq) const {
        const int row0 = u.pm * BM + wr * 64 + fr, col0 = u.pn * BM + wc * 32 + 8 * fq;
#pragma unroll
        for (int ai = 0; ai < 2; ++ai)
#pragma unroll
            for (int m = 0; m < 4; ++m) { bf16_t* rowp = O + (size_t)(row0 + ai * HALF + m * 16) * ldc + col0;
#pragma unroll
                for (int bj = 0; bj < 2; ++bj) { const f32x4 v0 = acc[ai][bj][m][0], v1 = acc[ai][bj][m][1];
                    u32x4 w; w.x = cvt_pk_bf16(v0[0], v0[1]); w.y = cvt_pk_bf16(v0[2], v0[3]); w.z = cvt_pk_bf16(v1[0], v1[1]); w.w = cvt_pk_bf16(v1[2], v1[3]);
                    *(u32x4*)(rowp + bj * HALF) = w; } }
    }
};
struct EpiSwiGLU {
    static constexpr bool PERM = true, AFTER_DRAIN = false;
    __device__ __forceinline__ bool keep(const Unit&) const { return false; }
    bf16_t* ACT;
    __device__ __forceinline__ void operator()(const f32x4 (&acc)[2][2][4][2], const Unit& u, int wr, int wc, int fr, int fq) const {
        const int row0 = u.pm * BM + wr * 64 + fr, col0 = u.pn * HALF + wc * 32 + 8 * fq;
#pragma unroll
        for (int ai = 0; ai < 2; ++ai)
#pragma unroll
            for (int m = 0; m < 4; ++m) {
                float o[8];
#pragma unroll
                for (int n = 0; n < 2; ++n)
#pragma unroll
                    for (int j = 0; j < 4; ++j) o[4 * n + j] = fast_silu(acc[ai][0][m][n][j]) * acc[ai][1][m][n][j];
                u32x4 w; w.x = cvt_pk_bf16(o[0], o[1]); w.y = cvt_pk_bf16(o[2], o[3]); w.z = cvt_pk_bf16(o[4], o[5]); w.w = cvt_pk_bf16(o[6], o[7]);
                *(u32x4*)(ACT + (size_t)(row0 + ai * HALF + m * 16) * FF + col0) = w; }
    }
};
struct EpiResid {
    static constexpr bool PERM = true, AFTER_DRAIN = false;
    __device__ __forceinline__ bool keep(const Unit&) const { return false; }
    float* X; float* OUT; const float* gate; float* SLAB; const float* XS;
    __device__ __forceinline__ void operator()(const f32x4 (&acc)[2][2][4][2], const Unit& u, int wr, int wc, int fr, int fq) const {
        const int row0 = u.pm * BM + wr * 64 + fr, col0 = u.pn * BM + wc * 32 + 8 * fq;
        const int mr = u.pm < 32 ? (u.pm >> 3) : 4;
        const float* gp = gate + (size_t)mr * 12288 + col0;
        float* dst = (OUT != nullptr && u.pm < 32) ? OUT : X;
        f32x4 g[2][2];
#pragma unroll
        for (int bj = 0; bj < 2; ++bj)
#pragma unroll
            for (int n = 0; n < 2; ++n) g[bj][n] = *(const f32x4*)(gp + bj * HALF + 4 * n);
        if (u.fl) {
            float* sl = SLAB + (size_t)(u.fl - 1) * MC * DM;
#pragma unroll
            for (int ai = 0; ai < 2; ++ai)
#pragma unroll
                for (int m = 0; m < 4; ++m) { float* xp = sl + (size_t)(row0 - ML + ai * HALF + m * 16) * DM + col0;
#pragma unroll
                    for (int bj = 0; bj < 2; ++bj)
#pragma unroll
                        for (int n = 0; n < 2; ++n) *(f32x4*)(xp + bj * HALF + 4 * n) = g[bj][n] * acc[ai][bj][m][n]; }
            return;
        }
#pragma unroll
        for (int ai = 0; ai < 2; ++ai)
#pragma unroll
            for (int m = 0; m < 4; ++m) { const size_t off = (size_t)(row0 + ai * HALF + m * 16) * DM + col0;
#pragma unroll
                for (int bj = 0; bj < 2; ++bj)
#pragma unroll
                    for (int n = 0; n < 2; ++n) { const f32x4 x = *(const f32x4*)(XS + off + bj * HALF + 4 * n);
                        *(f32x4*)(dst + off + bj * HALF + 4 * n) = x + g[bj][n] * acc[ai][bj][m][n]; } }
    }
};
struct EpiMerge {
    static constexpr bool PERM = true, AFTER_DRAIN = false;
    const bf16_t* Z; bf16_t* MERGED; float* MSLAB;
    __device__ __forceinline__ bool keep(const Unit& u) const { return u.fl < 2; }
    __device__ __forceinline__ void operator()(f32x4 (&acc)[2][2][4][2], const Unit& u, int wr, int wc, int fr, int fq) const {
        const int seg = u.fl & 3, pm = u.pm - seg * 36, pn = u.pn - seg * 8; const bool sub = (u.fl & 4) != 0;
        const int row0 = pm * BM + wr * 64 + fr, col0 = pn * BM + wc * 32 + 8 * fq;
#pragma unroll
        for (int ai = 0; ai < 2; ++ai)
#pragma unroll
            for (int m = 0; m < 4; ++m) { const int row = row0 + ai * HALF + m * 16;
#pragma unroll
                for (int bj = 0; bj < 2; ++bj) {
                    const bf16_t* gp = Z + (size_t)row * NZB + ZC_GATE + seg * DM + col0 + bj * HALF;
                    const u32x4 gw = *(const u32x4*)gp;
                    const unsigned gv[4] = {gw.x, gw.y, gw.z, gw.w};
                    float f[8];
#pragma unroll
                    for (int j = 0; j < 4; ++j) { f[2 * j] = bflo(gv[j]); f[2 * j + 1] = bfhi(gv[j]); }
                    if (seg < 2 && !sub) {
                        const u32x4 hw = *(const u32x4*)(gp + DM); const unsigned hv[4] = {hw.x, hw.y, hw.z, hw.w};
#pragma unroll
                        for (int j = 0; j < 4; ++j) { f[2 * j] *= __builtin_amdgcn_rcpf(bflo(hv[j])); f[2 * j + 1] *= __builtin_amdgcn_rcpf(bfhi(hv[j])); }
                    }
                    f32x4 v0 = acc[ai][bj][m][0], v1 = acc[ai][bj][m][1];
#pragma unroll
                    for (int j = 0; j < 4; ++j) { v0[j] *= f[j]; v1[j] *= f[4 + j]; }
                    if (sub) { float* sp = MSLAB + ((size_t)(seg * 2 + ((u.fl >> 3) & 1)) * MC + (row - ML)) * DM + col0 + bj * HALF;
                        *(f32x4*)sp = v0; *(f32x4*)(sp + 4) = v1; }
                    else if (seg < 2) { acc[ai][bj][m][0] = v0; acc[ai][bj][m][1] = v1; }
                    else { u32x4 w; w.x = cvt_pk_bf16(v0[0], v0[1]); w.y = cvt_pk_bf16(v0[2], v0[3]); w.z = cvt_pk_bf16(v1[0], v1[1]); w.w = cvt_pk_bf16(v1[2], v1[3]);
                        *(u32x4*)(MERGED + (size_t)row * DM + col0 + bj * HALF) = w; } } }
    }
};

template <class Epi, class Sched, bool ALIGN_EPI = true>
__device__ __forceinline__ void gemm_phase(LAS unsigned char* lds, const Gemm g, const Sched& S, const Epi& E) {
    int tid = threadIdx.x; asm volatile("" : "+v"(tid));
    const int wid = __builtin_amdgcn_readfirstlane(tid >> 6), lane = tid & 63, wr = wid >> 2, wc = wid & 3, fr = lane & 15, fq = lane >> 4;
    int K = g.K, lda = g.lda; asm volatile("" : "+s"(K), "+s"(lda));
    unsigned voffA[2], voffB[2];
#pragma unroll
    for (int i = 0; i < 2; ++i) { int R, C; stage_rc(tid * 16 + i * 8192, R, C); const int Rb = Epi::PERM ? ((R & ~31) + perm32(R & 31)) : R;
        voffA[i] = (unsigned)(R * lda + C) * 2u; voffB[i] = (unsigned)(Rb * K + C) * 2u; }
    const size_t kstep = (size_t)(BK * 2);
    const size_t hstepA = (size_t)HALF * lda * 2, hstepB = (size_t)HALF * K * 2;
    const size_t tstepA = 2 * hstepA, tstepB = 2 * hstepB;
    const unsigned ldsw = (unsigned)wid * 1024u;
    const int aoff = lds_byte(wr * 64 + fr, fq * 8), boff = lds_byte(wc * 32 + fr, fq * 8);
#define PG8_SA(b, h) (((b) * 2 + (h)) * HTB)
#define PG8_SB(b, h) ((4 + (b) * 2 + (h)) * HTB)
#define PG8_STAGE(bufoff, gbase, voff) do { _Pragma("unroll") for (int _i = 0; _i < 2; ++_i) \
        __builtin_amdgcn_global_load_lds((const unsigned*)((const char*)(gbase) + (voff)[_i]), (LAS unsigned*)(lds + (bufoff) + ldsw + _i * 8192), 16, 0, 0); } while (0)
#define PG8_LDA(dst, b, h) do { _Pragma("unroll") for (int m = 0; m < 4; ++m) _Pragma("unroll") for (int k = 0; k < 2; ++k) dst[m][k] = *(const LAS bf16x8*)(lds + PG8_SA(b, h) + aoff + m * 2048 + k * 1024); } while (0)
#define PG8_LDB(dst, b, h) do { _Pragma("unroll") for (int n = 0; n < 2; ++n) _Pragma("unroll") for (int k = 0; k < 2; ++k) dst[n][k] = *(const LAS bf16x8*)(lds + PG8_SB(b, h) + boff + n * 2048 + k * 1024); } while (0)
#define PG8_MMA(ai, bj, At, Bt) do { __builtin_amdgcn_s_setprio(1); _Pragma("unroll") for (int m = 0; m < 4; ++m) _Pragma("unroll") for (int n = 0; n < 2; ++n) _Pragma("unroll") for (int k = 0; k < 2; ++k) \
        acc[ai][bj][m][n] = __builtin_amdgcn_mfma_f32_16x16x32_bf16(Bt[n][k], At[m][k], acc[ai][bj][m][n], 0, 0, 0); __builtin_amdgcn_s_setprio(0); } while (0)
#define PG8_WAIT_V(n) asm volatile("s_waitcnt vmcnt(" #n ")" ::: "memory")
#define PG8_WAIT_L(n) asm volatile("s_waitcnt lgkmcnt(" #n ")" ::: "memory")
#define PG8_BAR __builtin_amdgcn_s_barrier()
#define PG8_SCHED __builtin_amdgcn_sched_barrier(0)
    Unit cur, nxt; int ui = 0;
    if (!S.next(0, cur)) return;
    f32x4 acc[2][2][4][2];
#pragma unroll
    for (int a = 0; a < 2; ++a)
#pragma unroll
        for (int b = 0; b < 2; ++b)
#pragma unroll
            for (int m = 0; m < 4; ++m)
#pragma unroll
                for (int n = 0; n < 2; ++n) acc[a][b][m][n] = (f32x4){0.f, 0.f, 0.f, 0.f};
    bf16x8 At[4][2], B0[2][2], B1[2][2];
    const char* cA = (const char*)g.A + (size_t)cur.pm * tstepA + (size_t)(cur.ka + cur.kb) * 2; const char* cB = (const char*)g.Bt + (size_t)cur.pn * tstepB + (size_t)cur.kb * 2;
    S.a_ready(cur);
    PG8_STAGE(PG8_SB(0, 0), cB, voffB); PG8_STAGE(PG8_SB(0, 1), cB + hstepB, voffB); PG8_STAGE(PG8_SA(0, 0), cA, voffA); PG8_STAGE(PG8_SA(0, 1), cA + hstepA, voffA);
    if (wr == 1) PG8_BAR;
    PG8_WAIT_V(2); PG8_BAR;
    PG8_STAGE(PG8_SB(1, 0), cB + kstep, voffB); PG8_STAGE(PG8_SA(1, 0), cA + kstep, voffA); PG8_STAGE(PG8_SB(1, 1), cB + hstepB + kstep, voffB);
    PG8_WAIT_V(6); PG8_BAR;
    for (;;) {
        const bool has_next = S.next(ui + 1, nxt);
        const char* nA = has_next ? (const char*)g.A + (size_t)nxt.pm * tstepA + (size_t)(nxt.ka + nxt.kb) * 2 : cA; const char* nB = has_next ? (const char*)g.Bt + (size_t)nxt.pn * tstepB + (size_t)nxt.kb * 2 : cB;
        const int nt = cur.nt;
        for (int t = 0; t < nt; t += 2) {
            const bool last = (t == nt - 2);
            const char* a1 = cA + (size_t)(t + 1) * kstep;
            const char* a2 = last ? nA : cA + (size_t)(t + 2) * kstep; const char* b2 = last ? nB : cB + (size_t)(t + 2) * kstep;
            const char* a3 = a2 + kstep; const char* b3 = b2 + kstep;
            if (last && has_next) S.a_ready(nxt);
            PG8_LDB(B0, 0, 0); PG8_LDB(B1, 0, 1); PG8_SCHED; PG8_LDA(At, 0, 0); PG8_STAGE(PG8_SA(1, 1), a1 + hstepA, voffA);
            PG8_WAIT_V(8); PG8_WAIT_L(0); PG8_BAR; PG8_MMA(0, 0, At, B0); PG8_MMA(0, 1, At, B1); PG8_BAR; PG8_SCHED;
            PG8_LDA(At, 0, 1); PG8_STAGE(PG8_SB(0, 0), b2, voffB); PG8_STAGE(PG8_SB(0, 1), b2 + hstepB, voffB); PG8_STAGE(PG8_SA(0, 0), a2, voffA);
            PG8_WAIT_V(8); PG8_WAIT_L(0); PG8_BAR; PG8_MMA(1, 0, At, B0); PG8_MMA(1, 1, At, B1); PG8_BAR; PG8_SCHED;
            PG8_LDB(B0, 1, 0); PG8_LDB(B1, 1, 1); PG8_SCHED; PG8_LDA(At, 1, 0); PG8_STAGE(PG8_SA(0, 1), a2 + hstepA, voffA);
            PG8_WAIT_V(8); PG8_WAIT_L(0); PG8_BAR; PG8_MMA(0, 0, At, B0); PG8_MMA(0, 1, At, B1); PG8_BAR; PG8_SCHED;
            PG8_LDA(At, 1, 1); PG8_STAGE(PG8_SB(1, 0), b3, voffB); PG8_STAGE(PG8_SB(1, 1), b3 + hstepB, voffB); PG8_STAGE(PG8_SA(1, 0), a3, voffA);
            PG8_WAIT_V(8); PG8_WAIT_L(0); PG8_BAR; PG8_MMA(1, 0, At, B0); PG8_MMA(1, 1, At, B1); PG8_BAR; PG8_SCHED;
        }
        if constexpr (ALIGN_EPI) { if (wr == 0) PG8_BAR; }
        E(acc, cur, wr, wc, fr, fq); S.done(cur);
        if (!has_next) break;
        if (!E.keep(cur))
#pragma unroll
        for (int a = 0; a < 2; ++a)
#pragma unroll
            for (int b = 0; b < 2; ++b)
#pragma unroll
                for (int m = 0; m < 4; ++m)
#pragma unroll
                    for (int n = 0; n < 2; ++n) acc[a][b][m][n] = (f32x4){0.f, 0.f, 0.f, 0.f};
        cur = nxt; cA = nA; cB = nB; ++ui;
        if constexpr (ALIGN_EPI) { if (wr == 1) PG8_BAR; }
    }
    PG8_WAIT_V(0);
    if constexpr (!ALIGN_EPI) { if (wr == 0) PG8_BAR; }
    PG8_BAR;
#undef PG8_SA
#undef PG8_SB
#undef PG8_STAGE
#undef PG8_LDA
#undef PG8_LDB
#undef PG8_MMA
#undef PG8_WAIT_V
#undef PG8_WAIT_L
#undef PG8_BAR
#undef PG8_SCHED
}
}

namespace att {
constexpr int DQ = 192, DV = 128, NW = 8, QBLK = 32, KVBLK = 64;
constexpr float SCALE = 0.07216878364870322f;
constexpr float THR = 8.f;
constexpr int SHM_V = KVBLK * DV * 2, SHM_K = KVBLK * 400, SHM_ATTN = 2 * SHM_V + 2 * SHM_K + NW * 64 * 4;
#define KSWZ(row, colB) ((row) * 400 + (colB))
#define SBAR() __builtin_amdgcn_sched_barrier(0)
__device__ __forceinline__ int crow(int r, int hi) { return (r & 3) + 8 * (r >> 2) + 4 * hi; }
__device__ __forceinline__ unsigned cvtpk(float lo, float hi) { unsigned r; asm volatile("v_cvt_pk_bf16_f32 %0, %1, %2" : "=v"(r) : "v"(lo), "v"(hi)); return r; }
__device__ __forceinline__ void partialSM(f32x16& p0, f32x16& p1, float& m_reg, float& mn, float& alpha) {
    constexpr float C = SCALE * 1.4426950408889634f;
    float pmax = p0[0];
#pragma unroll
    for (int r = 1; r < 16; ++r) pmax = fmaxf(pmax, p0[r]);
#pragma unroll
    for (int r = 0; r < 16; ++r) pmax = fmaxf(pmax, p1[r]);
    { auto rr = __builtin_amdgcn_permlane32_swap(__float_as_uint(pmax), __float_as_uint(pmax), false, false);
      pmax = fmaxf(__uint_as_float(rr[0]), __uint_as_float(rr[1])); }
    if (__builtin_expect(__all(pmax - m_reg <= THR / SCALE), 1)) { mn = m_reg; alpha = 1.f; }
    else { mn = fmaxf(m_reg, pmax); alpha = __builtin_amdgcn_exp2f((m_reg - mn) * C); m_reg = mn; }
    const float mnC = -mn * C;
#pragma unroll
    for (int r = 0; r < 16; ++r) p0[r] = fmaf(p0[r], C, mnC);
#pragma unroll
    for (int r = 0; r < 16; ++r) p1[r] = fmaf(p1[r], C, mnC);
#pragma unroll
    for (int r = 0; r < 16; ++r) p0[r] = __builtin_amdgcn_exp2f(p0[r]);
}
__device__ __forceinline__ void finishSM(f32x16& p0, f32x16& p1, float alpha, float& l_reg, bf16x8& pa0, bf16x8& pa1, bf16x8& pa2, bf16x8& pa3) {
#pragma unroll
    for (int r = 0; r < 16; ++r) p1[r] = __builtin_amdgcn_exp2f(p1[r]);
    float ps = 0;
#pragma unroll
    for (int r = 0; r < 16; ++r) ps += p0[r];
#pragma unroll
    for (int r = 0; r < 16; ++r) ps += p1[r];
    { auto rr = __builtin_amdgcn_permlane32_swap(__float_as_uint(ps), __float_as_uint(ps), false, false);
      ps = __uint_as_float(rr[0]) + __uint_as_float(rr[1]); }
    l_reg = l_reg * alpha + ps;
#define PK4(P, BASE, OUT) do { unsigned a0 = cvtpk(P[BASE + 0], P[BASE + 1]), a1 = cvtpk(P[BASE + 2], P[BASE + 3]);   \
    unsigned b0 = cvtpk(P[BASE + 4], P[BASE + 5]), b1 = cvtpk(P[BASE + 6], P[BASE + 7]);                              \
    auto r0 = __builtin_amdgcn_permlane32_swap(a0, b0, false, false); auto r1 = __builtin_amdgcn_permlane32_swap(a1, b1, false, false); \
    u32x4 w = {r0[0], r1[0], r0[1], r1[1]}; OUT = *reinterpret_cast<bf16x8*>(&w); } while (0)
    PK4(p0, 0, pa0); PK4(p0, 8, pa1); PK4(p1, 0, pa2); PK4(p1, 8, pa3);
#undef PK4
}
__device__ __forceinline__ void qkt(f32x16& p0, f32x16& p1, const char* Ks, const bf16x8* qr, int r32, int hi) {
    p0 = f32x16{}; p1 = f32x16{};
#pragma unroll
    for (int d0 = 0; d0 < DQ / 16; ++d0) { const int cb = (d0 * 16 + hi * 8) * 2;
        const bf16x8 b0 = *reinterpret_cast<const bf16x8*>(Ks + KSWZ(r32, cb));
        const bf16x8 b1 = *reinterpret_cast<const bf16x8*>(Ks + KSWZ(32 + r32, cb));
        p0 = __builtin_amdgcn_mfma_f32_32x32x16_bf16(b0, qr[d0], p0, 0, 0, 0);
        p1 = __builtin_amdgcn_mfma_f32_32x32x16_bf16(b1, qr[d0], p1, 0, 0, 0); }
}
__device__ __forceinline__ int v_st(int k, int c) { const int kk = (k & ~0xC) | ((k & 4) << 1) | ((k & 8) >> 1); return ((kk >> 3) * 4 + (c >> 5)) * 512 + ((kk & 7) * 32 + (c & 31)) * 2; }
__device__ __forceinline__ int v_rd_base(int lane) { return ((lane & 3) << 3) | (((lane >> 2) & 3) << 6) | (((lane >> 4) & 1) << 5) | (((lane >> 5) & 1) << 8); }
constexpr int v_rd_off(int d0, int ks, int half) { return d0 * 512 + ks * 4096 + half * 2048; }
template <int OFF> __device__ __forceinline__ s16x4 tr_read(int vb) {
    s16x4 r; asm volatile("ds_read_b64_tr_b16 %0, %1 offset:%2" : "=&v"(r) : "v"(vb), "i"(OFF) : "memory"); return r;
}
template <int D0> __device__ __forceinline__ void pv_one(f32x16& od, int vb, bf16x8 pa0, bf16x8 pa1, bf16x8 pa2, bf16x8 pa3) {
    const s16x4 l0 = tr_read<v_rd_off(D0, 0, 0)>(vb), h0 = tr_read<v_rd_off(D0, 0, 1)>(vb), l1 = tr_read<v_rd_off(D0, 1, 0)>(vb), h1 = tr_read<v_rd_off(D0, 1, 1)>(vb);
    const s16x4 l2 = tr_read<v_rd_off(D0, 2, 0)>(vb), h2 = tr_read<v_rd_off(D0, 2, 1)>(vb), l3 = tr_read<v_rd_off(D0, 3, 0)>(vb), h3 = tr_read<v_rd_off(D0, 3, 1)>(vb);
    asm volatile("s_waitcnt lgkmcnt(0)" ::: "memory"); SBAR();
#define PK(L, H) (bf16x8){L[0], L[1], L[2], L[3], H[0], H[1], H[2], H[3]}
    od = __builtin_amdgcn_mfma_f32_32x32x16_bf16(pa0, PK(l0, h0), od, 0, 0, 0);
    od = __builtin_amdgcn_mfma_f32_32x32x16_bf16(pa1, PK(l1, h1), od, 0, 0, 0);
    od = __builtin_amdgcn_mfma_f32_32x32x16_bf16(pa2, PK(l2, h2), od, 0, 0, 0);
    od = __builtin_amdgcn_mfma_f32_32x32x16_bf16(pa3, PK(l3, h3), od, 0, 0, 0);
#undef PK
}
__device__ __forceinline__ void pv_d0(f32x16* o, int vb, bf16x8 pa0, bf16x8 pa1, bf16x8 pa2, bf16x8 pa3) {
    pv_one<0>(o[0], vb, pa0, pa1, pa2, pa3); pv_one<1>(o[1], vb, pa0, pa1, pa2, pa3); pv_one<2>(o[2], vb, pa0, pa1, pa2, pa3); pv_one<3>(o[3], vb, pa0, pa1, pa2, pa3);
}
__device__ __forceinline__ void attn_body(const bf16_t* __restrict__ Qb, const bf16_t* __restrict__ Kh, const bf16_t* __restrict__ Vh, bf16_t* __restrict__ Ob, int ldo, int seq, char* lds) {
    int tid = threadIdx.x; asm volatile("" : "+v"(tid));
    const int wid = tid >> 6, lane = tid & 63, r32 = lane & 31, hi = lane >> 5;
    char* V_lds = lds; char* K_lds = lds + 2 * SHM_V;
    float* ws = (float*)(lds + 2 * SHM_V + 2 * SHM_K) + wid * 64; float* li_l = ws; float* al_l = ws + 32;
    float m_reg = -1e30f, l_reg = 0; f32x16 o[4] = {}; bf16x8 qr[DQ / 16];
    const bf16_t* Qw = Qb + (size_t)(wid * QBLK + r32) * DQ + hi * 8;
#pragma unroll
    for (int d0 = 0; d0 < DQ / 16; ++d0) qr[d0] = *reinterpret_cast<const bf16x8*>(Qw + d0 * 16);
    const int sr = tid >> 4, sc = (tid & 15) * 8, vst0 = v_st(sr, sc), vst1 = v_st(32 + sr, sc);
    const int krow = tid >> 3, kseg = (tid & 7) * 16;
    const int kgo = krow * 384 + kseg, klo = krow * 400 + kseg;
    const int vb0 = (int)(uintptr_t)V_lds + v_rd_base(lane);
    bf16x8 vs0, vs1, ks0, ks1, ks2;
#define SLOAD(k0) do { vs0 = *reinterpret_cast<const bf16x8*>(&Vh[(size_t)((k0) + sr) * DV + sc]); vs1 = *reinterpret_cast<const bf16x8*>(&Vh[(size_t)((k0) + 32 + sr) * DV + sc]); \
    { const char* kp_ = (const char*)Kh + (size_t)(k0) * 384 + kgo; ks0 = *reinterpret_cast<const bf16x8*>(kp_); ks1 = *reinterpret_cast<const bf16x8*>(kp_ + 128); ks2 = *reinterpret_cast<const bf16x8*>(kp_ + 256); } } while (0)
#define SWRITE(b) do { *(bf16x8*)(V_lds + (b) * SHM_V + vst0) = vs0; *(bf16x8*)(V_lds + (b) * SHM_V + vst1) = vs1; \
    *(bf16x8*)(K_lds + (b) * SHM_K + klo) = ks0; *(bf16x8*)(K_lds + (b) * SHM_K + klo + 128) = ks1; *(bf16x8*)(K_lds + (b) * SHM_K + klo + 256) = ks2; } while (0)
#define SWAIT() asm volatile("s_waitcnt vmcnt(0)" ::: "memory")
#define RESC(a) do { if (__any((a) < 1.f)) { if (hi == 0) al_l[r32] = (a); asm volatile("s_waitcnt lgkmcnt(0)" ::: "memory"); \
    _Pragma("unroll") for (int d = 0; d < 4; ++d) _Pragma("unroll") for (int r = 0; r < 16; ++r) o[d][r] *= al_l[crow(r, hi)]; } } while (0)
    f32x16 p0, p1; float mn, al; bf16x8 pa0, pa1, pa2, pa3; const int NT = seq / KVBLK;
    const bool grpB = wid >= 4;
#define DO_QK(b) do { SBAR(); qkt(p0, p1, K_lds + (b) * SHM_K, qr, r32, hi); SBAR(); } while (0)
#define DO_SMPV(b) do { partialSM(p0, p1, m_reg, mn, al); RESC(al); finishSM(p0, p1, al, l_reg, pa0, pa1, pa2, pa3); SBAR(); pv_d0(o, vb0 + (b) * SHM_V, pa0, pa1, pa2, pa3); } while (0)
    SLOAD(0); SWAIT(); SWRITE(0);
    if (NT > 1) SLOAD(KVBLK);
    __syncthreads();
#pragma unroll 1
    for (int j = 0; j < NT; ++j) {
        const int bsel = j & 1;
        if (!grpB) DO_QK(bsel); else if (j > 0) DO_SMPV(bsel ^ 1);
        __syncthreads();
        if (j + 1 < NT) { SWAIT(); SWRITE(bsel ^ 1); if (j + 2 < NT) SLOAD((j + 2) * KVBLK); }
        if (!grpB) DO_SMPV(bsel); else DO_QK(bsel);
        __syncthreads();
    }
    if (grpB) DO_SMPV((NT - 1) & 1);
#undef DO_QK
#undef DO_SMPV
    if (hi == 0) li_l[r32] = l_reg; asm volatile("s_waitcnt lgkmcnt(0)" ::: "memory");
    float rli[16];
#pragma unroll
    for (int r = 0; r < 16; ++r) rli[r] = __builtin_amdgcn_rcpf(li_l[crow(r, hi)]);
    bf16_t* Ow = Ob + (size_t)(wid * QBLK) * ldo;
#pragma unroll
    for (int r = 0; r < 16; ++r) { const int orow = crow(r, hi);
#pragma unroll
        for (int d0 = 0; d0 < 4; ++d0) Ow[(size_t)orow * ldo + d0 * 32 + r32] = f2bf(o[d0][r] * rli[r]); }
    __syncthreads();
#undef SLOAD
#undef SWRITE
#undef SWAIT
#undef RESC
}
}

struct Args { const float* in[25]; float* out; unsigned char* ws; int q_lo, q_hi, single, pad; };
enum { I_X = 0, I_C, I_CTX, I_CCTX, I_WMOD, I_BMOD, I_N1G, I_N2G, I_WIN, I_QNG, I_WQUP, I_KVNG, I_WKVUP, I_QHG, I_KHG, I_GWG, I_GBG, I_GONG, I_PW, I_PS, I_WBR, I_WOUT, I_W1, I_W3, I_W2 };
constexpr int NPH = 11;

struct Frame {
    LAS unsigned char* lds; unsigned char* ldsg;
    int tid, lane, wave, G, c;
    const float* const* in; float* out; unsigned char* ws;
};

__device__ __forceinline__ void refresh_lane(Frame& F) { int t = threadIdx.x; asm volatile("" : "+v"(t)); F.tid = t; F.lane = t & 63;
    unsigned char* w = F.ws; int c = F.c, wv = F.wave; asm volatile("" : "+s"(w), "+s"(c), "+s"(wv)); F.ws = w; F.c = c; F.wave = wv; }
__device__ __forceinline__ int mod_row(int row) { return row < ML ? (row >> 11) : 4; }

__device__ __forceinline__ int win_dst_row(int n) {
    if (n < 512) return ZC_CKV + n;
    if (n < 576) return NZB + ZT_KR + (n - 512);
    if (n < 1600) return ZC_GK + (n - 576);
    if (n < 2624) return ZC_GV + (n - 1600);
    if (n < 2656) return NZB + ZT_LR + (n - 2624);
    if (n < 3168) return ZC_CQ + (n - 2656);
    if (n < 4192) return ZC_GQ + (n - 3168);
    if (n < 5216) return ZC_GG + (n - 4192);
    if (n < 6240) return ZC_PIN + (n - 5216);
    return ZC_GATE + (n - 6240);
}
constexpr int IT_IN = 32 * 387, IT_Q = 8 * 48, IT_KV = 8 * 64, IT_P = 4 * 4 * 8, IT_B = 3 * 16 * 64, IT_O = 32 * 64, IT_1 = 32 * 176, IT_2 = 88 * 64;
constexpr int IT_LAYER = IT_IN + IT_Q + IT_KV + IT_P + IT_B + IT_O + 2 * IT_1 + IT_2;
__device__ __forceinline__ void item_decode(const Frame& F, int it, const float*& src, int& ldsrc, int& c0, int& k0, bf16_t*& dst, int& lddst, int& r0, const float*& kscale, const float*& nscale) {
    const int l = it / IT_LAYER; int r = it % IT_LAYER;
    bf16_t* wl = (bf16_t*)(F.ws + WS_W + (size_t)l * W_LAYER);
    kscale = nullptr; nscale = nullptr;
    if (r < IT_IN) { const int kb = r / 387, nb = r % 387;
        src = F.in[I_WIN] + (size_t)l * DM * IN_COLS; ldsrc = IN_COLS; c0 = 32 * nb; k0 = 64 * kb; dst = wl + W_IN / 2; lddst = DM; r0 = win_dst_row(32 * nb); return; } r -= IT_IN;
    if (r < IT_Q) { const int kb = r / 48, nb = r % 48;
        src = F.in[I_WQUP] + (size_t)l * 512 * 1536; ldsrc = 1536; c0 = 32 * nb; k0 = 64 * kb; dst = wl + W_QKV / 2; lddst = 512; r0 = 32 * nb; kscale = F.in[I_QNG] + l * 512; return; } r -= IT_Q;
    if (r < IT_KV) { const int kb = r / 64, nb = r % 64;
        src = F.in[I_WKVUP] + (size_t)l * 512 * 2048; ldsrc = 2048; c0 = 32 * nb; k0 = 64 * kb; dst = wl + W_QKV / 2; lddst = 512; r0 = 1536 + 32 * nb; kscale = F.in[I_KVNG] + l * 512; return; } r -= IT_KV;
    if (r < IT_P) { const int g = r / 32, kb = (r % 32) / 8, nb = r % 8;
        src = F.in[I_PW] + ((size_t)l * 4 + g) * 65536; ldsrc = 256; c0 = 32 * nb; k0 = 64 * kb; dst = wl + W_P / 2; lddst = 256; r0 = g * 256 + 32 * nb; nscale = F.in[I_PS] + l * 1024 + g * 256 + 32 * nb; return; } r -= IT_P;
    if (r < IT_B) { const int n = r / 1024, kb = (r % 1024) / 64, nb = r % 64;
        src = F.in[I_WBR] + ((size_t)l * 3 + n) * 1024 * 2048; ldsrc = 2048; c0 = 32 * nb; k0 = 64 * kb; dst = wl + W_B / 2; lddst = 1024; r0 = n * 2048 + 32 * nb; return; } r -= IT_B;
    if (r < IT_O) { const int kb = r / 64, nb = r % 64;
        src = F.in[I_WOUT] + (size_t)l * DM * DM; ldsrc = DM; c0 = 32 * nb; k0 = 64 * kb; dst = wl + W_O / 2; lddst = DM; r0 = 32 * nb; return; } r -= IT_O;
    if (r < 2 * IT_1) { const int which = r / IT_1; r %= IT_1; const int kb = r / 176, nb = r % 176, n0 = 32 * nb;
        src = F.in[which ? I_W3 : I_W1] + (size_t)l * DM * FF; ldsrc = FF; c0 = n0; k0 = 64 * kb; dst = wl + W_13 / 2; lddst = DM; r0 = (n0 >> 7) * 256 + which * 128 + (n0 & 127); return; } r -= 2 * IT_1;
    { const int kb = r / 64, nb = r % 64;
        src = F.in[I_W2] + (size_t)l * FF * DM; ldsrc = DM; c0 = 32 * nb; k0 = 64 * kb; dst = wl + W_2 / 2; lddst = FF; r0 = 32 * nb; }
}
__device__ __forceinline__ void item_load(float (&v)[32], const float* src, int ldsrc, int c0, int k0, int lane) {
    const float* p = src + (size_t)(k0 + (lane >> 5)) * ldsrc + c0 + (lane & 31);
#pragma unroll
    for (int i = 0; i < 32; ++i) v[i] = p[(size_t)(2 * i) * ldsrc];
}
__device__ __forceinline__ void item_finish(const float (&v)[32], int k0, bf16_t* dst, int lddst, int r0, const float* kscale, const float* nscale, LAS float* scr, int lane) {
#pragma unroll
    for (int i = 0; i < 32; ++i) scr[(2 * i + (lane >> 5)) * 33 + (lane & 31)] = v[i];
    LDS_WAIT(); asm volatile("" ::: "memory");
    const int c = lane & 7;
    float ks[8];
#pragma unroll
    for (int i = 0; i < 8; ++i) ks[i] = kscale ? kscale[k0 + 8 * c + i] : 1.0f;
#pragma unroll
    for (int j = 0; j < 4; ++j) { const int n = (lane >> 3) + 8 * j; const LAS float* s = scr + (8 * c) * 33 + n; const float ns = nscale ? nscale[n] : 1.0f;
        u32x4 o; o.x = cvt_pk_bf16(s[0 * 33] * ks[0] * ns, s[1 * 33] * ks[1] * ns); o.y = cvt_pk_bf16(s[2 * 33] * ks[2] * ns, s[3 * 33] * ks[3] * ns);
        o.z = cvt_pk_bf16(s[4 * 33] * ks[4] * ns, s[5 * 33] * ks[5] * ns); o.w = cvt_pk_bf16(s[6 * 33] * ks[6] * ns, s[7 * 33] * ks[7] * ns);
        *(u32x4*)(dst + (size_t)(r0 + n) * lddst + k0 + 8 * c) = o; }
    LDS_WAIT(); asm volatile("" ::: "memory");
}
__device__ __forceinline__ void prologue_item(const Frame& F, int it, LAS float* scr) {
    const float* src; int ldsrc, c0, k0; bf16_t* dst; int lddst, r0; const float* kscale; const float* nscale;
    item_decode(F, it, src, ldsrc, c0, k0, dst, lddst, r0, kscale, nscale);
    float v[32];
    item_load(v, src, ldsrc, c0, k0, F.lane);
    item_finish(v, k0, dst, lddst, r0, kscale, nscale, scr, F.lane);
}
__device__ __forceinline__ void phase_prologue(const Frame& F) {
    { LAS float* scr = (LAS float*)(F.lds + F.wave * 8448);
      const int gw = F.c * 8 + F.wave, NGW = F.G * 8;
      for (int it = gw; it < (F.G == 256 ? 1 : NLAYER) * IT_LAYER; it += NGW) prologue_item(F, it, scr);
      const int gt = F.c * 512 + F.tid, NT = F.G * 512;
      for (int i = gt; i < NLAYER * 160 * (DM / 8); i += NT) { const int l = i / (160 * 256), rr = (i % (160 * 256)) / 256, cc = i % 256;
          *(u32x4*)((bf16_t*)(F.ws + WS_W + (size_t)l * W_LAYER + W_IN) + (size_t)(IN_COLS + rr) * DM + cc * 8) = (u32x4){0u, 0u, 0u, 0u}; } }
    __syncthreads();
    { float* sc = (float*)F.ldsg;
      float* red = (float*)(F.ldsg + 40960);
      for (int i = F.tid; i < 5 * DM; i += 512) { const int r = i >> 11, k = i & 2047; const float v = r < 4 ? F.in[I_C][r * DM + k] : F.in[I_CCTX][k]; sc[i] = v / (1.0f + __expf(-v)); }
      __syncthreads();
      float* mods = (float*)(F.ws + WS_MODS);
      for (int wb = F.c; wb < 256; wb += F.G) {
          const int l = wb >> 6, col0 = (wb & 63) * 192;
          const int cg = F.tid % 48, ksl = F.tid / 48;
          if (ksl < 10) {
              f32x4 a[5];
#pragma unroll
              for (int r = 0; r < 5; ++r) a[r] = (f32x4){0.f, 0.f, 0.f, 0.f};
              const float* wp = F.in[I_WMOD] + (size_t)l * DM * 12288 + col0 + 4 * cg;
#pragma unroll 8
              for (int k = ksl; k < DM; k += 10) { const f32x4 w = *(const f32x4*)(wp + (size_t)k * 12288);
#pragma unroll
                  for (int r = 0; r < 5; ++r) a[r] += w * sc[r * DM + k]; }
#pragma unroll
              for (int r = 0; r < 5; ++r) *(f32x4*)(red + (ksl * 5 + r) * 192 + 4 * cg) = a[r];
          }
          __syncthreads();
          for (int i = F.tid; i < 960; i += 512) { const int r = i / 192, j = i % 192; float s = F.in[I_BMOD][l * 12288 + col0 + j];
#pragma unroll
              for (int q = 0; q < 10; ++q) s += red[(q * 5 + r) * 192 + j];
              mods[((size_t)l * 5 + r) * 12288 + col0 + j] = s; }
          __syncthreads();
      } }
    { const int gt = F.c * 512 + F.tid;
      if (gt < 96 * 16) { const int pi = gt >> 4, i = gt & 15; const float invf = 1.0f / powf(10000.0f, (float)(2 * i) / 32.0f);
          const float ang = (float)(pi < 32 ? pi : pi - 32) * invf; float* rt = (float*)(F.ws + WS_ROPE) + gt * 2; rt[0] = cosf(ang); rt[1] = sinf(ang); } }
    if (F.G != 256) { const int gt = F.c * 512 + F.tid, NT = F.G * 512; f32x4* X = (f32x4*)(F.ws + WS_X);
      const f32x4* x = (const f32x4*)F.in[I_X]; const f32x4* cx = (const f32x4*)F.in[I_CTX];
      for (int i = gt; i < ML * DM / 4; i += NT) X[i] = x[i];
      for (int i = gt; i < MC * DM / 4; i += NT) X[ML * DM / 4 + i] = cx[i]; }
}

__device__ __forceinline__ void phase_norm(const Frame& F, int nrows, bool slabs, const float* xl, const float* xc, const float* ng, const float* mods_l, int ch_shift, int ch_scale) {
    float* X = (float*)(F.ws + WS_X); const float* SL = (const float*)(F.ws + WS_RSLAB); bf16_t* H = (bf16_t*)(F.ws + WS_H);
    const int step = F.G * 8;
    for (int rowA = F.c * 8 + F.wave; rowA < nrows; rowA += 2 * step) {
        const int rowB = rowA + step; const bool vb = rowB < nrows;
        const f32x4* xa = (const f32x4*)(rowA < ML ? xl + (size_t)rowA * DM : xc + (size_t)(rowA - ML) * DM) + F.lane;
        const f32x4* xb = (const f32x4*)(rowB < ML ? xl + (size_t)rowB * DM : xc + (size_t)(rowB - ML) * DM) + F.lane;
        f32x4 va[8], vbv[8];
#pragma unroll
        for (int j = 0; j < 8; ++j) va[j] = xa[64 * j];
        if (vb) {
#pragma unroll
            for (int j = 0; j < 8; ++j) vbv[j] = xb[64 * j];
        }
#pragma unroll
        for (int which = 0; which < 2; ++which) {
            if (which == 1 && !vb) break;
            const int row = which ? rowB : rowA;
            f32x4 v[8];
#pragma unroll
            for (int j = 0; j < 8; ++j) v[j] = which ? vbv[j] : va[j];
            if (slabs && row >= ML) {
#pragma unroll
                for (int q = 0; q < 8; ++q) { const f32x4* sr = (const f32x4*)(SL + ((size_t)q * MC + (row - ML)) * DM) + F.lane;
#pragma unroll
                    for (int j = 0; j < 8; ++j) v[j] += sr[64 * j]; }
                f32x4* xw = (f32x4*)(X + (size_t)row * DM) + F.lane;
#pragma unroll
                for (int j = 0; j < 8; ++j) xw[64 * j] = v[j];
            }
            float s = 0.f;
#pragma unroll
            for (int j = 0; j < 8; ++j) { s += (v[j][0] * v[j][0] + v[j][1] * v[j][1]) + (v[j][2] * v[j][2] + v[j][3] * v[j][3]); }
            const float rstd = rsqrtf(wave_sum(s) * (1.0f / DM) + RMS_EPS);
            const float* mp = mods_l + (size_t)mod_row(row) * 12288;
#pragma unroll
            for (int j = 0; j < 8; ++j) { const int col = 4 * (F.lane + 64 * j);
                const f32x4 g = *(const f32x4*)(ng + col), sh = *(const f32x4*)(mp + ch_shift * DM + col), sc = *(const f32x4*)(mp + ch_scale * DM + col);
                const f32x4 h = (v[j] * rstd * g) * (sc + 1.0f) + sh;
                u32x2 w; w.x = cvt_pk_bf16(h[0], h[1]); w.y = cvt_pk_bf16(h[2], h[3]);
                *(u32x2*)(H + (size_t)row * DM + col) = w; }
        }
    }
}

__device__ __forceinline__ int gla_row(int b, int dir, int n, int p) {
    if (n < 4) { const int s = 64 * n + p, t = dir ? (CTXL - 1 - s) : s; return ML + b * CTXL + t; }
    const int s = 64 * (n - 4) + p, t = dir ? (SEQ - 1 - s) : s; return b * SEQ + t;
}
__device__ __forceinline__ void gla_prep_units(const Frame& F, int layer) {
  const int tid = F.tid;
  u32x4 tq[4], tk[4], tv[4]; f32x4 tlr = (f32x4){0.f, 0.f, 0.f, 0.f};
#define PREP_LOAD(uu) do { const int n_ = (uu) % NCH, cd_ = (uu) / NCH, dir_ = cd_ & 1, h_ = (cd_ >> 1) & 3, b_ = cd_ >> 3; \
      _Pragma("unroll") for (int i = 0; i < 4; ++i) { const int idx = tid + 512 * i, p = idx >> 5, sg = (idx & 31) * 8; const bf16_t* zr = (const bf16_t*)(F.ws + WS_Z) + (size_t)gla_row(b_, dir_, n_, p) * NZB + h_ * 256 + sg; \
          tq[i] = *(const u32x4*)(zr + ZC_GQ); tk[i] = *(const u32x4*)(zr + ZC_GK); tv[i] = *(const u32x4*)(zr + ZC_GV); } \
      if (tid < 256) { const int p = tid >> 2, q4 = tid & 3; tlr = *(const f32x4*)((const float*)(F.ws + WS_ZT) + (size_t)gla_row(b_, dir_, n_, p) * 256 + ZT_LR + dir_ * 16 + q4 * 4); } } while (0)
  int u = F.c; if (u >= NGU) return;
  PREP_LOAD(u);
  for (; u < NGU; u += F.G) {
    const int n = u % NCH, cd = u / NCH, dir = cd & 1, bh = cd >> 1, h = bh & 3, b = bh >> 2;
    bf16_t* Ql = (bf16_t*)F.ldsg; bf16_t* Kl = (bf16_t*)(F.ldsg + 33792); bf16_t* Vl = (bf16_t*)(F.ldsg + 2 * 33792); float* lrs = (float*)(F.ldsg + 3 * 33792); float* hs = lrs + 1024;
    const bf16_t* Z = (const bf16_t*)(F.ws + WS_Z); const float* ZT = (const float*)(F.ws + WS_ZT);
    bf16_t* GQ = (bf16_t*)(F.ws + WS_GQ) + (size_t)u * 16384; bf16_t* GKT = (bf16_t*)(F.ws + WS_GKT) + (size_t)u * 16384; bf16_t* GVT = (bf16_t*)(F.ws + WS_GVT) + (size_t)u * 16384;
    bf16_t* GP = (bf16_t*)(F.ws + WS_GP) + (size_t)u * 4096; float* GD = (float*)(F.ws + WS_GD) + (size_t)u * 256;
    { if (tid < 256) { const int p = tid >> 2, q4 = tid & 3; *(f32x4*)(lrs + p * 16 + q4 * 4) = tlr; }
#pragma unroll
      for (int i = 0; i < 4; ++i) { const int idx = tid + 512 * i, p = idx >> 5, sg = (idx & 31) * 8;
          *(u32x4*)(Ql + p * 264 + sg) = tq[i]; *(u32x4*)(Kl + p * 264 + sg) = tk[i]; *(u32x4*)(Vl + p * 264 + sg) = tv[i]; } }
    const int d = tid & 255, hf = tid >> 8, col = h * 256 + d;
    float w[16];
#pragma unroll
    for (int r = 0; r < 16; ++r) w[r] = F.in[I_GWG][((size_t)(layer * 2 + dir) * 16 + r) * 1024 + col];
    const float bias = F.in[I_GBG][(layer * 2 + dir) * 1024 + col];
    __syncthreads();
    if (u + F.G < NGU) PREP_LOAD(u + F.G);
    float cum[32]; float run = 0.f;
#pragma unroll
    for (int i = 0; i < 32; ++i) { const int p = 32 * hf + i; float lg = bias;
#pragma unroll
        for (int r = 0; r < 16; ++r) lg += lrs[p * 16 + r] * w[r];
        const float ls = fminf(lg, 0.f) - __logf(1.0f + __expf(-fabsf(lg)));
        run += ls * (1.0f / 16.0f); cum[i] = run; }
    hs[hf * 256 + d] = run; __syncthreads();
    const float tot0 = hs[d], tot1 = hs[256 + d], last = tot0 + tot1, off = hf ? tot0 : 0.f, elast = __expf(last);
    unsigned khp[16], vvp[16];
#pragma unroll
    for (int i = 0; i < 32; i += 2) {
        float kh2[2]; unsigned short vv2[2];
#pragma unroll
        for (int e = 0; e < 2; ++e) { const int p = 32 * hf + i + e; const float cc = cum[i + e] + off;
            const float q = bf2f(Ql[p * 264 + d]), k = bf2f(Kl[p * 264 + d]); vv2[e] = Vl[p * 264 + d];
            const float ec = __expf(cc), kt = k * __builtin_amdgcn_rcpf(ec);
            Ql[p * 264 + d] = f2bf(q * 0.0625f * ec); Kl[p * 264 + d] = f2bf(kt);
            kh2[e] = kt * elast; }
        khp[i >> 1] = cvt_pk_bf16(kh2[0], kh2[1]); vvp[i >> 1] = (unsigned)vv2[0] | ((unsigned)vv2[1] << 16); }
#pragma unroll
    for (int q = 0; q < 4; ++q) { *(u32x4*)(GKT + d * 64 + 32 * hf + 8 * q) = (u32x4){khp[4 * q], khp[4 * q + 1], khp[4 * q + 2], khp[4 * q + 3]};
                                  *(u32x4*)(GVT + d * 64 + 32 * hf + 8 * q) = (u32x4){vvp[4 * q], vvp[4 * q + 1], vvp[4 * q + 2], vvp[4 * q + 3]}; }
    if (hf == 0) GD[d] = elast;
    __syncthreads();
#pragma unroll
    for (int i = 0; i < 4; ++i) { const int idx = tid + 512 * i, p = idx >> 5, sg = (idx & 31) * 8; *(u32x4*)(GQ + p * 256 + sg) = *(const u32x4*)(Ql + p * 264 + sg); }
    { const int l15 = F.lane & 15, l4 = F.lane >> 4, tb = F.wave >> 1;
#pragma unroll
      for (int q = 0; q < 2; ++q) { const int sb = 2 * (F.wave & 1) + q; f32x4 acc = (f32x4){0.f, 0.f, 0.f, 0.f};
          if (sb <= tb) {
#pragma unroll
              for (int kk = 0; kk < 8; ++kk) { const bf16x8 a = *(const bf16x8*)(Kl + (sb * 16 + l15) * 264 + kk * 32 + 8 * l4), bq = *(const bf16x8*)(Ql + (tb * 16 + l15) * 264 + kk * 32 + 8 * l4);
                  acc = __builtin_amdgcn_mfma_f32_16x16x32_bf16(a, bq, acc, 0, 0, 0); } }
          const int t = tb * 16 + l15, s0 = sb * 16 + 4 * l4;
          float o[4];
#pragma unroll
          for (int j = 0; j < 4; ++j) o[j] = (s0 + j <= t) ? acc[j] : 0.f;
          u32x2 wv; wv.x = cvt_pk_bf16(o[0], o[1]); wv.y = cvt_pk_bf16(o[2], o[3]);
          *(u32x2*)(GP + t * 64 + s0) = wv; } }
    __syncthreads();
  }
#undef PREP_LOAD
}

__device__ __forceinline__ void gla_scan_unit(const Frame& F, int unit, int snap_from, int it0, int it_end, int it_stride) {
    const int es = unit & 7, cd = unit >> 3;
    const int u0 = cd * NCH;
    const int l15 = F.lane & 15, l4 = F.lane >> 4, w = F.wave;
    bf16_t* Sl = (bf16_t*)(F.ldsg + 4 * 8448);
    if (w < 4) {
        const unsigned o64 = (unsigned)(l15 * 64 + 8 * l4) * 2u, od = (unsigned)(4 * l4) * 4u;
        const f32x4 z4 = (f32x4){0.f, 0.f, 0.f, 0.f};
        f32x4 S00 = z4, S01 = z4, S10 = z4, S11 = z4, S20 = z4, S21 = z4, S30 = z4, S31 = z4;
        bf16x8 vA00, vA01, vA10, vA11, kA00, kA01, kA10, kA11, kA20, kA21, kA30, kA31; f32x4 dA0, dA1, dA2, dA3;
        bf16x8 vB00, vB01, vB10, vB11, kB00, kB01, kB10, kB11, kB20, kB21, kB30, kB31; f32x4 dB0, dB1, dB2, dB3;
#define SCAN_LOAD(X, u) do { \
    const char* gv_ = (const char*)(F.ws + WS_GVT) + ((size_t)(u) * 16384 + es * 32 * 64) * 2 + o64; \
    v##X##00 = *(const bf16x8*)(gv_); v##X##01 = *(const bf16x8*)(gv_ + 64); v##X##10 = *(const bf16x8*)(gv_ + 2048); v##X##11 = *(const bf16x8*)(gv_ + 2048 + 64); \
    const char* gk_ = (const char*)(F.ws + WS_GKT) + ((size_t)(u) * 16384 + 64 * w * 64) * 2 + o64; \
    k##X##00 = *(const bf16x8*)(gk_); k##X##01 = *(const bf16x8*)(gk_ + 64); k##X##10 = *(const bf16x8*)(gk_ + 2048); k##X##11 = *(const bf16x8*)(gk_ + 2048 + 64); \
    k##X##20 = *(const bf16x8*)(gk_ + 4096); k##X##21 = *(const bf16x8*)(gk_ + 4096 + 64); k##X##30 = *(const bf16x8*)(gk_ + 6144); k##X##31 = *(const bf16x8*)(gk_ + 6144 + 64); \
    const char* gd_ = (const char*)(F.ws + WS_GD) + ((size_t)(u) * 256 + 64 * w) * 4 + od; \
    d##X##0 = *(const f32x4*)(gd_); d##X##1 = *(const f32x4*)(gd_ + 64); d##X##2 = *(const f32x4*)(gd_ + 128); d##X##3 = *(const f32x4*)(gd_ + 192); } while (0)
#define MF16(a, b, c) __builtin_amdgcn_mfma_f32_16x16x32_bf16(a, b, c, 0, 0, 0)
#define SCAN_PUT(sp, T) do { u32x2 wv_; wv_.x = cvt_pk_bf16(T[0], T[1]); wv_.y = cvt_pk_bf16(T[2], T[3]); *(u32x2*)(sp) = wv_; } while (0)
#define SCAN_STEP(X, n) do { \
    { bf16_t* sp = Sl + ((n) & 1) * (32 * 264) + l15 * 264 + 64 * w + 4 * l4; \
      SCAN_PUT(sp, S00); SCAN_PUT(sp + 16 * 264, S01); SCAN_PUT(sp + 16, S10); SCAN_PUT(sp + 16 * 264 + 16, S11); \
      SCAN_PUT(sp + 32, S20); SCAN_PUT(sp + 16 * 264 + 32, S21); SCAN_PUT(sp + 48, S30); SCAN_PUT(sp + 16 * 264 + 48, S31); } \
    asm volatile("s_waitcnt lgkmcnt(0)" ::: "memory"); __builtin_amdgcn_s_barrier(); asm volatile("" ::: "memory"); \
    S00 = S00 * d##X##0; S01 = S01 * d##X##0; S10 = S10 * d##X##1; S11 = S11 * d##X##1; S20 = S20 * d##X##2; S21 = S21 * d##X##2; S30 = S30 * d##X##3; S31 = S31 * d##X##3; \
    S00 = MF16(k##X##00, v##X##00, S00); S01 = MF16(k##X##00, v##X##10, S01); S10 = MF16(k##X##10, v##X##00, S10); S11 = MF16(k##X##10, v##X##10, S11); \
    S20 = MF16(k##X##20, v##X##00, S20); S21 = MF16(k##X##20, v##X##10, S21); S30 = MF16(k##X##30, v##X##00, S30); S31 = MF16(k##X##30, v##X##10, S31); \
    S00 = MF16(k##X##01, v##X##01, S00); S01 = MF16(k##X##01, v##X##11, S01); S10 = MF16(k##X##11, v##X##01, S10); S11 = MF16(k##X##11, v##X##11, S11); \
    S20 = MF16(k##X##21, v##X##01, S20); S21 = MF16(k##X##21, v##X##11, S21); S30 = MF16(k##X##31, v##X##01, S30); S31 = MF16(k##X##31, v##X##11, S31); } while (0)
        SCAN_LOAD(A, u0);
#pragma unroll 1
        for (int n = 0; n < NCH; n += 2) {
            SCAN_LOAD(B, u0 + n + 1);
            SCAN_STEP(A, n);
            SCAN_LOAD(A, u0 + (n + 2 < NCH ? n + 2 : NCH - 1));
            SCAN_STEP(B, n + 1);
        }
#undef SCAN_LOAD
#undef SCAN_STEP
#undef SCAN_PUT
#undef MF16
    } else {
        const int i = w - 4;
        LAS float* scr = (LAS float*)(F.lds + i * 8448);
        float cv[32], cw[32]; const float* c_src; int c_ld, c_c0, c_k0, c_ldd, c_r0; bf16_t* c_dst; const float* c_ks; const float* c_ns;
        const float* e_src; int e_ld, e_c0, e_k0, e_ldd, e_r0; bf16_t* e_dst; const float* e_ks; const float* e_ns; int it = it0;
        bool a_on = false, b_on = false;
#define CONV_ISSUE() do { a_on = it < it_end; b_on = it + it_stride < it_end; \
        if (a_on) { item_decode(F, it, c_src, c_ld, c_c0, c_k0, c_dst, c_ldd, c_r0, c_ks, c_ns); item_load(cv, c_src, c_ld, c_c0, c_k0, F.lane); } \
        if (b_on) { item_decode(F, it + it_stride, e_src, e_ld, e_c0, e_k0, e_dst, e_ldd, e_r0, e_ks, e_ns); item_load(cw, e_src, e_ld, e_c0, e_k0, F.lane); } \
        it += 2 * it_stride; } while (0)
#define CONV_FINISH() do { if (a_on) item_finish(cv, c_k0, c_dst, c_ldd, c_r0, c_ks, c_ns, scr, F.lane); \
        if (b_on) item_finish(cw, e_k0, e_dst, e_ldd, e_r0, e_ks, e_ns, scr, F.lane); a_on = false; b_on = false; } while (0)
#pragma unroll 1
        for (int n = 0; n < NCH; ++n) {
            asm volatile("" ::: "memory"); __builtin_amdgcn_s_barrier(); asm volatile("" ::: "memory");
            if (n >= snap_from) {
                const bf16_t* sl = Sl + (n & 1) * (32 * 264);
                bf16_t* sn = (bf16_t*)(F.ws + WS_SN) + ((size_t)(u0 + n) * 256 + es * 32) * 256;
                u32x4 t[4];
#pragma unroll
                for (int j = 0; j < 4; ++j) { const int c = i * 64 + F.lane + 256 * j; t[j] = *(const u32x4*)(sl + (c >> 5) * 264 + (c & 31) * 8); }
                asm volatile("s_waitcnt lgkmcnt(0)" ::: "memory");
#pragma unroll
                for (int j = 0; j < 4; ++j) { const int c = i * 64 + F.lane + 256 * j; *(u32x4*)(sn + (c >> 5) * 256 + (c & 31) * 8) = t[j]; }
            }
            if (n & 1) CONV_FINISH(); else CONV_ISSUE();
        }
        CONV_FINISH();
        while (it < it_end) { CONV_ISSUE(); CONV_FINISH(); }
#undef CONV_ISSUE
#undef CONV_FINISH
    }
    __syncthreads();
}
__device__ __forceinline__ void gla_o_unit(const Frame& F, int layer, int unit) {
    const int jj = unit % NCH, bh = unit / NCH, h = bh & 3, b = bh >> 2;
    const int l15 = F.lane & 15, l4 = F.lane >> 4, w = F.wave, tid = F.tid;
    const int row0 = jj < 4 ? (ML + b * CTXL + 64 * jj) : (b * SEQ + 64 * (jj - 4));
    const int nb = jj < 4 ? 3 - jj : 39 - jj;
    const size_t uf = (size_t)((bh * 2 + 0) * NCH + jj), ub = (size_t)((bh * 2 + 1) * NCH + nb);
    bf16_t* Ql = (bf16_t*)F.ldsg;
    bf16_t* Pl = (bf16_t*)(F.ldsg + 2 * 33792);
    float* part = (float*)(F.ldsg + 2 * 33792 + 2 * 9216);
    float* rs = part + 512;
    u32x4 tq[8], tp[2];
#pragma unroll
    for (int i = 0; i < 8; ++i) { const int idx = tid + 512 * i, dir = idx >> 11, r = idx & 2047;
        tq[i] = *(const u32x4*)((const char*)(F.ws + WS_GQ) + (dir ? ub : uf) * 32768 + (size_t)r * 16); }
#pragma unroll
    for (int i = 0; i < 2; ++i) { const int idx = tid + 512 * i, dir = idx >> 9, r = idx & 511;
        tp[i] = *(const u32x4*)((const char*)(F.ws + WS_GP) + (dir ? ub : uf) * 8192 + (size_t)r * 16); }
    const unsigned so = (unsigned)((32 * w + l15) * 512 + 16 * l4), vo = (unsigned)((32 * w + l15) * 128 + 16 * l4);
    bf16x8 sf[2][8], vf[2][2], sbk[2][8], vbk[2][2];
    { const char* sn = (const char*)(F.ws + WS_SN) + uf * 131072 + so; const char* gv = (const char*)(F.ws + WS_GVT) + uf * 32768 + vo;
#pragma unroll
      for (int eb = 0; eb < 2; ++eb) {
#pragma unroll
          for (int kk = 0; kk < 8; ++kk) sf[eb][kk] = *(const bf16x8*)(sn + eb * 8192 + kk * 64);
#pragma unroll
          for (int ss = 0; ss < 2; ++ss) vf[eb][ss] = *(const bf16x8*)(gv + eb * 2048 + ss * 64); } }
#pragma unroll
    for (int i = 0; i < 8; ++i) { const int idx = tid + 512 * i, dir = idx >> 11, r = idx & 2047; *(u32x4*)(Ql + dir * (64 * 264) + (r >> 5) * 264 + (r & 31) * 8) = tq[i]; }
#pragma unroll
    for (int i = 0; i < 2; ++i) { const int idx = tid + 512 * i, dir = idx >> 9, r = idx & 511; *(u32x4*)(Pl + dir * (64 * 72) + (r >> 3) * 72 + (r & 7) * 8) = tp[i]; }
    { const char* sn = (const char*)(F.ws + WS_SN) + ub * 131072 + so; const char* gv = (const char*)(F.ws + WS_GVT) + ub * 32768 + vo;
#pragma unroll
      for (int eb = 0; eb < 2; ++eb) {
#pragma unroll
          for (int kk = 0; kk < 8; ++kk) sbk[eb][kk] = *(const bf16x8*)(sn + eb * 8192 + kk * 64);
#pragma unroll
          for (int ss = 0; ss < 2; ++ss) vbk[eb][ss] = *(const bf16x8*)(gv + eb * 2048 + ss * 64); } }
    __syncthreads();
    f32x4 acc[4][2];
#pragma unroll
    for (int tb = 0; tb < 4; ++tb)
#pragma unroll
        for (int eb = 0; eb < 2; ++eb) acc[tb][eb] = (f32x4){0.f, 0.f, 0.f, 0.f};
#pragma unroll
    for (int dir = 0; dir < 2; ++dir) {
        const bf16_t* ql = Ql + dir * (64 * 264) + 8 * l4; const bf16_t* pl = Pl + dir * (64 * 72) + 8 * l4;
#pragma unroll
        for (int tb = 0; tb < 4; ++tb) { const int t = tb * 16 + l15, p = dir ? 63 - t : t;
#pragma unroll
            for (int kk = 0; kk < 8; ++kk) { const bf16x8 qa = *(const bf16x8*)(ql + p * 264 + kk * 32);
#pragma unroll
                for (int eb = 0; eb < 2; ++eb) acc[tb][eb] = __builtin_amdgcn_mfma_f32_16x16x32_bf16(dir ? sbk[eb][kk] : sf[eb][kk], qa, acc[tb][eb], 0, 0, 0); }
#pragma unroll
            for (int ss = 0; ss < 2; ++ss) { const bf16x8 pa = *(const bf16x8*)(pl + p * 72 + ss * 32);
#pragma unroll
                for (int eb = 0; eb < 2; ++eb) acc[tb][eb] = __builtin_amdgcn_mfma_f32_16x16x32_bf16(dir ? vbk[eb][ss] : vf[eb][ss], pa, acc[tb][eb], 0, 0, 0); } }
    }
#pragma unroll
    for (int tb = 0; tb < 4; ++tb) { float q = 0.f;
#pragma unroll
        for (int eb = 0; eb < 2; ++eb) q += (acc[tb][eb][0] * acc[tb][eb][0] + acc[tb][eb][1] * acc[tb][eb][1]) + (acc[tb][eb][2] * acc[tb][eb][2] + acc[tb][eb][3] * acc[tb][eb][3]);
        q += __shfl_xor(q, 16); q += __shfl_xor(q, 32);
        if (l4 == 0) part[(tb * 16 + l15) * 8 + w] = q; }
    __syncthreads();
    if (tid < 64) { float q = 0.f;
#pragma unroll
        for (int i = 0; i < 8; ++i) q += part[tid * 8 + i];
        rs[tid] = rsqrtf(q * (1.0f / 256.0f) + RMS_EPS); }
    __syncthreads();
    const bf16_t* Z = (const bf16_t*)(F.ws + WS_Z); bf16_t* O = (bf16_t*)(F.ws + WS_BR) + (size_t)2 * MT * 1024;
#pragma unroll
    for (int eb = 0; eb < 2; ++eb) { const int e = 32 * w + 16 * eb + 4 * l4; const f32x4 g = *(const f32x4*)(F.in[I_GONG] + layer * 256 + e);
#pragma unroll
        for (int tb = 0; tb < 4; ++tb) { const int t = tb * 16 + l15; const float r = rs[t]; const size_t row = (size_t)(row0 + t);
            const u32x2 gw = *(const u32x2*)(Z + row * NZB + ZC_GG + h * 256 + e);
            const f32x4 o = acc[tb][eb];
            u32x2 wv; wv.x = cvt_pk_bf16(o[0] * r * g[0] * fast_silu(bflo(gw.x)), o[1] * r * g[1] * fast_silu(bfhi(gw.x)));
            wv.y = cvt_pk_bf16(o[2] * r * g[2] * fast_silu(bflo(gw.y)), o[3] * r * g[3] * fast_silu(bfhi(gw.y)));
            *(u32x2*)(O + row * 1024 + h * 256 + e) = wv; } }
    __syncthreads();
}

__device__ __forceinline__ void pool_rows(const Frame& F) {
    const bf16_t* Z = (const bf16_t*)(F.ws + WS_Z); bf16_t* P = (bf16_t*)(F.ws + WS_POOLED);
    const int gt = F.c * 512 + F.tid, NT = F.G * 512;
    for (int idx = gt; idx < MT * 128; idx += NT) {
        const int row = idx >> 7, c0 = (idx & 127) * 8, gi = c0 >> 8, hw = 1 << gi;
        int base, t, L;
        if (row < ML) { base = row & ~(SEQ - 1); t = row & (SEQ - 1); L = SEQ; } else { const int r = row - ML; base = ML + (r & ~(CTXL - 1)); t = r & (CTXL - 1); L = CTXL; }
        const int lo = max(t - hw, 0), hi = min(t + hw - 1, L - 1);
        float s[8];
#pragma unroll
        for (int j = 0; j < 8; ++j) s[j] = 0.f;
        for (int i = lo; i <= hi; ++i) { const u32x4 v = *(const u32x4*)(Z + (size_t)(base + i) * NZB + ZC_PIN + c0);
            s[0] += bflo(v.x); s[1] += bfhi(v.x); s[2] += bflo(v.y); s[3] += bfhi(v.y); s[4] += bflo(v.z); s[5] += bfhi(v.z); s[6] += bflo(v.w); s[7] += bfhi(v.w); }
        const u32x4 v = *(const u32x4*)(Z + (size_t)row * NZB + ZC_PIN + c0);
        const float ic = 1.0f / (float)(hi - lo + 1);
        u32x4 o; o.x = cvt_pk_bf16(s[0] * ic - bflo(v.x), s[1] * ic - bfhi(v.x)); o.y = cvt_pk_bf16(s[2] * ic - bflo(v.y), s[3] * ic - bfhi(v.y));
        o.z = cvt_pk_bf16(s[4] * ic - bflo(v.z), s[5] * ic - bfhi(v.z)); o.w = cvt_pk_bf16(s[6] * ic - bflo(v.w), s[7] * ic - bfhi(v.w));
        *(u32x4*)(P + (size_t)row * 1024 + c0) = o;
    }
}

__device__ __forceinline__ void post_up_rows(const Frame& F, int layer) {
    const bf16_t* Z = (const bf16_t*)(F.ws + WS_Z); const float* ZT = (const float*)(F.ws + WS_ZT); const bf16_t* R = (const bf16_t*)(F.ws + WS_QKVR);
    bf16_t* QF = (bf16_t*)(F.ws + WS_QF); bf16_t* KF = (bf16_t*)(F.ws + WS_KF); bf16_t* VF = (bf16_t*)(F.ws + WS_VF);
    const float* rope = (const float*)(F.ws + WS_ROPE);
    const int lane = F.lane, h = lane >> 3, sub = lane & 7;
    float* gl = (float*)F.ldsg;
    float* qs = (float*)(F.ldsg + 2048) + F.wave * (8 * 192);
    float* kb = (float*)(F.ldsg + 2048 + 8 * 8 * 192 * 4) + F.wave * 64;
    for (int i = F.tid; i < 384; i += 512) gl[i] = i < 192 ? F.in[I_QHG][layer * 192 + i] : F.in[I_KHG][layer * 192 + (i - 192)];
    __syncthreads();
    for (int row = F.c * 8 + F.wave; row < MT; row += F.G * 8) {
        int b, pos, prow = 0, pcol = 0; const bool lat = row < ML;
        if (lat) { b = row >> 11; const int t = row & (SEQ - 1); pos = CTXL + t; prow = t >> 6; pcol = 32 + (t & 63); }
        else { const int r = row - ML; b = r >> 8; pos = r & (CTXL - 1); }
        const bf16_t* rr = R + (size_t)row * NQKV;
        const u32x4 ca = *(const u32x4*)(Z + (size_t)row * NZB + ZC_CQ + 8 * lane), cc = *(const u32x4*)(Z + (size_t)row * NZB + ZC_CKV + 8 * lane);
        const float kr = ZT[(size_t)row * 256 + ZT_KR + lane];
        u32x4 qw[3], kw[4];
#pragma unroll
        for (int j = 0; j < 3; ++j) qw[j] = *(const u32x4*)(rr + h * 192 + sub * 24 + 8 * j);
#pragma unroll
        for (int j = 0; j < 4; ++j) kw[j] = *(const u32x4*)(rr + 1536 + h * 256 + sub * 32 + 8 * j);
        float sq = 0.f, skv = 0.f;
        { const unsigned aw[4] = {ca.x, ca.y, ca.z, ca.w}, cw[4] = {cc.x, cc.y, cc.z, cc.w};
#pragma unroll
          for (int j = 0; j < 4; ++j) { sq += bflo(aw[j]) * bflo(aw[j]) + bfhi(aw[j]) * bfhi(aw[j]); skv += bflo(cw[j]) * bflo(cw[j]) + bfhi(cw[j]) * bfhi(cw[j]); } }
        const float rq = rsqrtf(wave_sum(sq) * (1.0f / 512.0f) + RMS_EPS), rkv = rsqrtf(wave_sum(skv) * (1.0f / 512.0f) + RMS_EPS);
        const float kr2 = wave_sum(kr * kr);
        { float x = kr * gl[192 + 128 + lane];
          if (lat) { const float* cs = rope + ((lane < 32 ? prow : pcol) * 16 + (lane & 15)) * 2; const float pr = __shfl_xor(x, 16);
              x = (lane & 16) ? (x * cs[0] + pr * cs[1]) : (x * cs[0] - pr * cs[1]); }
          kb[lane] = x; }
        float q[24]; float ss = 0.f;
#pragma unroll
        for (int j = 0; j < 3; ++j) { const unsigned w4[4] = {qw[j].x, qw[j].y, qw[j].z, qw[j].w};
#pragma unroll
            for (int e = 0; e < 4; ++e) { q[8 * j + 2 * e] = bflo(w4[e]) * rq; q[8 * j + 2 * e + 1] = bfhi(w4[e]) * rq; } }
#pragma unroll
        for (int i = 0; i < 24; ++i) ss += q[i] * q[i];
        ss += __shfl_xor(ss, 1); ss += __shfl_xor(ss, 2); ss += __shfl_xor(ss, 4);
        const float rh = rsqrtf(ss * (1.0f / 192.0f) + RMS_EPS);
#pragma unroll
        for (int i = 0; i < 24; ++i) q[i] *= rh * gl[sub * 24 + i];
        if (lat) {
            float* qh = qs + h * 192 + sub * 24;
#pragma unroll
            for (int j = 0; j < 6; ++j) *(f32x4*)(qh + 4 * j) = (f32x4){q[4 * j], q[4 * j + 1], q[4 * j + 2], q[4 * j + 3]};
            LDS_WAIT(); asm volatile("" ::: "memory");
            if (sub >= 5) {
#pragma unroll
                for (int i = 0; i < 24; ++i) { const int dd = sub * 24 + i;
                    if (dd >= 128) { const int r = dd - 128; const float pr = qs[h * 192 + 128 + (r ^ 16)];
                        const float* cs = rope + ((r < 32 ? prow : pcol) * 16 + (r & 15)) * 2;
                        q[i] = (r & 16) ? (q[i] * cs[0] + pr * cs[1]) : (q[i] * cs[0] - pr * cs[1]); } }
            }
        }
        const size_t ob = ((size_t)(b * 8 + h) * KPOS + pos);
#pragma unroll
        for (int j = 0; j < 3; ++j) { u32x4 w; w.x = cvt_pk_bf16(q[8 * j], q[8 * j + 1]); w.y = cvt_pk_bf16(q[8 * j + 2], q[8 * j + 3]); w.z = cvt_pk_bf16(q[8 * j + 4], q[8 * j + 5]); w.w = cvt_pk_bf16(q[8 * j + 6], q[8 * j + 7]);
            *(u32x4*)(QF + ob * 192 + sub * 24 + 8 * j) = w; }
        float kv[32]; float sk = 0.f;
#pragma unroll
        for (int j = 0; j < 4; ++j) { const unsigned w4[4] = {kw[j].x, kw[j].y, kw[j].z, kw[j].w};
#pragma unroll
            for (int e = 0; e < 4; ++e) { kv[8 * j + 2 * e] = bflo(w4[e]) * rkv; kv[8 * j + 2 * e + 1] = bfhi(w4[e]) * rkv; } }
        if (sub < 4) {
#pragma unroll
            for (int i = 0; i < 32; ++i) sk += kv[i] * kv[i]; }
        sk += __shfl_xor(sk, 1); sk += __shfl_xor(sk, 2); sk += __shfl_xor(sk, 4);
        const float rk = rsqrtf((sk + kr2) * (1.0f / 192.0f) + RMS_EPS);
        if (sub < 4) {
#pragma unroll
            for (int i = 0; i < 32; ++i) kv[i] *= rk * gl[192 + sub * 32 + i]; }
        bf16_t* kvp = sub < 4 ? KF + ob * 192 + sub * 32 : VF + ob * 128 + (sub - 4) * 32;
#pragma unroll
        for (int j = 0; j < 4; ++j) { u32x4 w; w.x = cvt_pk_bf16(kv[8 * j], kv[8 * j + 1]); w.y = cvt_pk_bf16(kv[8 * j + 2], kv[8 * j + 3]); w.z = cvt_pk_bf16(kv[8 * j + 4], kv[8 * j + 5]); w.w = cvt_pk_bf16(kv[8 * j + 6], kv[8 * j + 7]);
            *(u32x4*)(kvp + 8 * j) = w; }
        { LDS_WAIT(); asm volatile("" ::: "memory");
          const f32x4 k0 = *(const f32x4*)(kb + sub * 8), k1 = *(const f32x4*)(kb + sub * 8 + 4);
          u32x4 w; w.x = cvt_pk_bf16(k0[0] * rk, k0[1] * rk); w.y = cvt_pk_bf16(k0[2] * rk, k0[3] * rk); w.z = cvt_pk_bf16(k1[0] * rk, k1[1] * rk); w.w = cvt_pk_bf16(k1[2] * rk, k1[3] * rk);
          *(u32x4*)(KF + ob * 192 + 128 + sub * 8) = w; }
        asm volatile("s_waitcnt lgkmcnt(0)" ::: "memory");
    }
    __syncthreads();
}

__global__ void __launch_bounds__(512, 2) fwd(Args args) {
    extern __shared__ __attribute__((aligned(16))) unsigned char lds[];
    Frame F;
    F.lds = (LAS unsigned char*)lds; F.ldsg = lds;
    F.tid = threadIdx.x; F.lane = F.tid & 63; F.wave = __builtin_amdgcn_readfirstlane(F.tid >> 6);
    F.G = gridDim.x; F.c = blockIdx.x; F.in = args.in; F.out = args.out; F.ws = args.ws;
    volatile LAS unsigned* MISC = (volatile LAS unsigned*)(F.lds + MISC_OFF);
    if (F.tid < 64) MISC[F.tid] = 0u;
    __syncthreads();
    XcdBarrier bar; bar.bar = (unsigned*)(F.ws + WS_CTL) + 4096; bar.x = 0; bar.st = nullptr;
    const bool single = args.single != 0;
    if (single) bar = xcd_barrier_post((unsigned*)(F.ws + WS_CTL) + 4096, MISC + 8);
    const int q_lo = args.q_lo, q_hi = args.q_hi;
#ifndef ONLY_PHASE
#define ONLY_PHASE -1
#endif
#define PEN(k) (ONLY_PHASE < 0 || ONLY_PHASE == (k))
#ifndef PROBE_MASK
#define PROBE_MASK 0
#endif
#define NREP(k) (((PROBE_MASK >> (k)) & 1) ? 2 : 1)
#define IN(q) (q_lo <= (q) && (q) < q_hi)
#define SEAM(q) do { if (single && (q) + 1 < q_hi) xcd_barrier(bar); } while (0)

    for (int rep_ = 0; rep_ < NREP(0); ++rep_) if (PEN(0) && IN(0)) { refresh_lane(F); phase_prologue(F); SEAM(0); }

    for (int layer = 0; layer < NLAYER; ++layer) {
        const int qb = 1 + layer * NPH;
        if (qb + NPH <= q_lo || qb >= q_hi) continue;
        const bf16_t* wl = (const bf16_t*)(F.ws + WS_W + (size_t)layer * W_LAYER);
        const float* mods_l = (const float*)(F.ws + WS_MODS) + (size_t)layer * 5 * 12288;
        const bool lastl = layer == NLAYER - 1;
        const bool nocopy0 = layer == 0 && F.G == 256;

        for (int rep_ = 0; rep_ < NREP(1); ++rep_) if (PEN(1) && IN(qb + 0)) { refresh_lane(F); phase_norm(F, MT, layer > 0 && F.G == 256, nocopy0 ? F.in[I_X] : (const float*)(F.ws + WS_X), nocopy0 ? F.in[I_CTX] : (const float*)(F.ws + WS_X) + (size_t)ML * DM, F.in[I_N1G] + layer * DM, mods_l, 0, 1); SEAM(qb + 0); }
        for (int rep_ = 0; rep_ < NREP(2); ++rep_) if (PEN(2) && IN(qb + 1)) { refresh_lane(F);
            pg8::Gemm g{(const bf16_t*)(F.ws + WS_H), wl + W_IN / 2, DM, DM}; pg8::SchedPlain S{36, 49, F.G, F.c, 0, 32};
            pg8::EpiZ E{(bf16_t*)(F.ws + WS_Z), (float*)(F.ws + WS_ZT)};
            pg8::gemm_phase<pg8::EpiZ, pg8::SchedPlain>(F.lds, g, S, E);
            SEAM(qb + 1);
        }
        for (int rep_ = 0; rep_ < NREP(3); ++rep_) if (PEN(3) && IN(qb + 2)) { refresh_lane(F);
            { pg8::Gemm g{(const bf16_t*)(F.ws + WS_Z), wl + W_QKV / 2, NZB, 512}; pg8::SchedPlain S{36, 14, F.G, F.c, 1, 8};
              pg8::EpiBf16 E{(bf16_t*)(F.ws + WS_QKVR), NQKV};
              for (int r2_ = 0; r2_ < NREP(24); ++r2_) pg8::gemm_phase<pg8::EpiBf16, pg8::SchedPlain>(F.lds, g, S, E); }
            __syncthreads();
            refresh_lane(F);
            for (int r2_ = 0; r2_ < NREP(21); ++r2_) gla_prep_units(F, layer);
            for (int r2_ = 0; r2_ < NREP(22); ++r2_) pool_rows(F);
            SEAM(qb + 2);
        }
        for (int rep_ = 0; rep_ < NREP(4); ++rep_) if (PEN(4) && IN(qb + 3)) { refresh_lane(F);
            for (int r2_ = 0; r2_ < NREP(20); ++r2_) post_up_rows(F, layer);
            SEAM(qb + 3);
        }
        for (int rep_ = 0; rep_ < NREP(5); ++rep_) if (PEN(5) && IN(qb + 4)) { refresh_lane(F);
            const bf16_t* QF = (const bf16_t*)(F.ws + WS_QF); const bf16_t* KF = (const bf16_t*)(F.ws + WS_KF); const bf16_t* VF = (const bf16_t*)(F.ws + WS_VF);
            bf16_t* O = (bf16_t*)(F.ws + WS_BR) + (size_t)MT * 1024;
            for (int i = F.c; i < 256 + (lastl ? 0 : 32); i += F.G) {
                int b, h, qpos, orow, seq;
                if (i < 256) { b = i >> 6; h = (i >> 3) & 7; const int qblk = i & 7; qpos = CTXL + qblk * 256; orow = b * SEQ + qblk * 256; seq = KPOS; }
                else { const int j = i - 256; b = j >> 3; h = j & 7; qpos = 0; orow = ML + b * CTXL; seq = CTXL; }
                const size_t hb = (size_t)(b * 8 + h) * KPOS;
                att::attn_body(QF + (hb + qpos) * 192, KF + hb * 192, VF + hb * 128, O + (size_t)orow * 1024 + h * 128, 1024, seq, (char*)lds);
            }
            for (int r2_ = 0; r2_ < NREP(25); ++r2_) for (int u = F.c; u < 256; u += F.G) { const int r8 = u >> 3; gla_scan_unit(F, (((u & 7) * 4 + (r8 >> 3)) << 3) | (r8 & 7), lastl ? 4 : 0, (F.G == 256 && !lastl) ? (layer + 1) * IT_LAYER + F.c * 4 + (F.wave & 3) : 0, (F.G == 256 && !lastl) ? (layer + 2) * IT_LAYER : 0, 1024); }
            SEAM(qb + 4);
        }
        for (int rep_ = 0; rep_ < NREP(6); ++rep_) if (PEN(6) && IN(qb + 5)) { refresh_lane(F); for (int r2_ = 0; r2_ < NREP(23); ++r2_) for (int u = F.c; u < NB * 4 * NCH; u += F.G) { if (lastl && (u % NCH) < 4) continue; gla_o_unit(F, layer, u); }
            refresh_lane(F);
            { pg8::Gemm g{(const bf16_t*)(F.ws + WS_POOLED), wl + W_P / 2, 1024, 256}; pg8::SchedPlain S{lastl ? 32 : 36, 4, F.G, F.G - 1 - F.c, 2, 4};
              pg8::EpiBf16 E{(bf16_t*)(F.ws + WS_BR), 1024};
              pg8::gemm_phase<pg8::EpiBf16, pg8::SchedPlain>(F.lds, g, S, E); }
            SEAM(qb + 5); }
        for (int rep_ = 0; rep_ < NREP(7); ++rep_) if (PEN(7) && IN(qb + 6)) { refresh_lane(F);
            pg8::Gemm g{(const bf16_t*)(F.ws + WS_BR), wl + W_B / 2, 1024, 1024}; pg8::SchedMerge S{F.G, F.c, !lastl};
            pg8::EpiMerge E{(const bf16_t*)(F.ws + WS_Z), (bf16_t*)(F.ws + WS_MERGED), (float*)(F.ws + WS_MSLAB)};
            pg8::gemm_phase<pg8::EpiMerge, pg8::SchedMerge>(F.lds, g, S, E);
            SEAM(qb + 6);
        }
        if (PEN(8) && IN(qb + 7)) { refresh_lane(F);
            if (!lastl && F.G == 256) {
                const int pmc = F.c >> 6, j = F.c & 7; const float* MS = (const float*)(F.ws + WS_MSLAB); bf16_t* MG = (bf16_t*)(F.ws + WS_MERGED);
#pragma unroll 4
                for (int i = 0; i < 32; ++i) { const int idx = F.tid + 512 * i, rowc = pmc * 256 + (idx >> 6), cc = 256 * j + (idx & 63) * 4;
                    f32x4 v = *(const f32x4*)(MS + (size_t)rowc * DM + cc);
#pragma unroll
                    for (int r = 1; r < 6; ++r) v += *(const f32x4*)(MS + ((size_t)r * MC + rowc) * DM + cc);
                    u32x2 w; w.x = cvt_pk_bf16(v[0], v[1]); w.y = cvt_pk_bf16(v[2], v[3]);
                    *(u32x2*)(MG + (size_t)(ML + rowc) * DM + cc) = w; }
                VM_WAIT(); __builtin_amdgcn_fence(__ATOMIC_ACQUIRE, "agent"); VM_WAIT(); __syncthreads();
            }
            pg8::Gemm g{(const bf16_t*)(F.ws + WS_MERGED), wl + W_O / 2, DM, DM}; pg8::SchedTail S{F.G, F.c, 32, !lastl};
            pg8::EpiResid E{(float*)(F.ws + WS_X), nullptr, mods_l + 2 * DM, (float*)(F.ws + WS_RSLAB), nocopy0 ? F.in[I_X] : (const float*)(F.ws + WS_X)};
            pg8::gemm_phase<pg8::EpiResid, pg8::SchedTail>(F.lds, g, S, E);
            SEAM(qb + 7);
        }
        for (int rep_ = 0; rep_ < NREP(9); ++rep_) if (PEN(9) && IN(qb + 8)) { refresh_lane(F); phase_norm(F, lastl ? ML : MT, !lastl && F.G == 256, (const float*)(F.ws + WS_X), nocopy0 ? F.in[I_CTX] : (const float*)(F.ws + WS_X) + (size_t)ML * DM, F.in[I_N2G] + layer * DM, mods_l, 3, 4); SEAM(qb + 8); }
        for (int rep_ = 0; rep_ < NREP(10); ++rep_) if (PEN(10) && IN(qb + 9)) { refresh_lane(F);
            pg8::Gemm g{(const bf16_t*)(F.ws + WS_H), wl + W_13 / 2, DM, DM}; pg8::SchedPlain S{lastl ? 32 : 36, 44, F.G, F.c, 0, 32};
            pg8::EpiSwiGLU E{(bf16_t*)(F.ws + WS_ACT)};
            pg8::gemm_phase<pg8::EpiSwiGLU, pg8::SchedPlain>(F.lds, g, S, E);
            SEAM(qb + 9);
        }
        if (PEN(11) && IN(qb + 10)) { refresh_lane(F);
            pg8::Gemm g{(const bf16_t*)(F.ws + WS_ACT), wl + W_2 / 2, FF, FF}; pg8::SchedTail S{F.G, F.c, 88, !lastl};
            pg8::EpiResid E{(float*)(F.ws + WS_X), lastl ? F.out : nullptr, mods_l + 5 * DM, (float*)(F.ws + WS_RSLAB), (const float*)(F.ws + WS_X)};
            pg8::gemm_phase<pg8::EpiResid, pg8::SchedTail>(F.lds, g, S, E);
            SEAM(qb + 10);
        }
    }
#undef IN
#undef SEAM
}

extern "C" void kernel_launch(void* const* d_in, const int* in_sizes, int n_in, void* d_out, int out_size, void* d_ws, size_t ws_size, hipStream_t stream) {
    static int grid = 0;
    if (grid == 0) {
        if (n_in != 25 || out_size != ML * DM || ws_size < WS_END) {
            fprintf(stderr, "kernel_launch: built for 25 inputs, out of %d floats, >= %zu bytes of workspace; got n_in %d, out %d, ws %zu; nothing launched\n", ML * DM, (size_t)WS_END, n_in, out_size, ws_size);
            grid = -1; return; }
        int dev = 0, cus = 0, per_cu = 0;
        if (hipGetDevice(&dev) != hipSuccess || hipDeviceGetAttribute(&cus, hipDeviceAttributeMultiprocessorCount, dev) != hipSuccess) { grid = -1; return; }
        if (hipFuncSetAttribute((const void*)fwd, hipFuncAttributeMaxDynamicSharedMemorySize, LDS_BYTES) != hipSuccess) { fprintf(stderr, "kernel_launch: hipFuncSetAttribute failed\n"); grid = -1; return; }
        if (hipOccupancyMaxActiveBlocksPerMultiprocessor(&per_cu, (const void*)fwd, 512, LDS_BYTES) != hipSuccess || per_cu < 1)
            fprintf(stderr, "kernel_launch: note: occupancy query reports %d workgroups per CU\n", per_cu);
        (void)hipGetLastError();
        grid = cus;
    }
    if (grid < 0) return;
    if (hipMemsetAsync((char*)d_ws + WS_CTL, 0, CTL_BYTES, stream) != hipSuccess) return;
    Args a{};
    for (int i = 0; i < 25; ++i) a.in[i] = (const float*)d_in[i];
    a.out = (float*)d_out; a.ws = (unsigned char*)d_ws; a.pad = 0;
    const int NQ = 1 + NLAYER * NPH;
#if MK_SINGLE
    a.q_lo = 0; a.q_hi = NQ; a.single = 1;
    hipLaunchKernelGGL(fwd, dim3(grid), dim3(512), LDS_BYTES, stream, a);
#else
    for (int q = 0; q < NQ; ++q) { a.q_lo = q; a.q_hi = q + 1; a.single = 0;
        hipLaunchKernelGGL(fwd, dim3(grid), dim3(512), LDS_BYTES, stream, a); }
#endif
    const hipError_t le = hipPeekAtLastError();
    if (le != hipSuccess) fprintf(stderr, "kernel_launch: launch failed: %s\n", hipGetErrorName(le));
}
```

```cpp
#include <hip/hip_runtime.h>
#include <cstdio>
#include <cstdint>

#ifndef MK_SINGLE
#define MK_SINGLE 1
#endif

#define LAS __attribute__((address_space(3)))
#define GAS __attribute__((address_space(1)))
typedef unsigned short bf16_t;
typedef short bf16x8 __attribute__((ext_vector_type(8)));
typedef short s16x4 __attribute__((ext_vector_type(4)));
typedef float f32x4 __attribute__((ext_vector_type(4)));
typedef float f32x16 __attribute__((ext_vector_type(16)));
typedef unsigned u32x4 __attribute__((ext_vector_type(4)));
typedef unsigned u32x2 __attribute__((ext_vector_type(2)));

constexpr int DM = 2048, NB = 4, SEQ = 2048, NLAYER = 4, CTXL = 256;
constexpr int ML = NB * SEQ, MC = NB * CTXL, MT = ML + MC;
constexpr int NZB = 12288, NZ = 12544;
constexpr int ZC_CQ = 0, ZC_CKV = 512, ZC_GK = 1024, ZC_GV = 2048, ZC_GQ = 3072, ZC_GG = 4096, ZC_PIN = 5120, ZC_GATE = 6144;
constexpr int ZT_KR = 0, ZT_LR = 64;
constexpr int FF = 5632, NQKV = 3584;
constexpr int KPOS = CTXL + SEQ;
constexpr int NCH = KPOS / 64;
constexpr int NGU = NB * 4 * 2 * NCH;
constexpr float RMS_EPS = 1e-6f;
constexpr int IN_COLS = 12384;

constexpr size_t al256(size_t x) { return (x + 255) / 256 * 256; }
constexpr size_t WS_CTL = 0, CTL_BYTES = 1u << 20;
constexpr size_t W_IN = 0, W_QKV = W_IN + (size_t)NZ * DM * 2, W_P = W_QKV + (size_t)NQKV * 512 * 2, W_B = W_P + (size_t)1024 * 256 * 2,
                 W_O = W_B + (size_t)3 * 2048 * 1024 * 2, W_13 = W_O + (size_t)DM * DM * 2, W_2 = W_13 + (size_t)2 * FF * DM * 2, W_LAYER = W_2 + (size_t)DM * FF * 2;
constexpr size_t WS_W = WS_CTL + CTL_BYTES;
constexpr size_t WS_MODS = WS_W + NLAYER * W_LAYER;
constexpr size_t WS_X = al256(WS_MODS + (size_t)NLAYER * 5 * 12288 * 4);
constexpr size_t WS_H = WS_X + (size_t)MT * DM * 4;
constexpr size_t WS_Z = WS_H + (size_t)MT * DM * 2;
constexpr size_t WS_ZT = WS_Z + (size_t)MT * NZB * 2;
constexpr size_t WS_QKVR = WS_ZT + (size_t)MT * 256 * 4;
constexpr size_t WS_QF = WS_QKVR + (size_t)MT * NQKV * 2;
constexpr size_t WS_KF = WS_QF + (size_t)NB * 8 * KPOS * 192 * 2;
constexpr size_t WS_VF = WS_KF + (size_t)NB * 8 * KPOS * 192 * 2;
constexpr size_t WS_GQ = WS_VF + (size_t)NB * 8 * KPOS * 128 * 2;
constexpr size_t WS_GKT = WS_GQ + (size_t)NGU * 64 * 256 * 2;
constexpr size_t WS_GVT = WS_GKT + (size_t)NGU * 64 * 256 * 2;
constexpr size_t WS_GP = WS_GVT + (size_t)NGU * 64 * 256 * 2;
constexpr size_t WS_GD = WS_GP + (size_t)NGU * 64 * 64 * 2;
constexpr size_t WS_SN = WS_GD + (size_t)NGU * 256 * 4;
constexpr size_t WS_BR = WS_SN + (size_t)NGU * 65536 * 2;
constexpr size_t WS_POOLED = WS_BR + (size_t)3 * MT * 1024 * 2;
constexpr size_t WS_MERGED = WS_POOLED + (size_t)MT * 1024 * 2;
constexpr size_t WS_RSLAB = WS_MERGED + (size_t)MT * DM * 2;
constexpr size_t WS_MSLAB = WS_RSLAB + (size_t)8 * MC * DM * 4;
constexpr size_t WS_ROPE = WS_MSLAB + (size_t)6 * MC * DM * 4;
constexpr size_t WS_END = WS_ROPE + 96 * 16 * 2 * 4;
constexpr size_t WS_MP = WS_GQ, WS_ACT = WS_Z;
static_assert((size_t)MT * DM * 4 <= (size_t)2 * NGU * 64 * 256 * 2, "MP overlay fits");
static_assert((size_t)MT * FF * 2 <= (size_t)MT * NZB * 2, "ACT overlay fits");

constexpr int RING_BYTES = 131072;
constexpr int MISC_OFF = RING_BYTES;
constexpr int LDS_BYTES = 147456;

__device__ __forceinline__ unsigned cvt_pk_bf16(float lo, float hi) { unsigned r; asm("v_cvt_pk_bf16_f32 %0, %1, %2" : "=v"(r) : "v"(lo), "v"(hi)); return r; }
__device__ __forceinline__ float bf2f(unsigned short b) { return __uint_as_float(((unsigned)b) << 16); }
__device__ __forceinline__ float bflo(unsigned w) { return __uint_as_float(w << 16); }
__device__ __forceinline__ float bfhi(unsigned w) { return __uint_as_float(w & 0xffff0000u); }
__device__ __forceinline__ bf16_t f2bf(float f) { return (bf16_t)(cvt_pk_bf16(f, 0.f) & 0xffffu); }
__device__ __forceinline__ float wave_sum(float v) {
#pragma unroll
    for (int o = 1; o < 64; o <<= 1) v += __shfl_xor(v, o);
    return v;
}
__device__ __forceinline__ float fast_sigmoid(float x) { return __builtin_amdgcn_rcpf(1.0f + __builtin_amdgcn_exp2f(-1.4426950408889634f * x)); }
__device__ __forceinline__ float fast_silu(float x) { return x * fast_sigmoid(x); }
__device__ __forceinline__ void atomic_add_f32(float* p, float v) { (void)__builtin_amdgcn_global_atomic_fadd_f32((GAS float*)p, v); }
#define LDS_WAIT() asm volatile("s_waitcnt lgkmcnt(0)" ::: "memory")
#define VM_WAIT() asm volatile("s_waitcnt vmcnt(0)" ::: "memory")

#define XB_TMO      128
#define XB_XCNT(j)  (256  + 64 * (j))
#define XB_XSUB(j)  (1280 + 64 * (j))
#define XB_XGEN(j)  (2304 + 64 * (j))
#define XB_TOP      3328
#define XB_TOPGEN   3392
#define XCD_BAR_WORDS 3456
#define XB_SPIN_CAP (1u << 18)
__device__ __forceinline__ unsigned xb_ld(unsigned* p)              { return __hip_atomic_load(p, __ATOMIC_RELAXED, __HIP_MEMORY_SCOPE_AGENT); }
__device__ __forceinline__ unsigned xb_add(unsigned* p, unsigned v) { return __hip_atomic_fetch_add(p, v, __ATOMIC_RELAXED, __HIP_MEMORY_SCOPE_AGENT); }
__device__ __forceinline__ unsigned xb_xcc_id() { return (unsigned)__builtin_amdgcn_s_getreg((3 << 11) | 20) & 0xFu; }
#define XB_SPIN(cond, bar) do { unsigned _sp = 0; while (cond) { __builtin_amdgcn_s_sleep(1); \
    if ((++_sp & 255u) == 0u) { if (xb_ld(&(bar)[XB_TMO])) break; if (_sp > XB_SPIN_CAP) { atomicAdd(&(bar)[XB_TMO], 1u); break; } } } } while (0)
struct XcdBarrier { unsigned* bar; unsigned x; volatile LAS unsigned* st; };
__device__ __forceinline__ XcdBarrier xcd_barrier_post(unsigned* bar, volatile LAS unsigned* st) {
    XcdBarrier b; b.bar = bar; b.x = xb_xcc_id(); b.st = st;
    if (threadIdx.x == 0) (void)xb_add(&bar[XB_XCNT(b.x)], 1u);
    return b;
}
__device__ __forceinline__ void xcd_barrier_complete(unsigned* bar, unsigned x, unsigned& nloc, unsigned& nx) {
    const unsigned G = gridDim.x * gridDim.y * gridDim.z;
    unsigned sum, cnt, mine, sp = 0u;
    for (;;) {
        sum = 0u; cnt = 0u; mine = 0u;
#pragma unroll
        for (unsigned j = 0; j < 16; ++j) { const unsigned c = xb_ld(&bar[XB_XCNT(j)]); sum += c; cnt += (c > 0u) ? 1u : 0u; mine = (j == x) ? c : mine; }
        if (sum == G) break;
        __builtin_amdgcn_s_sleep(1);
        if ((++sp & 255u) == 0u) { if (xb_ld(&bar[XB_TMO])) break; if (sp > XB_SPIN_CAP) { atomicAdd(&bar[XB_TMO], 1u); break; } }
    }
    nloc = mine > 0u ? mine : 1u; nx = cnt > 0u ? cnt : 1u;
}
__device__ __forceinline__ void xcd_barrier(const XcdBarrier& b) {
    asm volatile("s_waitcnt vmcnt(0)" ::: "memory");
    __syncthreads();
    if (threadIdx.x == 0) {
        unsigned* bar = b.bar;
        __builtin_amdgcn_s_waitcnt(0);
        unsigned nloc = b.st[0], nx = b.st[1];
        if (nloc == 0u) { xcd_barrier_complete(bar, b.x, nloc, nx); b.st[0] = nloc; b.st[1] = nx; }
        const unsigned old = xb_add(&bar[XB_XSUB(b.x)], 1u);
        const unsigned gen = old / nloc;
        if (old + 1u == (gen + 1u) * nloc) {
            __builtin_amdgcn_fence(__ATOMIC_RELEASE, "agent");
            asm volatile("s_waitcnt vmcnt(0)" ::: "memory");
            const unsigned og = xb_add(&bar[XB_TOP], 1u);
            const unsigned tg = og / nx;
            if (og + 1u == (tg + 1u) * nx) xb_add(&bar[XB_TOPGEN], 1u);
            else XB_SPIN(xb_ld(&bar[XB_TOPGEN]) == tg, bar);
            __builtin_amdgcn_fence(__ATOMIC_ACQUIRE, "agent");
            xb_add(&bar[XB_XGEN(b.x)], 1u);
            asm volatile("s_waitcnt vmcnt(0)" ::: "memory");
        } else {
            XB_SPIN(xb_ld(&bar[XB_XGEN(b.x)]) == gen, bar);
            __builtin_amdgcn_fence(__ATOMIC_ACQUIRE, "agent");
            asm volatile("s_waitcnt vmcnt(0)" ::: "memory");
        }
    }
    __syncthreads();
}

namespace pg8 {
constexpr int BM = 256, BK = 64, HALF = 128, HTB = HALF * BK * 2, STAGE_BYTES = 8 * HTB, NXCD = 8, WGM = 8;
__host__ __device__ __forceinline__ int lds_byte(int r, int c) { const int st = (r >> 4) * 2 + (c >> 5), rr = r & 15, cc = c & 31, ob = rr * 64 + cc * 2; return st * 1024 + (ob ^ (((ob >> 9) & 1) << 5)); }
__host__ __device__ __forceinline__ void stage_rc(int b, int& R, int& C) { const int st = b / 1024, sb = b % 1024, swz = sb ^ (((sb >> 9) & 1) << 5); R = (st >> 1) * 16 + swz / 64; C = (st & 1) * 32 + (swz % 64) / 2; }
__host__ __device__ __forceinline__ int perm32(int rho) { const int n = rho >> 4, i = rho & 15; return 8 * (i >> 2) + 4 * n + (i & 3); }

struct Unit { int pm, pn, ka, kb, nt, fl; };
struct Gemm { const bf16_t* A; const bf16_t* Bt; int lda, K; };

__device__ __forceinline__ void tile_of(int L, int nM, int nN, int& pm, int& pn) {
    const int nwg = nM * nN; int wgid = L;
    { const int q = nwg / NXCD, r = nwg % NXCD, xcd = wgid % NXCD, off = wgid / NXCD; wgid = (xcd < r ? xcd * (q + 1) : r * (q + 1) + (xcd - r) * q) + off; }
    const int nig = WGM * nN, gid = wgid / nig, fm = gid * WGM, gsz = (nM - fm) < WGM ? (nM - fm) : WGM;
    pm = fm + ((wgid % nig) % gsz); pn = (wgid % nig) / gsz;
}
struct SchedPlain {
    int nM, nN, G, c, mode, nt;
    __device__ __forceinline__ bool next(int i, Unit& u) const {
        const int L = i * G + c; if (L >= nM * nN) return false;
        tile_of(L, nM, nN, u.pm, u.pn);
        u.ka = (mode == 1) ? (u.pn < 6 ? ZC_CQ : ZC_CKV) : (mode == 2 ? 256 * u.pn : 0);
        u.kb = 0; u.nt = nt; u.fl = 0;
        return true;
    }
    __device__ __forceinline__ void a_ready(const Unit&) const {}
    __device__ __forceinline__ void done(const Unit&) const {}
};
struct SchedTail {
    int G, c, ntf; bool ctx;
    __device__ __forceinline__ bool next(int i, Unit& u) const {
        const bool fast = (G == 256), sub = fast && (i == 1);
        const int nM = fast ? 32 : (ctx ? 36 : 32), L = fast ? c : i * G + c;
        const bool ok = fast ? (i == 0 || (i == 1 && ctx)) : (L < nM * 8);
        int pm, pn; tile_of(ok ? L : 0, nM, 8, pm, pn);
        const int tile = c >> 3, j = c & 7, base = ntf >> 3, odd = base & 1;
        const int snt = odd ? (j < 4 ? base + 1 : base - 1) : base;
        const int skt = odd ? (j < 4 ? j * (base + 1) : 4 * (base + 1) + (j - 4) * (base - 1)) : j * base;
        Unit r; r.pm = sub ? 32 + (tile >> 3) : pm; r.pn = sub ? (tile & 7) : pn; r.ka = 0; r.kb = sub ? 64 * skt : 0; r.nt = sub ? snt : ntf; r.fl = sub ? 1 + j : 0;
        u = r; return ok;
    }
    __device__ __forceinline__ void a_ready(const Unit&) const {}
    __device__ __forceinline__ void done(const Unit&) const {}
};
struct SchedMerge {
    int G, c; bool ctx;
    __device__ __forceinline__ bool next(int i, Unit& u) const {
        const bool fast = (G == 256), sub = fast && (i == 3);
        const int nM = fast ? 32 : (ctx ? 36 : 32), T = fast ? c : (i / 3) * G + c;
        const bool ok = fast ? (i < 3 || (i == 3 && ctx && c < 192)) : (T < nM * 8);
        int pm, pn; tile_of(ok ? T : 0, nM, 8, pm, pn);
        const int tile = c / 6, rr = c - 6 * tile, sseg = rr >> 1, half = rr & 1;
        const int seg = sub ? sseg : (i % 3);
        Unit r; r.pm = seg * 36 + (sub ? 32 + (tile >> 3) : pm); r.pn = seg * 8 + (sub ? (tile & 7) : pn); r.ka = 0; r.kb = sub ? half * 512 : 0; r.nt = sub ? 8 : 16; r.fl = sub ? (4 | seg | (half << 3)) : seg;
        u = r; return ok;
    }
    __device__ __forceinline__ void a_ready(const Unit&) const {}
    __device__ __forceinline__ void done(const Unit&) const {}
};

struct EpiZ {
    static constexpr bool PERM = true, AFTER_DRAIN = false;
    __device__ __forceinline__ bool keep(const Unit&) const { return false; }
    bf16_t* Z; float* ZT;
    __device__ __forceinline__ void operator()(const f32x4 (&acc)[2][2][4][2], const Unit& u, int wr, int wc, int fr, int fq) const {
        const int row0 = u.pm * BM + wr * 64 + fr, cw = wc * 32 + 8 * fq;
        if (u.pn < 48) {
#pragma unroll
            for (int ai = 0; ai < 2; ++ai)
#pragma unroll
                for (int m = 0; m < 4; ++m) { bf16_t* rowp = Z + (size_t)(row0 + ai * HALF + m * 16) * NZB + u.pn * BM + cw;
#pragma unroll
                    for (int bj = 0; bj < 2; ++bj) { f32x4 v0 = acc[ai][bj][m][0], v1 = acc[ai][bj][m][1];
                        if (u.pn >= ZC_GATE / BM) {
#pragma unroll
                            for (int j = 0; j < 4; ++j) { v0[j] = fast_sigmoid(v0[j]); v1[j] = fast_sigmoid(v1[j]); } }
                        u32x4 w; w.x = cvt_pk_bf16(v0[0], v0[1]); w.y = cvt_pk_bf16(v0[2], v0[3]); w.z = cvt_pk_bf16(v1[0], v1[1]); w.w = cvt_pk_bf16(v1[2], v1[3]);
                        *(u32x4*)(rowp + bj * HALF) = w; } }
        } else {
#pragma unroll
            for (int ai = 0; ai < 2; ++ai)
#pragma unroll
                for (int m = 0; m < 4; ++m) { float* rowp = ZT + (size_t)(row0 + ai * HALF + m * 16) * 256 + cw;
#pragma unroll
                    for (int bj = 0; bj < 2; ++bj) { *(f32x4*)(rowp + bj * HALF) = acc[ai][bj][m][0]; *(f32x4*)(rowp + bj * HALF + 4) = acc[ai][bj][m][1]; } }
        }
    }
};
struct EpiBf16 {
    static constexpr bool PERM = true, AFTER_DRAIN = false;
    __device__ __forceinline__ bool keep(const Unit&) const { return false; }
    bf16_t* O; int ldc;
    __device__ __forceinline__ void operator()(const f32x4 (&acc)[2][2][4][2], const Unit& u, int wr, int wc, int fr, int fq) const {
        const int row0 = u.pm * BM + wr * 64 + fr, col0 = u.pn * BM + wc * 32 + 8 * fq;
#pragma unroll
        for (int ai = 0; ai < 2; ++ai)
#pragma unroll
            for (int m = 0; m < 4; ++m) { bf16_t* rowp = O + (size_t)(row0 + ai * HALF + m * 16) * ldc + col0;
#pragma unroll
                for (int bj = 0; bj < 2; ++bj) { const f32x4 v0 = acc[ai][bj][m][0], v1 = acc[ai][bj][m][1];
                    u32x4 w; w.x = cvt_pk_bf16(v0[0], v0[1]); w.y = cvt_pk_bf16(v0[2], v0[3]); w.z = cvt_pk_bf16(v1[0], v1[1]); w.w = cvt_pk_bf16(v1[2], v1[3]);
                    *(u32x4*)(rowp + bj * HALF) = w; } }
    }
};
struct EpiSwiGLU {
    static constexpr bool PERM = true, AFTER_DRAIN = false;
    __device__ __forceinline__ bool keep(const Unit&) const { return false; }
    bf16_t* ACT;
    __device__ __forceinline__ void operator()(const f32x4 (&acc)[2][2][4][2], const Unit& u, int wr, int wc, int fr, int fq) const {
        const int row0 = u.pm * BM + wr * 64 + fr, col0 = u.pn * HALF + wc * 32 + 8 * fq;
#pragma unroll
        for (int ai = 0; ai < 2; ++ai)
#pragma unroll
            for (int m = 0; m < 4; ++m) {
                float o[8];
#pragma unroll
                for (int n = 0; n < 2; ++n)
#pragma unroll
                    for (int j = 0; j < 4; ++j) o[4 * n + j] = fast_silu(acc[ai][0][m][n][j]) * acc[ai][1][m][n][j];
                u32x4 w; w.x = cvt_pk_bf16(o[0], o[1]); w.y = cvt_pk_bf16(o[2], o[3]); w.z = cvt_pk_bf16(o[4], o[5]); w.w = cvt_pk_bf16(o[6], o[7]);
                *(u32x4*)(ACT + (size_t)(row0 + ai * HALF + m * 16) * FF + col0) = w; }
    }
};
struct EpiResid {
    static constexpr bool PERM = true, AFTER_DRAIN = false;
    __device__ __forceinline__ bool keep(const Unit&) const { return false; }
    float* X; float* OUT; const float* gate; float* SLAB; const float* XS;
    __device__ __forceinline__ void operator()(const f32x4 (&acc)[2][2][4][2], const Unit& u, int wr, int wc, int fr, int fq) const {
        const int row0 = u.pm * BM + wr * 64 + fr, col0 = u.pn * BM + wc * 32 + 8 * fq;
        const int mr = u.pm < 32 ? (u.pm >> 3) : 4;
        const float* gp = gate + (size_t)mr * 12288 + col0;
        float* dst = (OUT != nullptr && u.pm < 32) ? OUT : X;
        f32x4 g[2][2];
#pragma unroll
        for (int bj = 0; bj < 2; ++bj)
#pragma unroll
            for (int n = 0; n < 2; ++n) g[bj][n] = *(const f32x4*)(gp + bj * HALF + 4 * n);
        if (u.fl) {
            float* sl = SLAB + (size_t)(u.fl - 1) * MC * DM;
#pragma unroll
            for (int ai = 0; ai < 2; ++ai)
#pragma unroll
                for (int m = 0; m < 4; ++m) { float* xp = sl + (size_t)(row0 - ML + ai * HALF + m * 16) * DM + col0;
#pragma unroll
                    for (int bj = 0; bj < 2; ++bj)
#pragma unroll
                        for (int n = 0; n < 2; ++n) *(f32x4*)(xp + bj * HALF + 4 * n) = g[bj][n] * acc[ai][bj][m][n]; }
            return;
        }
#pragma unroll
        for (int ai = 0; ai < 2; ++ai)
#pragma unroll
            for (int m = 0; m < 4; ++m) { const size_t off = (size_t)(row0 + ai * HALF + m * 16) * DM + col0;
#pragma unroll
                for (int bj = 0; bj < 2; ++bj)
#pragma unroll
                    for (int n = 0; n < 2; ++n) { const f32x4 x = *(const f32x4*)(XS + off + bj * HALF + 4 * n);
                        *(f32x4*)(dst + off + bj * HALF + 4 * n) = x + g[bj][n] * acc[ai][bj][m][n]; } }
    }
};
struct EpiMerge {
    static constexpr bool PERM = true, AFTER_DRAIN = false;
    const bf16_t* Z; bf16_t* MERGED; float* MSLAB;
    __device__ __forceinline__ bool keep(const Unit& u) const { return u.fl < 2; }
    __device__ __forceinline__ void operator()(f32x4 (&acc)[2][2][4][2], const Unit& u, int wr, int wc, int fr, int fq) const {
        const int seg = u.fl & 3, pm = u.pm - seg * 36, pn = u.pn - seg * 8; const bool sub = (u.fl & 4) != 0;
        const int row0 = pm * BM + wr * 64 + fr, col0 = pn * BM + wc * 32 + 8 * fq;
#pragma unroll
        for (int ai = 0; ai < 2; ++ai)
#pragma unroll
            for (int m = 0; m < 4; ++m) { const int row = row0 + ai * HALF + m * 16;
#pragma unroll
                for (int bj = 0; bj < 2; ++bj) {
                    const bf16_t* gp = Z + (size_t)row * NZB + ZC_GATE + seg * DM + col0 + bj * HALF;
                    const u32x4 gw = *(const u32x4*)gp;
                    const unsigned gv[4] = {gw.x, gw.y, gw.z, gw.w};
                    float f[8];
#pragma unroll
                    for (int j = 0; j < 4; ++j) { f[2 * j] = bflo(gv[j]); f[2 * j + 1] = bfhi(gv[j]); }
                    if (seg < 2 && !sub) {
                        const u32x4 hw = *(const u32x4*)(gp + DM); const unsigned hv[4] = {hw.x, hw.y, hw.z, hw.w};
#pragma unroll
                        for (int j = 0; j < 4; ++j) { f[2 * j] *= __builtin_amdgcn_rcpf(bflo(hv[j])); f[2 * j + 1] *= __builtin_amdgcn_rcpf(bfhi(hv[j])); }
                    }
                    f32x4 v0 = acc[ai][bj][m][0], v1 = acc[ai][bj][m][1];
#pragma unroll
                    for (int j = 0; j < 4; ++j) { v0[j] *= f[j]; v1[j] *= f[4 + j]; }
                    if (sub) { float* sp = MSLAB + ((size_t)(seg * 2 + ((u.fl >> 3) & 1)) * MC + (row - ML)) * DM + col0 + bj * HALF;
                        *(f32x4*)sp = v0; *(f32x4*)(sp + 4) = v1; }
                    else if (seg < 2) { acc[ai][bj][m][0] = v0; acc[ai][bj][m][1] = v1; }
                    else { u32x4 w; w.x = cvt_pk_bf16(v0[0], v0[1]); w.y = cvt_pk_bf16(v0[2], v0[3]); w.z = cvt_pk_bf16(v1[0], v1[1]); w.w = cvt_pk_bf16(v1[2], v1[3]);
                        *(u32x4*)(MERGED + (size_t)row * DM + col0 + bj * HALF) = w; } } }
    }
};

template <class Epi, class Sched, bool ALIGN_EPI = true>
__device__ __forceinline__ void gemm_phase(LAS unsigned char* lds, const Gemm g, const Sched& S, const Epi& E) {
    int tid = threadIdx.x; asm volatile("" : "+v"(tid));
    const int wid = __builtin_amdgcn_readfirstlane(tid >> 6), lane = tid & 63, wr = wid >> 2, wc = wid & 3, fr = lane & 15, fq = lane >> 4;
    int K = g.K, lda = g.lda; asm volatile("" : "+s"(K), "+s"(lda));
    unsigned voffA[2], voffB[2];
#pragma unroll
    for (int i = 0; i < 2; ++i) { int R, C; stage_rc(tid * 16 + i * 8192, R, C); const int Rb = Epi::PERM ? ((R & ~31) + perm32(R & 31)) : R;
        voffA[i] = (unsigned)(R * lda + C) * 2u; voffB[i] = (unsigned)(Rb * K + C) * 2u; }
    const size_t kstep = (size_t)(BK * 2);
    const size_t hstepA = (size_t)HALF * lda * 2, hstepB = (size_t)HALF * K * 2;
    const size_t tstepA = 2 * hstepA, tstepB = 2 * hstepB;
    const unsigned ldsw = (unsigned)wid * 1024u;
    const int aoff = lds_byte(wr * 64 + fr, fq * 8), boff = lds_byte(wc * 32 + fr, fq * 8);
#define PG8_SA(b, h) (((b) * 2 + (h)) * HTB)
#define PG8_SB(b, h) ((4 + (b) * 2 + (h)) * HTB)
#define PG8_STAGE(bufoff, gbase, voff) do { _Pragma("unroll") for (int _i = 0; _i < 2; ++_i) \
        __builtin_amdgcn_global_load_lds((const unsigned*)((const char*)(gbase) + (voff)[_i]), (LAS unsigned*)(lds + (bufoff) + ldsw + _i * 8192), 16, 0, 0); } while (0)
#define PG8_LDA(dst, b, h) do { _Pragma("unroll") for (int m = 0; m < 4; ++m) _Pragma("unroll") for (int k = 0; k < 2; ++k) dst[m][k] = *(const LAS bf16x8*)(lds + PG8_SA(b, h) + aoff + m * 2048 + k * 1024); } while (0)
#define PG8_LDB(dst, b, h) do { _Pragma("unroll") for (int n = 0; n < 2; ++n) _Pragma("unroll") for (int k = 0; k < 2; ++k) dst[n][k] = *(const LAS bf16x8*)(lds + PG8_SB(b, h) + boff + n * 2048 + k * 1024); } while (0)
#define PG8_MMA(ai, bj, At, Bt) do { __builtin_amdgcn_s_setprio(1); _Pragma("unroll") for (int m = 0; m < 4; ++m) _Pragma("unroll") for (int n = 0; n < 2; ++n) _Pragma("unroll") for (int k = 0; k < 2; ++k) \
        acc[ai][bj][m][n] = __builtin_amdgcn_mfma_f32_16x16x32_bf16(Bt[n][k], At[m][k], acc[ai][bj][m][n], 0, 0, 0); __builtin_amdgcn_s_setprio(0); } while (0)
#define PG8_WAIT_V(n) asm volatile("s_waitcnt vmcnt(" #n ")" ::: "memory")
#define PG8_WAIT_L(n) asm volatile("s_waitcnt lgkmcnt(" #n ")" ::: "memory")
#define PG8_BAR __builtin_amdgcn_s_barrier()
#define PG8_SCHED __builtin_amdgcn_sched_barrier(0)
    Unit cur, nxt; int ui = 0;
    if (!S.next(0, cur)) return;
    f32x4 acc[2][2][4][2];
#pragma unroll
    for (int a = 0; a < 2; ++a)
#pragma unroll
        for (int b = 0; b < 2; ++b)
#pragma unroll
            for (int m = 0; m < 4; ++m)
#pragma unroll
                for (int n = 0; n < 2; ++n) acc[a][b][m][n] = (f32x4){0.f, 0.f, 0.f, 0.f};
    bf16x8 At[4][2], B0[2][2], B1[2][2];
    const char* cA = (const char*)g.A + (size_t)cur.pm * tstepA + (size_t)(cur.ka + cur.kb) * 2; const char* cB = (const char*)g.Bt + (size_t)cur.pn * tstepB + (size_t)cur.kb * 2;
    S.a_ready(cur);
    PG8_STAGE(PG8_SB(0, 0), cB, voffB); PG8_STAGE(PG8_SB(0, 1), cB + hstepB, voffB); PG8_STAGE(PG8_SA(0, 0), cA, voffA); PG8_STAGE(PG8_SA(0, 1), cA + hstepA, voffA);
    if (wr == 1) PG8_BAR;
    PG8_WAIT_V(2); PG8_BAR;
    PG8_STAGE(PG8_SB(1, 0), cB + kstep, voffB); PG8_STAGE(PG8_SA(1, 0), cA + kstep, voffA); PG8_STAGE(PG8_SB(1, 1), cB + hstepB + kstep, voffB);
    PG8_WAIT_V(6); PG8_BAR;
    for (;;) {
        const bool has_next = S.next(ui + 1, nxt);
        const char* nA = has_next ? (const char*)g.A + (size_t)nxt.pm * tstepA + (size_t)(nxt.ka + nxt.kb) * 2 : cA; const char* nB = has_next ? (const char*)g.Bt + (size_t)nxt.pn * tstepB + (size_t)nxt.kb * 2 : cB;
        const int nt = cur.nt;
        for (int t = 0; t < nt; t += 2) {
            const bool last = (t == nt - 2);
            const char* a1 = cA + (size_t)(t + 1) * kstep;
            const char* a2 = last ? nA : cA + (size_t)(t + 2) * kstep; const char* b2 = last ? nB : cB + (size_t)(t + 2) * kstep;
            const char* a3 = a2 + kstep; const char* b3 = b2 + kstep;
            if (last && has_next) S.a_ready(nxt);
            PG8_LDB(B0, 0, 0); PG8_LDB(B1, 0, 1); PG8_SCHED; PG8_LDA(At, 0, 0); PG8_STAGE(PG8_SA(1, 1), a1 + hstepA, voffA);
            PG8_WAIT_V(8); PG8_WAIT_L(0); PG8_BAR; PG8_MMA(0, 0, At, B0); PG8_MMA(0, 1, At, B1); PG8_BAR; PG8_SCHED;
            PG8_LDA(At, 0, 1); PG8_STAGE(PG8_SB(0, 0), b2, voffB); PG8_STAGE(PG8_SB(0, 1), b2 + hstepB, voffB); PG8_STAGE(PG8_SA(0, 0), a2, voffA);
            PG8_WAIT_V(8); PG8_WAIT_L(0); PG8_BAR; PG8_MMA(1, 0, At, B0); PG8_MMA(1, 1, At, B1); PG8_BAR; PG8_SCHED;
            PG8_LDB(B0, 1, 0); PG8_LDB(B1, 1, 1); PG8_SCHED; PG8_LDA(At, 1, 0); PG8_STAGE(PG8_SA(0, 1), a2 + hstepA, voffA);
            PG8_WAIT_V(8); PG8_WAIT_L(0); PG8_BAR; PG8_MMA(0, 0, At, B0); PG8_MMA(0, 1, At, B1); PG8_BAR; PG8_SCHED;
            PG8_LDA(At, 1, 1); PG8_STAGE(PG8_SB(1, 0), b3, voffB); PG8_STAGE(PG8_SB(1, 1), b3 + hstepB, voffB); PG8_STAGE(PG8_SA(1, 0), a3, voffA);
            PG8_WAIT_V(8); PG8_WAIT_L(0); PG8_BAR; PG8_MMA(1, 0, At, B0); PG8_MMA(1, 1, At, B1); PG8_BAR; PG8_SCHED;
        }
        if constexpr (ALIGN_EPI) { if (wr == 0) PG8_BAR; }
        E(acc, cur, wr, wc, fr, fq); S.done(cur);
        if (!has_next) break;
        if (!E.keep(cur))
#pragma unroll
        for (int a = 0; a < 2; ++a)
#pragma unroll
            for (int b = 0; b < 2; ++b)
#pragma unroll
                for (int m = 0; m < 4; ++m)
#pragma unroll
                    for (int n = 0; n < 2; ++n) acc[a][b][m][n] = (f32x4){0.f, 0.f, 0.f, 0.f};
        cur = nxt; cA = nA; cB = nB; ++ui;
        if constexpr (ALIGN_EPI) { if (wr == 1) PG8_BAR; }
    }
    PG8_WAIT_V(0);
    if constexpr (!ALIGN_EPI) { if (wr == 0) PG8_BAR; }
    PG8_BAR;
#undef PG8_SA
#undef PG8_SB
#undef PG8_STAGE
#undef PG8_LDA
#undef PG8_LDB
#undef PG8_MMA
#undef PG8_WAIT_V
#undef PG8_WAIT_L
#undef PG8_BAR
#undef PG8_SCHED
}
}

namespace att {
constexpr int DQ = 192, DV = 128, NW = 8, QBLK = 32, KVBLK = 64;
constexpr float SCALE = 0.07216878364870322f;
constexpr float THR = 8.f;
constexpr int SHM_V = KVBLK * DV * 2, SHM_K = KVBLK * 400, SHM_ATTN = 2 * SHM_V + 2 * SHM_K + NW * 64 * 4;
#define KSWZ(row, colB) ((row) * 400 + (colB))
#define SBAR() __builtin_amdgcn_sched_barrier(0)
__device__ __forceinline__ int crow(int r, int hi) { return (r & 3) + 8 * (r >> 2) + 4 * hi; }
__device__ __forceinline__ unsigned cvtpk(float lo, float hi) { unsigned r; asm volatile("v_cvt_pk_bf16_f32 %0, %1, %2" : "=v"(r) : "v"(lo), "v"(hi)); return r; }
__device__ __forceinline__ void partialSM(f32x16& p0, f32x16& p1, float& m_reg, float& mn, float& alpha) {
    constexpr float C = SCALE * 1.4426950408889634f;
    float pmax = p0[0];
#pragma unroll
    for (int r = 1; r < 16; ++r) pmax = fmaxf(pmax, p0[r]);
#pragma unroll
    for (int r = 0; r < 16; ++r) pmax = fmaxf(pmax, p1[r]);
    { auto rr = __builtin_amdgcn_permlane32_swap(__float_as_uint(pmax), __float_as_uint(pmax), false, false);
      pmax = fmaxf(__uint_as_float(rr[0]), __uint_as_float(rr[1])); }
    if (__builtin_expect(__all(pmax - m_reg <= THR / SCALE), 1)) { mn = m_reg; alpha = 1.f; }
    else { mn = fmaxf(m_reg, pmax); alpha = __builtin_amdgcn_exp2f((m_reg - mn) * C); m_reg = mn; }
    const float mnC = -mn * C;
#pragma unroll
    for (int r = 0; r < 16; ++r) p0[r] = fmaf(p0[r], C, mnC);
#pragma unroll
    for (int r = 0; r < 16; ++r) p1[r] = fmaf(p1[r], C, mnC);
#pragma unroll
    for (int r = 0; r < 16; ++r) p0[r] = __builtin_amdgcn_exp2f(p0[r]);
}
__device__ __forceinline__ void finishSM(f32x16& p0, f32x16& p1, float alpha, float& l_reg, bf16x8& pa0, bf16x8& pa1, bf16x8& pa2, bf16x8& pa3) {
#pragma unroll
    for (int r = 0; r < 16; ++r) p1[r] = __builtin_amdgcn_exp2f(p1[r]);
    float ps = 0;
#pragma unroll
    for (int r = 0; r < 16; ++r) ps += p0[r];
#pragma unroll
    for (int r = 0; r < 16; ++r) ps += p1[r];
    { auto rr = __builtin_amdgcn_permlane32_swap(__float_as_uint(ps), __float_as_uint(ps), false, false);
      ps = __uint_as_float(rr[0]) + __uint_as_float(rr[1]); }
    l_reg = l_reg * alpha + ps;
#define PK4(P, BASE, OUT) do { unsigned a0 = cvtpk(P[BASE + 0], P[BASE + 1]), a1 = cvtpk(P[BASE + 2], P[BASE + 3]);   \
    unsigned b0 = cvtpk(P[BASE + 4], P[BASE + 5]), b1 = cvtpk(P[BASE + 6], P[BASE + 7]);                              \
    auto r0 = __builtin_amdgcn_permlane32_swap(a0, b0, false, false); auto r1 = __builtin_amdgcn_permlane32_swap(a1, b1, false, false); \
    u32x4 w = {r0[0], r1[0], r0[1], r1[1]}; OUT = *reinterpret_cast<bf16x8*>(&w); } while (0)
    PK4(p0, 0, pa0); PK4(p0, 8, pa1); PK4(p1, 0, pa2); PK4(p1, 8, pa3);
#undef PK4
}
__device__ __forceinline__ void qkt(f32x16& p0, f32x16& p1, const char* Ks, const bf16x8* qr, int r32, int hi) {
    p0 = f32x16{}; p1 = f32x16{};
#pragma unroll
    for (int d0 = 0; d0 < DQ / 16; ++d0) { const int cb = (d0 * 16 + hi * 8) * 2;
        const bf16x8 b0 = *reinterpret_cast<const bf16x8*>(Ks + KSWZ(r32, cb));
        const bf16x8 b1 = *reinterpret_cast<const bf16x8*>(Ks + KSWZ(32 + r32, cb));
        p0 = __builtin_amdgcn_mfma_f32_32x32x16_bf16(b0, qr[d0], p0, 0, 0, 0);
        p1 = __builtin_amdgcn_mfma_f32_32x32x16_bf16(b1, qr[d0], p1, 0, 0, 0); }
}
__device__ __forceinline__ int v_st(int k, int c) { const int kk = (k & ~0xC) | ((k & 4) << 1) | ((k & 8) >> 1); return ((kk >> 3) * 4 + (c >> 5)) * 512 + ((kk & 7) * 32 + (c & 31)) * 2; }
__device__ __forceinline__ int v_rd_base(int lane) { return ((lane & 3) << 3) | (((lane >> 2) & 3) << 6) | (((lane >> 4) & 1) << 5) | (((lane >> 5) & 1) << 8); }
constexpr int v_rd_off(int d0, int ks, int half) { return d0 * 512 + ks * 4096 + half * 2048; }
template <int OFF> __device__ __forceinline__ s16x4 tr_read(int vb) {
    s16x4 r; asm volatile("ds_read_b64_tr_b16 %0, %1 offset:%2" : "=&v"(r) : "v"(vb), "i"(OFF) : "memory"); return r;
}
template <int D0> __device__ __forceinline__ void pv_one(f32x16& od, int vb, bf16x8 pa0, bf16x8 pa1, bf16x8 pa2, bf16x8 pa3) {
    const s16x4 l0 = tr_read<v_rd_off(D0, 0, 0)>(vb), h0 = tr_read<v_rd_off(D0, 0, 1)>(vb), l1 = tr_read<v_rd_off(D0, 1, 0)>(vb), h1 = tr_read<v_rd_off(D0, 1, 1)>(vb);
    const s16x4 l2 = tr_read<v_rd_off(D0, 2, 0)>(vb), h2 = tr_read<v_rd_off(D0, 2, 1)>(vb), l3 = tr_read<v_rd_off(D0, 3, 0)>(vb), h3 = tr_read<v_rd_off(D0, 3, 1)>(vb);
    asm volatile("s_waitcnt lgkmcnt(0)" ::: "memory"); SBAR();
#define PK(L, H) (bf16x8){L[0], L[1], L[2], L[3], H[0], H[1], H[2], H[3]}
    od = __builtin_amdgcn_mfma_f32_32x32x16_bf16(pa0, PK(l0, h0), od, 0, 0, 0);
    od = __builtin_amdgcn_mfma_f32_32x32x16_bf16(pa1, PK(l1, h1), od, 0, 0, 0);
    od = __builtin_amdgcn_mfma_f32_32x32x16_bf16(pa2, PK(l2, h2), od, 0, 0, 0);
    od = __builtin_amdgcn_mfma_f32_32x32x16_bf16(pa3, PK(l3, h3), od, 0, 0, 0);
#undef PK
}
__device__ __forceinline__ void pv_d0(f32x16* o, int vb, bf16x8 pa0, bf16x8 pa1, bf16x8 pa2, bf16x8 pa3) {
    pv_one<0>(o[0], vb, pa0, pa1, pa2, pa3); pv_one<1>(o[1], vb, pa0, pa1, pa2, pa3); pv_one<2>(o[2], vb, pa0, pa1, pa2, pa3); pv_one<3>(o[3], vb, pa0, pa1, pa2, pa3);
}
__device__ __forceinline__ void attn_body(const bf16_t* __restrict__ Qb, const bf16_t* __restrict__ Kh, const bf16_t* __restrict__ Vh, bf16_t* __restrict__ Ob, int ldo, int seq, char* lds) {
    int tid = threadIdx.x; asm volatile("" : "+v"(tid));
    const int wid = tid >> 6, lane = tid & 63, r32 = lane & 31, hi = lane >> 5;
    char* V_lds = lds; char* K_lds = lds + 2 * SHM_V;
    float* ws = (float*)(lds + 2 * SHM_V + 2 * SHM_K) + wid * 64; float* li_l = ws; float* al_l = ws + 32;
    float m_reg = -1e30f, l_reg = 0; f32x16 o[4] = {}; bf16x8 qr[DQ / 16];
    const bf16_t* Qw = Qb + (size_t)(wid * QBLK + r32) * DQ + hi * 8;
#pragma unroll
    for (int d0 = 0; d0 < DQ / 16; ++d0) qr[d0] = *reinterpret_cast<const bf16x8*>(Qw + d0 * 16);
    const int sr = tid >> 4, sc = (tid & 15) * 8, vst0 = v_st(sr, sc), vst1 = v_st(32 + sr, sc);
    const int krow = tid >> 3, kseg = (tid & 7) * 16;
    const int kgo = krow * 384 + kseg, klo = krow * 400 + kseg;
    const int vb0 = (int)(uintptr_t)V_lds + v_rd_base(lane);
    bf16x8 vs0, vs1, ks0, ks1, ks2;
#define SLOAD(k0) do { vs0 = *reinterpret_cast<const bf16x8*>(&Vh[(size_t)((k0) + sr) * DV + sc]); vs1 = *reinterpret_cast<const bf16x8*>(&Vh[(size_t)((k0) + 32 + sr) * DV + sc]); \
    { const char* kp_ = (const char*)Kh + (size_t)(k0) * 384 + kgo; ks0 = *reinterpret_cast<const bf16x8*>(kp_); ks1 = *reinterpret_cast<const bf16x8*>(kp_ + 128); ks2 = *reinterpret_cast<const bf16x8*>(kp_ + 256); } } while (0)
#define SWRITE(b) do { *(bf16x8*)(V_lds + (b) * SHM_V + vst0) = vs0; *(bf16x8*)(V_lds + (b) * SHM_V + vst1) = vs1; \
    *(bf16x8*)(K_lds + (b) * SHM_K + klo) = ks0; *(bf16x8*)(K_lds + (b) * SHM_K + klo + 128) = ks1; *(bf16x8*)(K_lds + (b) * SHM_K + klo + 256) = ks2; } while (0)
#define SWAIT() asm volatile("s_waitcnt vmcnt(0)" ::: "memory")
#define RESC(a) do { if (__any((a) < 1.f)) { if (hi == 0) al_l[r32] = (a); asm volatile("s_waitcnt lgkmcnt(0)" ::: "memory"); \
    _Pragma("unroll") for (int d = 0; d < 4; ++d) _Pragma("unroll") for (int r = 0; r < 16; ++r) o[d][r] *= al_l[crow(r, hi)]; } } while (0)
    f32x16 p0, p1; float mn, al; bf16x8 pa0, pa1, pa2, pa3; const int NT = seq / KVBLK;
    const bool grpB = wid >= 4;
#define DO_QK(b) do { SBAR(); qkt(p0, p1, K_lds + (b) * SHM_K, qr, r32, hi); SBAR(); } while (0)
#define DO_SMPV(b) do { partialSM(p0, p1, m_reg, mn, al); RESC(al); finishSM(p0, p1, al, l_reg, pa0, pa1, pa2, pa3); SBAR(); pv_d0(o, vb0 + (b) * SHM_V, pa0, pa1, pa2, pa3); } while (0)
    SLOAD(0); SWAIT(); SWRITE(0);
    if (NT > 1) SLOAD(KVBLK);
    __syncthreads();
#pragma unroll 1
    for (int j = 0; j < NT; ++j) {
        const int bsel = j & 1;
        if (!grpB) DO_QK(bsel); else if (j > 0) DO_SMPV(bsel ^ 1);
        __syncthreads();
        if (j + 1 < NT) { SWAIT(); SWRITE(bsel ^ 1); if (j + 2 < NT) SLOAD((j + 2) * KVBLK); }
        if (!grpB) DO_SMPV(bsel); else DO_QK(bsel);
        __syncthreads();
    }
    if (grpB) DO_SMPV((NT - 1) & 1);
#undef DO_QK
#undef DO_SMPV
    if (hi == 0) li_l[r32] = l_reg; asm volatile("s_waitcnt lgkmcnt(0)" ::: "memory");
    float rli[16];
#pragma unroll
    for (int r = 0; r < 16; ++r) rli[r] = __builtin_amdgcn_rcpf(li_l[crow(r, hi)]);
    bf16_t* Ow = Ob + (size_t)(wid * QBLK) * ldo;
#pragma unroll
    for (int r = 0; r < 16; ++r) { const int orow = crow(r, hi);
#pragma unroll
        for (int d0 = 0; d0 < 4; ++d0) Ow[(size_t)orow * ldo + d0 * 32 + r32] = f2bf(o[d0][r] * rli[r]); }
    __syncthreads();
#undef SLOAD
#undef SWRITE
#undef SWAIT
#undef RESC
}
}

struct Args { const float* in[25]; float* out; unsigned char* ws; int q_lo, q_hi, single, pad; };
enum { I_X = 0, I_C, I_CTX, I_CCTX, I_WMOD, I_BMOD, I_N1G, I_N2G, I_WIN, I_QNG, I_WQUP, I_KVNG, I_WKVUP, I_QHG, I_KHG, I_GWG, I_GBG, I_GONG, I_PW, I_PS, I_WBR, I_WOUT, I_W1, I_W3, I_W2 };
constexpr int NPH = 11;

struct Frame {
    LAS unsigned char* lds; unsigned char* ldsg;
    int tid, lane, wave, G, c;
    const float* const* in; float* out; unsigned char* ws;
};

__device__ __forceinline__ void refresh_lane(Frame& F) { int t = threadIdx.x; asm volatile("" : "+v"(t)); F.tid = t; F.lane = t & 63;
    unsigned char* w = F.ws; int c = F.c, wv = F.wave; asm volatile("" : "+s"(w), "+s"(c), "+s"(wv)); F.ws = w; F.c = c; F.wave = wv; }
__device__ __forceinline__ int mod_row(int row) { return row < ML ? (row >> 11) : 4; }

__device__ __forceinline__ int win_dst_row(int n) {
    if (n < 512) return ZC_CKV + n;
    if (n < 576) return NZB + ZT_KR + (n - 512);
    if (n < 1600) return ZC_GK + (n - 576);
    if (n < 2624) return ZC_GV + (n - 1600);
    if (n < 2656) return NZB + ZT_LR + (n - 2624);
    if (n < 3168) return ZC_CQ + (n - 2656);
    if (n < 4192) return ZC_GQ + (n - 3168);
    if (n < 5216) return ZC_GG + (n - 4192);
    if (n < 6240) return ZC_PIN + (n - 5216);
    return ZC_GATE + (n - 6240);
}
constexpr int IT_IN = 32 * 387, IT_Q = 8 * 48, IT_KV = 8 * 64, IT_P = 4 * 4 * 8, IT_B = 3 * 16 * 64, IT_O = 32 * 64, IT_1 = 32 * 176, IT_2 = 88 * 64;
constexpr int IT_LAYER = IT_IN + IT_Q + IT_KV + IT_P + IT_B + IT_O + 2 * IT_1 + IT_2;
__device__ __forceinline__ void item_decode(const Frame& F, int it, const float*& src, int& ldsrc, int& c0, int& k0, bf16_t*& dst, int& lddst, int& r0, const float*& kscale, const float*& nscale) {
    const int l = it / IT_LAYER; int r = it % IT_LAYER;
    bf16_t* wl = (bf16_t*)(F.ws + WS_W + (size_t)l * W_LAYER);
    kscale = nullptr; nscale = nullptr;
    if (r < IT_IN) { const int kb = r / 387, nb = r % 387;
        src = F.in[I_WIN] + (size_t)l * DM * IN_COLS; ldsrc = IN_COLS; c0 = 32 * nb; k0 = 64 * kb; dst = wl + W_IN / 2; lddst = DM; r0 = win_dst_row(32 * nb); return; } r -= IT_IN;
    if (r < IT_Q) { const int kb = r / 48, nb = r % 48;
        src = F.in[I_WQUP] + (size_t)l * 512 * 1536; ldsrc = 1536; c0 = 32 * nb; k0 = 64 * kb; dst = wl + W_QKV / 2; lddst = 512; r0 = 32 * nb; kscale = F.in[I_QNG] + l * 512; return; } r -= IT_Q;
    if (r < IT_KV) { const int kb = r / 64, nb = r % 64;
        src = F.in[I_WKVUP] + (size_t)l * 512 * 2048; ldsrc = 2048; c0 = 32 * nb; k0 = 64 * kb; dst = wl + W_QKV / 2; lddst = 512; r0 = 1536 + 32 * nb; kscale = F.in[I_KVNG] + l * 512; return; } r -= IT_KV;
    if (r < IT_P) { const int g = r / 32, kb = (r % 32) / 8, nb = r % 8;
        src = F.in[I_PW] + ((size_t)l * 4 + g) * 65536; ldsrc = 256; c0 = 32 * nb; k0 = 64 * kb; dst = wl + W_P / 2; lddst = 256; r0 = g * 256 + 32 * nb; nscale = F.in[I_PS] + l * 1024 + g * 256 + 32 * nb; return; } r -= IT_P;
    if (r < IT_B) { const int n = r / 1024, kb = (r % 1024) / 64, nb = r % 64;
        src = F.in[I_WBR] + ((size_t)l * 3 + n) * 1024 * 2048; ldsrc = 2048; c0 = 32 * nb; k0 = 64 * kb; dst = wl + W_B / 2; lddst = 1024; r0 = n * 2048 + 32 * nb; return; } r -= IT_B;
    if (r < IT_O) { const int kb = r / 64, nb = r % 64;
        src = F.in[I_WOUT] + (size_t)l * DM * DM; ldsrc = DM; c0 = 32 * nb; k0 = 64 * kb; dst = wl + W_O / 2; lddst = DM; r0 = 32 * nb; return; } r -= IT_O;
    if (r < 2 * IT_1) { const int which = r / IT_1; r %= IT_1; const int kb = r / 176, nb = r % 176, n0 = 32 * nb;
        src = F.in[which ? I_W3 : I_W1] + (size_t)l * DM * FF; ldsrc = FF; c0 = n0; k0 = 64 * kb; dst = wl + W_13 / 2; lddst = DM; r0 = (n0 >> 7) * 256 + which * 128 + (n0 & 127); return; } r -= 2 * IT_1;
    { const int kb = r / 64, nb = r % 64;
        src = F.in[I_W2] + (size_t)l * FF * DM; ldsrc = DM; c0 = 32 * nb; k0 = 64 * kb; dst = wl + W_2 / 2; lddst = FF; r0 = 32 * nb; }
}
__device__ __forceinline__ void item_load(float (&v)[32], const float* src, int ldsrc, int c0, int k0, int lane) {
    const float* p = src + (size_t)(k0 + (lane >> 5)) * ldsrc + c0 + (lane & 31);
#pragma unroll
    for (int i = 0; i < 32; ++i) v[i] = p[(size_t)(2 * i) * ldsrc];
}
__device__ __forceinline__ void item_finish(const float (&v)[32], int k0, bf16_t* dst, int lddst, int r0, const float* kscale, const float* nscale, LAS float* scr, int lane) {
#pragma unroll
    for (int i = 0; i < 32; ++i) scr[(2 * i + (lane >> 5)) * 33 + (lane & 31)] = v[i];
    LDS_WAIT(); asm volatile("" ::: "memory");
    const int c = lane & 7;
    float ks[8];
#pragma unroll
    for (int i = 0; i < 8; ++i) ks[i] = kscale ? kscale[k0 + 8 * c + i] : 1.0f;
#pragma unroll
    for (int j = 0; j < 4; ++j) { const int n = (lane >> 3) + 8 * j; const LAS float* s = scr + (8 * c) * 33 + n; const float ns = nscale ? nscale[n] : 1.0f;
        u32x4 o; o.x = cvt_pk_bf16(s[0 * 33] * ks[0] * ns, s[1 * 33] * ks[1] * ns); o.y = cvt_pk_bf16(s[2 * 33] * ks[2] * ns, s[3 * 33] * ks[3] * ns);
        o.z = cvt_pk_bf16(s[4 * 33] * ks[4] * ns, s[5 * 33] * ks[5] * ns); o.w = cvt_pk_bf16(s[6 * 33] * ks[6] * ns, s[7 * 33] * ks[7] * ns);
        *(u32x4*)(dst + (size_t)(r0 + n) * lddst + k0 + 8 * c) = o; }
    LDS_WAIT(); asm volatile("" ::: "memory");
}
__device__ __forceinline__ void prologue_item(const Frame& F, int it, LAS float* scr) {
    const float* src; int ldsrc, c0, k0; bf16_t* dst; int lddst, r0; const float* kscale; const float* nscale;
    item_decode(F, it, src, ldsrc, c0, k0, dst, lddst, r0, kscale, nscale);
    float v[32];
    item_load(v, src, ldsrc, c0, k0, F.lane);
    item_finish(v, k0, dst, lddst, r0, kscale, nscale, scr, F.lane);
}
__device__ __forceinline__ void phase_prologue(const Frame& F) {
    { LAS float* scr = (LAS float*)(F.lds + F.wave * 8448);
      const int gw = F.c * 8 + F.wave, NGW = F.G * 8;
      for (int it = gw; it < (F.G == 256 ? 1 : NLAYER) * IT_LAYER; it += NGW) prologue_item(F, it, scr);
      const int gt = F.c * 512 + F.tid, NT = F.G * 512;
      for (int i = gt; i < NLAYER * 160 * (DM / 8); i += NT) { const int l = i / (160 * 256), rr = (i % (160 * 256)) / 256, cc = i % 256;
          *(u32x4*)((bf16_t*)(F.ws + WS_W + (size_t)l * W_LAYER + W_IN) + (size_t)(IN_COLS + rr) * DM + cc * 8) = (u32x4){0u, 0u, 0u, 0u}; } }
    __syncthreads();
    { float* sc = (float*)F.ldsg;
      float* red = (float*)(F.ldsg + 40960);
      for (int i = F.tid; i < 5 * DM; i += 512) { const int r = i >> 11, k = i & 2047; const float v = r < 4 ? F.in[I_C][r * DM + k] : F.in[I_CCTX][k]; sc[i] = v / (1.0f + __expf(-v)); }
      __syncthreads();
      float* mods = (float*)(F.ws + WS_MODS);
      for (int wb = F.c; wb < 256; wb += F.G) {
          const int l = wb >> 6, col0 = (wb & 63) * 192;
          const int cg = F.tid % 48, ksl = F.tid / 48;
          if (ksl < 10) {
              f32x4 a[5];
#pragma unroll
              for (int r = 0; r < 5; ++r) a[r] = (f32x4){0.f, 0.f, 0.f, 0.f};
              const float* wp = F.in[I_WMOD] + (size_t)l * DM * 12288 + col0 + 4 * cg;
#pragma unroll 8
              for (int k = ksl; k < DM; k += 10) { const f32x4 w = *(const f32x4*)(wp + (size_t)k * 12288);
#pragma unroll
                  for (int r = 0; r < 5; ++r) a[r] += w * sc[r * DM + k]; }
#pragma unroll
              for (int r = 0; r < 5; ++r) *(f32x4*)(red + (ksl * 5 + r) * 192 + 4 * cg) = a[r];
          }
          __syncthreads();
          for (int i = F.tid; i < 960; i += 512) { const int r = i / 192, j = i % 192; float s = F.in[I_BMOD][l * 12288 + col0 + j];
#pragma unroll
              for (int q = 0; q < 10; ++q) s += red[(q * 5 + r) * 192 + j];
              mods[((size_t)l * 5 + r) * 12288 + col0 + j] = s; }
          __syncthreads();
      } }
    { const int gt = F.c * 512 + F.tid;
      if (gt < 96 * 16) { const int pi = gt >> 4, i = gt & 15; const float invf = 1.0f / powf(10000.0f, (float)(2 * i) / 32.0f);
          const float ang = (float)(pi < 32 ? pi : pi - 32) * invf; float* rt = (float*)(F.ws + WS_ROPE) + gt * 2; rt[0] = cosf(ang); rt[1] = sinf(ang); } }
    if (F.G != 256) { const int gt = F.c * 512 + F.tid, NT = F.G * 512; f32x4* X = (f32x4*)(F.ws + WS_X);
      const f32x4* x = (const f32x4*)F.in[I_X]; const f32x4* cx = (const f32x4*)F.in[I_CTX];
      for (int i = gt; i < ML * DM / 4; i += NT) X[i] = x[i];
      for (int i = gt; i < MC * DM / 4; i += NT) X[ML * DM / 4 + i] = cx[i]; }
}

__device__ __forceinline__ void phase_norm(const Frame& F, int nrows, bool slabs, const float* xl, const float* xc, const float* ng, const float* mods_l, int ch_shift, int ch_scale) {
    float* X = (float*)(F.ws + WS_X); const float* SL = (const float*)(F.ws + WS_RSLAB); bf16_t* H = (bf16_t*)(F.ws + WS_H);
    const int step = F.G * 8;
    for (int rowA = F.c * 8 + F.wave; rowA < nrows; rowA += 2 * step) {
        const int rowB = rowA + step; const bool vb = rowB < nrows;
        const f32x4* xa = (const f32x4*)(rowA < ML ? xl + (size_t)rowA * DM : xc + (size_t)(rowA - ML) * DM) + F.lane;
        const f32x4* xb = (const f32x4*)(rowB < ML ? xl + (size_t)rowB * DM : xc + (size_t)(rowB - ML) * DM) + F.lane;
        f32x4 va[8], vbv[8];
#pragma unroll
        for (int j = 0; j < 8; ++j) va[j] = xa[64 * j];
        if (vb) {
#pragma unroll
            for (int j = 0; j < 8; ++j) vbv[j] = xb[64 * j];
        }
#pragma unroll
        for (int which = 0; which < 2; ++which) {
            if (which == 1 && !vb) break;
            const int row = which ? rowB : rowA;
            f32x4 v[8];
#pragma unroll
            for (int j = 0; j < 8; ++j) v[j] = which ? vbv[j] : va[j];
            if (slabs && row >= ML) {
#pragma unroll
                for (int q = 0; q < 8; ++q) { const f32x4* sr = (const f32x4*)(SL + ((size_t)q * MC + (row - ML)) * DM) + F.lane;
#pragma unroll
                    for (int j = 0; j < 8; ++j) v[j] += sr[64 * j]; }
                f32x4* xw = (f32x4*)(X + (size_t)row * DM) + F.lane;
#pragma unroll
                for (int j = 0; j < 8; ++j) xw[64 * j] = v[j];
            }
            float s = 0.f;
#pragma unroll
            for (int j = 0; j < 8; ++j) { s += (v[j][0] * v[j][0] + v[j][1] * v[j][1]) + (v[j][2] * v[j][2] + v[j][3] * v[j][3]); }
            const float rstd = rsqrtf(wave_sum(s) * (1.0f / DM) + RMS_EPS);
            const float* mp = mods_l + (size_t)mod_row(row) * 12288;
#pragma unroll
            for (int j = 0; j < 8; ++j) { const int col = 4 * (F.lane + 64 * j);
                const f32x4 g = *(const f32x4*)(ng + col), sh = *(const f32x4*)(mp + ch_shift * DM + col), sc = *(const f32x4*)(mp + ch_scale * DM + col);
                const f32x4 h = (v[j] * rstd * g) * (sc + 1.0f) + sh;
                u32x2 w; w.x = cvt_pk_bf16(h[0], h[1]); w.y = cvt_pk_bf16(h[2], h[3]);
                *(u32x2*)(H + (size_t)row * DM + col) = w; }
        }
    }
}

__device__ __forceinline__ int gla_row(int b, int dir, int n, int p) {
    if (n < 4) { const int s = 64 * n + p, t = dir ? (CTXL - 1 - s) : s; return ML + b * CTXL + t; }
    const int s = 64 * (n - 4) + p, t = dir ? (SEQ - 1 - s) : s; return b * SEQ + t;
}
__device__ __forceinline__ void gla_prep_units(const Frame& F, int layer) {
  const int tid = F.tid;
  u32x4 tq[4], tk[4], tv[4]; f32x4 tlr = (f32x4){0.f, 0.f, 0.f, 0.f};
#define PREP_LOAD(uu) do { const int n_ = (uu) % NCH, cd_ = (uu) / NCH, dir_ = cd_ & 1, h_ = (cd_ >> 1) & 3, b_ = cd_ >> 3; \
      _Pragma("unroll") for (int i = 0; i < 4; ++i) { const int idx = tid + 512 * i, p = idx >> 5, sg = (idx & 31) * 8; const bf16_t* zr = (const bf16_t*)(F.ws + WS_Z) + (size_t)gla_row(b_, dir_, n_, p) * NZB + h_ * 256 + sg; \
          tq[i] = *(const u32x4*)(zr + ZC_GQ); tk[i] = *(const u32x4*)(zr + ZC_GK); tv[i] = *(const u32x4*)(zr + ZC_GV); } \
      if (tid < 256) { const int p = tid >> 2, q4 = tid & 3; tlr = *(const f32x4*)((const float*)(F.ws + WS_ZT) + (size_t)gla_row(b_, dir_, n_, p) * 256 + ZT_LR + dir_ * 16 + q4 * 4); } } while (0)
  int u = F.c; if (u >= NGU) return;
  PREP_LOAD(u);
  for (; u < NGU; u += F.G) {
    const int n = u % NCH, cd = u / NCH, dir = cd & 1, bh = cd >> 1, h = bh & 3, b = bh >> 2;
    bf16_t* Ql = (bf16_t*)F.ldsg; bf16_t* Kl = (bf16_t*)(F.ldsg + 33792); bf16_t* Vl = (bf16_t*)(F.ldsg + 2 * 33792); float* lrs = (float*)(F.ldsg + 3 * 33792); float* hs = lrs + 1024;
    const bf16_t* Z = (const bf16_t*)(F.ws + WS_Z); const float* ZT = (const float*)(F.ws + WS_ZT);
    bf16_t* GQ = (bf16_t*)(F.ws + WS_GQ) + (size_t)u * 16384; bf16_t* GKT = (bf16_t*)(F.ws + WS_GKT) + (size_t)u * 16384; bf16_t* GVT = (bf16_t*)(F.ws + WS_GVT) + (size_t)u * 16384;
    bf16_t* GP = (bf16_t*)(F.ws + WS_GP) + (size_t)u * 4096; float* GD = (float*)(F.ws + WS_GD) + (size_t)u * 256;
    { if (tid < 256) { const int p = tid >> 2, q4 = tid & 3; *(f32x4*)(lrs + p * 16 + q4 * 4) = tlr; }
#pragma unroll
      for (int i = 0; i < 4; ++i) { const int idx = tid + 512 * i, p = idx >> 5, sg = (idx & 31) * 8;
          *(u32x4*)(Ql + p * 264 + sg) = tq[i]; *(u32x4*)(Kl + p * 264 + sg) = tk[i]; *(u32x4*)(Vl + p * 264 + sg) = tv[i]; } }
    const int d = tid & 255, hf = tid >> 8, col = h * 256 + d;
    float w[16];
#pragma unroll
    for (int r = 0; r < 16; ++r) w[r] = F.in[I_GWG][((size_t)(layer * 2 + dir) * 16 + r) * 1024 + col];
    const float bias = F.in[I_GBG][(layer * 2 + dir) * 1024 + col];
    __syncthreads();
    if (u + F.G < NGU) PREP_LOAD(u + F.G);
    float cum[32]; float run = 0.f;
#pragma unroll
    for (int i = 0; i < 32; ++i) { const int p = 32 * hf + i; float lg = bias;
#pragma unroll
        for (int r = 0; r < 16; ++r) lg += lrs[p * 16 + r] * w[r];
        const float ls = fminf(lg, 0.f) - __logf(1.0f + __expf(-fabsf(lg)));
        run += ls * (1.0f / 16.0f); cum[i] = run; }
    hs[hf * 256 + d] = run; __syncthreads();
    const float tot0 = hs[d], tot1 = hs[256 + d], last = tot0 + tot1, off = hf ? tot0 : 0.f, elast = __expf(last);
    unsigned khp[16], vvp[16];
#pragma unroll
    for (int i = 0; i < 32; i += 2) {
        float kh2[2]; unsigned short vv2[2];
#pragma unroll
        for (int e = 0; e < 2; ++e) { const int p = 32 * hf + i + e; const float cc = cum[i + e] + off;
            const float q = bf2f(Ql[p * 264 + d]), k = bf2f(Kl[p * 264 + d]); vv2[e] = Vl[p * 264 + d];
            const float ec = __expf(cc), kt = k * __builtin_amdgcn_rcpf(ec);
            Ql[p * 264 + d] = f2bf(q * 0.0625f * ec); Kl[p * 264 + d] = f2bf(kt);
            kh2[e] = kt * elast; }
        khp[i >> 1] = cvt_pk_bf16(kh2[0], kh2[1]); vvp[i >> 1] = (unsigned)vv2[0] | ((unsigned)vv2[1] << 16); }
#pragma unroll
    for (int q = 0; q < 4; ++q) { *(u32x4*)(GKT + d * 64 + 32 * hf + 8 * q) = (u32x4){khp[4 * q], khp[4 * q + 1], khp[4 * q + 2], khp[4 * q + 3]};
                                  *(u32x4*)(GVT + d * 64 + 32 * hf + 8 * q) = (u32x4){vvp[4 * q], vvp[4 * q + 1], vvp[4 * q + 2], vvp[4 * q + 3]}; }
    if (hf == 0) GD[d] = elast;
    __syncthreads();
#pragma unroll
    for (int i = 0; i < 4; ++i) { const int idx = tid + 512 * i, p = idx >> 5, sg = (idx & 31) * 8; *(u32x4*)(GQ + p * 256 + sg) = *(const u32x4*)(Ql + p * 264 + sg); }
    { const int l15 = F.lane & 15, l4 = F.lane >> 4, tb = F.wave >> 1;
#pragma unroll
      for (int q = 0; q < 2; ++q) { const int sb = 2 * (F.wave & 1) + q; f32x4 acc = (f32x4){0.f, 0.f, 0.f, 0.f};
          if (sb <= tb) {
#pragma unroll
              for (int kk = 0; kk < 8; ++kk) { const bf16x8 a = *(const bf16x8*)(Kl + (sb * 16 + l15) * 264 + kk * 32 + 8 * l4), bq = *(const bf16x8*)(Ql + (tb * 16 + l15) * 264 + kk * 32 + 8 * l4);
                  acc = __builtin_amdgcn_mfma_f32_16x16x32_bf16(a, bq, acc, 0, 0, 0); } }
          const int t = tb * 16 + l15, s0 = sb * 16 + 4 * l4;
          float o[4];
#pragma unroll
          for (int j = 0; j < 4; ++j) o[j] = (s0 + j <= t) ? acc[j] : 0.f;
          u32x2 wv; wv.x = cvt_pk_bf16(o[0], o[1]); wv.y = cvt_pk_bf16(o[2], o[3]);
          *(u32x2*)(GP + t * 64 + s0) = wv; } }
    __syncthreads();
  }
#undef PREP_LOAD
}

__device__ __forceinline__ void gla_scan_unit(const Frame& F, int unit, int snap_from, int it0, int it_end, int it_stride) {
    const int es = unit & 7, cd = unit >> 3;
    const int u0 = cd * NCH;
    const int l15 = F.lane & 15, l4 = F.lane >> 4, w = F.wave;
    bf16_t* Sl = (bf16_t*)(F.ldsg + 4 * 8448);
    if (w < 4) {
        const unsigned o64 = (unsigned)(l15 * 64 + 8 * l4) * 2u, od = (unsigned)(4 * l4) * 4u;
        const f32x4 z4 = (f32x4){0.f, 0.f, 0.f, 0.f};
        f32x4 S00 = z4, S01 = z4, S10 = z4, S11 = z4, S20 = z4, S21 = z4, S30 = z4, S31 = z4;
        bf16x8 vA00, vA01, vA10, vA11, kA00, kA01, kA10, kA11, kA20, kA21, kA30, kA31; f32x4 dA0, dA1, dA2, dA3;
        bf16x8 vB00, vB01, vB10, vB11, kB00, kB01, kB10, kB11, kB20, kB21, kB30, kB31; f32x4 dB0, dB1, dB2, dB3;
#define SCAN_LOAD(X, u) do { \
    const char* gv_ = (const char*)(F.ws + WS_GVT) + ((size_t)(u) * 16384 + es * 32 * 64) * 2 + o64; \
    v##X##00 = *(const bf16x8*)(gv_); v##X##01 = *(const bf16x8*)(gv_ + 64); v##X##10 = *(const bf16x8*)(gv_ + 2048); v##X##11 = *(const bf16x8*)(gv_ + 2048 + 64); \
    const char* gk_ = (const char*)(F.ws + WS_GKT) + ((size_t)(u) * 16384 + 64 * w * 64) * 2 + o64; \
    k##X##00 = *(const bf16x8*)(gk_); k##X##01 = *(const bf16x8*)(gk_ + 64); k##X##10 = *(const bf16x8*)(gk_ + 2048); k##X##11 = *(const bf16x8*)(gk_ + 2048 + 64); \
    k##X##20 = *(const bf16x8*)(gk_ + 4096); k##X##21 = *(const bf16x8*)(gk_ + 4096 + 64); k##X##30 = *(const bf16x8*)(gk_ + 6144); k##X##31 = *(const bf16x8*)(gk_ + 6144 + 64); \
    const char* gd_ = (const char*)(F.ws + WS_GD) + ((size_t)(u) * 256 + 64 * w) * 4 + od; \
    d##X##0 = *(const f32x4*)(gd_); d##X##1 = *(const f32x4*)(gd_ + 64); d##X##2 = *(const f32x4*)(gd_ + 128); d##X##3 = *(const f32x4*)(gd_ + 192); } while (0)
#define MF16(a, b, c) __builtin_amdgcn_mfma_f32_16x16x32_bf16(a, b, c, 0, 0, 0)
#define SCAN_PUT(sp, T) do { u32x2 wv_; wv_.x = cvt_pk_bf16(T[0], T[1]); wv_.y = cvt_pk_bf16(T[2], T[3]); *(u32x2*)(sp) = wv_; } while (0)
#define SCAN_STEP(X, n) do { \
    { bf16_t* sp = Sl + ((n) & 1) * (32 * 264) + l15 * 264 + 64 * w + 4 * l4; \
      SCAN_PUT(sp, S00); SCAN_PUT(sp + 16 * 264, S01); SCAN_PUT(sp + 16, S10); SCAN_PUT(sp + 16 * 264 + 16, S11); \
      SCAN_PUT(sp + 32, S20); SCAN_PUT(sp + 16 * 264 + 32, S21); SCAN_PUT(sp + 48, S30); SCAN_PUT(sp + 16 * 264 + 48, S31); } \
    asm volatile("s_waitcnt lgkmcnt(0)" ::: "memory"); __builtin_amdgcn_s_barrier(); asm volatile("" ::: "memory"); \
    S00 = S00 * d##X##0; S01 = S01 * d##X##0; S10 = S10 * d##X##1; S11 = S11 * d##X##1; S20 = S20 * d##X##2; S21 = S21 * d##X##2; S30 = S30 * d##X##3; S31 = S31 * d##X##3; \
    S00 = MF16(k##X##00, v##X##00, S00); S01 = MF16(k##X##00, v##X##10, S01); S10 = MF16(k##X##10, v##X##00, S10); S11 = MF16(k##X##10, v##X##10, S11); \
    S20 = MF16(k##X##20, v##X##00, S20); S21 = MF16(k##X##20, v##X##10, S21); S30 = MF16(k##X##30, v##X##00, S30); S31 = MF16(k##X##30, v##X##10, S31); \
    S00 = MF16(k##X##01, v##X##01, S00); S01 = MF16(k##X##01, v##X##11, S01); S10 = MF16(k##X##11, v##X##01, S10); S11 = MF16(k##X##11, v##X##11, S11); \
    S20 = MF16(k##X##21, v##X##01, S20); S21 = MF16(k##X##21, v##X##11, S21); S30 = MF16(k##X##31, v##X##01, S30); S31 = MF16(k##X##31, v##X##11, S31); } while (0)
        SCAN_LOAD(A, u0);
#pragma unroll 1
        for (int n = 0; n < NCH; n += 2) {
            SCAN_LOAD(B, u0 + n + 1);
            SCAN_STEP(A, n);
            SCAN_LOAD(A, u0 + (n + 2 < NCH ? n + 2 : NCH - 1));
            SCAN_STEP(B, n + 1);
        }
#undef SCAN_LOAD
#undef SCAN_STEP
#undef SCAN_PUT
#undef MF16
    } else {
        const int i = w - 4;
        LAS float* scr = (LAS float*)(F.lds + i * 8448);
        float cv[32], cw[32]; const float* c_src; int c_ld, c_c0, c_k0, c_ldd, c_r0; bf16_t* c_dst; const float* c_ks; const float* c_ns;
        const float* e_src; int e_ld, e_c0, e_k0, e_ldd, e_r0; bf16_t* e_dst; const float* e_ks; const float* e_ns; int it = it0;
        bool a_on = false, b_on = false;
#define CONV_ISSUE() do { a_on = it < it_end; b_on = it + it_stride < it_end; \
        if (a_on) { item_decode(F, it, c_src, c_ld, c_c0, c_k0, c_dst, c_ldd, c_r0, c_ks, c_ns); item_load(cv, c_src, c_ld, c_c0, c_k0, F.lane); } \
        if (b_on) { item_decode(F, it + it_stride, e_src, e_ld, e_c0, e_k0, e_dst, e_ldd, e_r0, e_ks, e_ns); item_load(cw, e_src, e_ld, e_c0, e_k0, F.lane); } \
        it += 2 * it_stride; } while (0)
#define CONV_FINISH() do { if (a_on) item_finish(cv, c_k0, c_dst, c_ldd, c_r0, c_ks, c_ns, scr, F.lane); \
        if (b_on) item_finish(cw, e_k0, e_dst, e_ldd, e_r0, e_ks, e_ns, scr, F.lane); a_on = false; b_on = false; } while (0)
#pragma unroll 1
        for (int n = 0; n < NCH; ++n) {
            asm volatile("" ::: "memory"); __builtin_amdgcn_s_barrier(); asm volatile("" ::: "memory");
            if (n >= snap_from) {
                const bf16_t* sl = Sl + (n & 1) * (32 * 264);
                bf16_t* sn = (bf16_t*)(F.ws + WS_SN) + ((size_t)(u0 + n) * 256 + es * 32) * 256;
                u32x4 t[4];
#pragma unroll
                for (int j = 0; j < 4; ++j) { const int c = i * 64 + F.lane + 256 * j; t[j] = *(const u32x4*)(sl + (c >> 5) * 264 + (c & 31) * 8); }
                asm volatile("s_waitcnt lgkmcnt(0)" ::: "memory");
#pragma unroll
                for (int j = 0; j < 4; ++j) { const int c = i * 64 + F.lane + 256 * j; *(u32x4*)(sn + (c >> 5) * 256 + (c & 31) * 8) = t[j]; }
            }
            if (n & 1) CONV_FINISH(); else CONV_ISSUE();
        }
        CONV_FINISH();
        while (it < it_end) { CONV_ISSUE(); CONV_FINISH(); }
#undef CONV_ISSUE
#undef CONV_FINISH
    }
    __syncthreads();
}
__device__ __forceinline__ void gla_o_unit(const Frame& F, int layer, int unit) {
    const int jj = unit % NCH, bh = unit / NCH, h = bh & 3, b = bh >> 2;
    const int l15 = F.lane & 15, l4 = F.lane >> 4, w = F.wave, tid = F.tid;
    const int row0 = jj < 4 ? (ML + b * CTXL + 64 * jj) : (b * SEQ + 64 * (jj - 4));
    const int nb = jj < 4 ? 3 - jj : 39 - jj;
    const size_t uf = (size_t)((bh * 2 + 0) * NCH + jj), ub = (size_t)((bh * 2 + 1) * NCH + nb);
    bf16_t* Ql = (bf16_t*)F.ldsg;
    bf16_t* Pl = (bf16_t*)(F.ldsg + 2 * 33792);
    float* part = (float*)(F.ldsg + 2 * 33792 + 2 * 9216);
    float* rs = part + 512;
    u32x4 tq[8], tp[2];
#pragma unroll
    for (int i = 0; i < 8; ++i) { const int idx = tid + 512 * i, dir = idx >> 11, r = idx & 2047;
        tq[i] = *(const u32x4*)((const char*)(F.ws + WS_GQ) + (dir ? ub : uf) * 32768 + (size_t)r * 16); }
#pragma unroll
    for (int i = 0; i < 2; ++i) { const int idx = tid + 512 * i, dir = idx >> 9, r = idx & 511;
        tp[i] = *(const u32x4*)((const char*)(F.ws + WS_GP) + (dir ? ub : uf) * 8192 + (size_t)r * 16); }
    const unsigned so = (unsigned)((32 * w + l15) * 512 + 16 * l4), vo = (unsigned)((32 * w + l15) * 128 + 16 * l4);
    bf16x8 sf[2][8], vf[2][2], sbk[2][8], vbk[2][2];
    { const char* sn = (const char*)(F.ws + WS_SN) + uf * 131072 + so; const char* gv = (const char*)(F.ws + WS_GVT) + uf * 32768 + vo;
#pragma unroll
      for (int eb = 0; eb < 2; ++eb) {
#pragma unroll
          for (int kk = 0; kk < 8; ++kk) sf[eb][kk] = *(const bf16x8*)(sn + eb * 8192 + kk * 64);
#pragma unroll
          for (int ss = 0; ss < 2; ++ss) vf[eb][ss] = *(const bf16x8*)(gv + eb * 2048 + ss * 64); } }
#pragma unroll
    for (int i = 0; i < 8; ++i) { const int idx = tid + 512 * i, dir = idx >> 11, r = idx & 2047; *(u32x4*)(Ql + dir * (64 * 264) + (r >> 5) * 264 + (r & 31) * 8) = tq[i]; }
#pragma unroll
    for (int i = 0; i < 2; ++i) { const int idx = tid + 512 * i, dir = idx >> 9, r = idx & 511; *(u32x4*)(Pl + dir * (64 * 72) + (r >> 3) * 72 + (r & 7) * 8) = tp[i]; }
    { const char* sn = (const char*)(F.ws + WS_SN) + ub * 131072 + so; const char* gv = (const char*)(F.ws + WS_GVT) + ub * 32768 + vo;
#pragma unroll
      for (int eb = 0; eb < 2; ++eb) {
#pragma unroll
          for (int kk = 0; kk < 8; ++kk) sbk[eb][kk] = *(const bf16x8*)(sn + eb * 8192 + kk * 64);
#pragma unroll
          for (int ss = 0; ss < 2; ++ss) vbk[eb][ss] = *(const bf16x8*)(gv + eb * 2048 + ss * 64); } }
    __syncthreads();
    f32x4 acc[4][2];
#pragma unroll
    for (int tb = 0; tb < 4; ++tb)
#pragma unroll
        for (int eb = 0; eb < 2; ++eb) acc[tb][eb] = (f32x4){0.f, 0.f, 0.f, 0.f};
#pragma unroll
    for (int dir = 0; dir < 2; ++dir) {
        const bf16_t* ql = Ql + dir * (64 * 264) + 8 * l4; const bf16_t* pl = Pl + dir * (64 * 72) + 8 * l4;
#pragma unroll
        for (int tb = 0; tb < 4; ++tb) { const int t = tb * 16 + l15, p = dir ? 63 - t : t;
#pragma unroll
            for (int kk = 0; kk < 8; ++kk) { const bf16x8 qa = *(const bf16x8*)(ql + p * 264 + kk * 32);
#pragma unroll
                for (int eb = 0; eb < 2; ++eb) acc[tb][eb] = __builtin_amdgcn_mfma_f32_16x16x32_bf16(dir ? sbk[eb][kk] : sf[eb][kk], qa, acc[tb][eb], 0, 0, 0); }
#pragma unroll
            for (int ss = 0; ss < 2; ++ss) { const bf16x8 pa = *(const bf16x8*)(pl + p * 72 + ss * 32);
#pragma unroll
                for (int eb = 0; eb < 2; ++eb) acc[tb][eb] = __builtin_amdgcn_mfma_f32_16x16x32_bf16(dir ? vbk[eb][ss] : vf[eb][ss], pa, acc[tb][eb], 0, 0, 0); } }
    }
#pragma unroll
    for (int tb = 0; tb < 4; ++tb) { float q = 0.f;
#pragma unroll
        for (int eb = 0; eb < 2; ++eb) q += (acc[tb][eb][0] * acc[tb][eb][0] + acc[tb][eb][1] * acc[tb][eb][1]) + (acc[tb][eb][2] * acc[tb][eb][2] + acc[tb][eb][3] * acc[tb][eb][3]);
        q += __shfl_xor(q, 16); q += __shfl_xor(q, 32);
        if (l4 == 0) part[(tb * 16 + l15) * 8 + w] = q; }
    __syncthreads();
    if (tid < 64) { float q = 0.f;
#pragma unroll
        for (int i = 0; i < 8; ++i) q += part[tid * 8 + i];
        rs[tid] = rsqrtf(q * (1.0f / 256.0f) + RMS_EPS); }
    __syncthreads();
    const bf16_t* Z = (const bf16_t*)(F.ws + WS_Z); bf16_t* O = (bf16_t*)(F.ws + WS_BR) + (size_t)2 * MT * 1024;
#pragma unroll
    for (int eb = 0; eb < 2; ++eb) { const int e = 32 * w + 16 * eb + 4 * l4; const f32x4 g = *(const f32x4*)(F.in[I_GONG] + layer * 256 + e);
#pragma unroll
        for (int tb = 0; tb < 4; ++tb) { const int t = tb * 16 + l15; const float r = rs[t]; const size_t row = (size_t)(row0 + t);
            const u32x2 gw = *(const u32x2*)(Z + row * NZB + ZC_GG + h * 256 + e);
            const f32x4 o = acc[tb][eb];
            u32x2 wv; wv.x = cvt_pk_bf16(o[0] * r * g[0] * fast_silu(bflo(gw.x)), o[1] * r * g[1] * fast_silu(bfhi(gw.x)));
            wv.y = cvt_pk_bf16(o[2] * r * g[2] * fast_silu(bflo(gw.y)), o[3] * r * g[3] * fast_silu(bfhi(gw.y)));
            *(u32x2*)(O + row * 1024 + h * 256 + e) = wv; } }
    __syncthreads();
}

__device__ __forceinline__ void pool_rows(const Frame& F) {
    const bf16_t* Z = (const bf16_t*)(F.ws + WS_Z); bf16_t* P = (bf16_t*)(F.ws + WS_POOLED);
    const int gt = F.c * 512 + F.tid, NT = F.G * 512;
    for (int idx = gt; idx < MT * 128; idx += NT) {
        const int row = idx >> 7, c0 = (idx & 127) * 8, gi = c0 >> 8, hw = 1 << gi;
        int base, t, L;
        if (row < ML) { base = row & ~(SEQ - 1); t = row & (SEQ - 1); L = SEQ; } else { const int r = row - ML; base = ML + (r & ~(CTXL - 1)); t = r & (CTXL - 1); L = CTXL; }
        const int lo = max(t - hw, 0), hi = min(t + hw - 1, L - 1);
        float s[8];
#pragma unroll
        for (int j = 0; j < 8; ++j) s[j] = 0.f;
        for (int i = lo; i <= hi; ++i) { const u32x4 v = *(const u32x4*)(Z + (size_t)(base + i) * NZB + ZC_PIN + c0);
            s[0] += bflo(v.x); s[1] += bfhi(v.x); s[2] += bflo(v.y); s[3] += bfhi(v.y); s[4] += bflo(v.z); s[5] += bfhi(v.z); s[6] += bflo(v.w); s[7] += bfhi(v.w); }
        const u32x4 v = *(const u32x4*)(Z + (size_t)row * NZB + ZC_PIN + c0);
        const float ic = 1.0f / (float)(hi - lo + 1);
        u32x4 o; o.x = cvt_pk_bf16(s[0] * ic - bflo(v.x), s[1] * ic - bfhi(v.x)); o.y = cvt_pk_bf16(s[2] * ic - bflo(v.y), s[3] * ic - bfhi(v.y));
        o.z = cvt_pk_bf16(s[4] * ic - bflo(v.z), s[5] * ic - bfhi(v.z)); o.w = cvt_pk_bf16(s[6] * ic - bflo(v.w), s[7] * ic - bfhi(v.w));
        *(u32x4*)(P + (size_t)row * 1024 + c0) = o;
    }
}

__device__ __forceinline__ void post_up_rows(const Frame& F, int layer) {
    const bf16_t* Z = (const bf16_t*)(F.ws + WS_Z); const float* ZT = (const float*)(F.ws + WS_ZT); const bf16_t* R = (const bf16_t*)(F.ws + WS_QKVR);
    bf16_t* QF = (bf16_t*)(F.ws + WS_QF); bf16_t* KF = (bf16_t*)(F.ws + WS_KF); bf16_t* VF = (bf16_t*)(F.ws + WS_VF);
    const float* rope = (const float*)(F.ws + WS_ROPE);
    const int lane = F.lane, h = lane >> 3, sub = lane & 7;
    float* gl = (float*)F.ldsg;
    float* qs = (float*)(F.ldsg + 2048) + F.wave * (8 * 192);
    float* kb = (float*)(F.ldsg + 2048 + 8 * 8 * 192 * 4) + F.wave * 64;
    for (int i = F.tid; i < 384; i += 512) gl[i] = i < 192 ? F.in[I_QHG][layer * 192 + i] : F.in[I_KHG][layer * 192 + (i - 192)];
    __syncthreads();
    u32x4 n_ca, n_cc, n_qw[3], n_kw[4]; float n_kr = 0.f;
#define PU_LOAD(r_) do { const bf16_t* rr_ = R + (size_t)(r_) * NQKV; \
        n_ca = *(const u32x4*)(Z + (size_t)(r_) * NZB + ZC_CQ + 8 * lane); n_cc = *(const u32x4*)(Z + (size_t)(r_) * NZB + ZC_CKV + 8 * lane); n_kr = ZT[(size_t)(r_) * 256 + ZT_KR + lane]; \
        _Pragma("unroll") for (int j = 0; j < 3; ++j) n_qw[j] = *(const u32x4*)(rr_ + h * 192 + sub * 24 + 8 * j); \
        _Pragma("unroll") for (int j = 0; j < 4; ++j) n_kw[j] = *(const u32x4*)(rr_ + 1536 + h * 256 + sub * 32 + 8 * j); } while (0)
    { const int r0_ = F.c * 8 + F.wave; if (r0_ < MT) PU_LOAD(r0_); }
    for (int row = F.c * 8 + F.wave; row < MT; row += F.G * 8) {
        int b, pos, prow = 0, pcol = 0; const bool lat = row < ML;
        if (lat) { b = row >> 11; const int t = row & (SEQ - 1); pos = CTXL + t; prow = t >> 6; pcol = 32 + (t & 63); }
        else { const int r = row - ML; b = r >> 8; pos = r & (CTXL - 1); }
        const u32x4 ca = n_ca, cc = n_cc; const float kr = n_kr;
        u32x4 qw[3], kw[4];
#pragma unroll
        for (int j = 0; j < 3; ++j) qw[j] = n_qw[j];
#pragma unroll
        for (int j = 0; j < 4; ++j) kw[j] = n_kw[j];
        if (row + F.G * 8 < MT) PU_LOAD(row + F.G * 8);
        float sq = 0.f, skv = 0.f;
        { const unsigned aw[4] = {ca.x, ca.y, ca.z, ca.w}, cw[4] = {cc.x, cc.y, cc.z, cc.w};
#pragma unroll
          for (int j = 0; j < 4; ++j) { sq += bflo(aw[j]) * bflo(aw[j]) + bfhi(aw[j]) * bfhi(aw[j]); skv += bflo(cw[j]) * bflo(cw[j]) + bfhi(cw[j]) * bfhi(cw[j]); } }
        const float rq = rsqrtf(wave_sum(sq) * (1.0f / 512.0f) + RMS_EPS), rkv = rsqrtf(wave_sum(skv) * (1.0f / 512.0f) + RMS_EPS);
        const float kr2 = wave_sum(kr * kr);
        { float x = kr * gl[192 + 128 + lane];
          if (lat) { const float* cs = rope + ((lane < 32 ? prow : pcol) * 16 + (lane & 15)) * 2; const float pr = __shfl_xor(x, 16);
              x = (lane & 16) ? (x * cs[0] + pr * cs[1]) : (x * cs[0] - pr * cs[1]); }
          kb[lane] = x; }
        float q[24]; float ss = 0.f;
#pragma unroll
        for (int j = 0; j < 3; ++j) { const unsigned w4[4] = {qw[j].x, qw[j].y, qw[j].z, qw[j].w};
#pragma unroll
            for (int e = 0; e < 4; ++e) { q[8 * j + 2 * e] = bflo(w4[e]) * rq; q[8 * j + 2 * e + 1] = bfhi(w4[e]) * rq; } }
#pragma unroll
        for (int i = 0; i < 24; ++i) ss += q[i] * q[i];
        ss += __shfl_xor(ss, 1); ss += __shfl_xor(ss, 2); ss += __shfl_xor(ss, 4);
        const float rh = rsqrtf(ss * (1.0f / 192.0f) + RMS_EPS);
#pragma unroll
        for (int i = 0; i < 24; ++i) q[i] *= rh * gl[sub * 24 + i];
        if (lat) {
            float* qh = qs + h * 192 + sub * 24;
#pragma unroll
            for (int j = 0; j < 6; ++j) *(f32x4*)(qh + 4 * j) = (f32x4){q[4 * j], q[4 * j + 1], q[4 * j + 2], q[4 * j + 3]};
            LDS_WAIT(); asm volatile("" ::: "memory");
            if (sub >= 5) {
#pragma unroll
                for (int i = 0; i < 24; ++i) { const int dd = sub * 24 + i;
                    if (dd >= 128) { const int r = dd - 128; const float pr = qs[h * 192 + 128 + (r ^ 16)];
                        const float* cs = rope + ((r < 32 ? prow : pcol) * 16 + (r & 15)) * 2;
                        q[i] = (r & 16) ? (q[i] * cs[0] + pr * cs[1]) : (q[i] * cs[0] - pr * cs[1]); } }
            }
        }
        const size_t ob = ((size_t)(b * 8 + h) * KPOS + pos);
#pragma unroll
        for (int j = 0; j < 3; ++j) { u32x4 w; w.x = cvt_pk_bf16(q[8 * j], q[8 * j + 1]); w.y = cvt_pk_bf16(q[8 * j + 2], q[8 * j + 3]); w.z = cvt_pk_bf16(q[8 * j + 4], q[8 * j + 5]); w.w = cvt_pk_bf16(q[8 * j + 6], q[8 * j + 7]);
            *(u32x4*)(QF + ob * 192 + sub * 24 + 8 * j) = w; }
        float kv[32]; float sk = 0.f;
#pragma unroll
        for (int j = 0; j < 4; ++j) { const unsigned w4[4] = {kw[j].x, kw[j].y, kw[j].z, kw[j].w};
#pragma unroll
            for (int e = 0; e < 4; ++e) { kv[8 * j + 2 * e] = bflo(w4[e]) * rkv; kv[8 * j + 2 * e + 1] = bfhi(w4[e]) * rkv; } }
        if (sub < 4) {
#pragma unroll
            for (int i = 0; i < 32; ++i) sk += kv[i] * kv[i]; }
        sk += __shfl_xor(sk, 1); sk += __shfl_xor(sk, 2); sk += __shfl_xor(sk, 4);
        const float rk = rsqrtf((sk + kr2) * (1.0f / 192.0f) + RMS_EPS);
        if (sub < 4) {
#pragma unroll
            for (int i = 0; i < 32; ++i) kv[i] *= rk * gl[192 + sub * 32 + i]; }
        bf16_t* kvp = sub < 4 ? KF + ob * 192 + sub * 32 : VF + ob * 128 + (sub - 4) * 32;
#pragma unroll
        for (int j = 0; j < 4; ++j) { u32x4 w; w.x = cvt_pk_bf16(kv[8 * j], kv[8 * j + 1]); w.y = cvt_pk_bf16(kv[8 * j + 2], kv[8 * j + 3]); w.z = cvt_pk_bf16(kv[8 * j + 4], kv[8 * j + 5]); w.w = cvt_pk_bf16(kv[8 * j + 6], kv[8 * j + 7]);
            *(u32x4*)(kvp + 8 * j) = w; }
        { LDS_WAIT(); asm volatile("" ::: "memory");
          const f32x4 k0 = *(const f32x4*)(kb + sub * 8), k1 = *(const f32x4*)(kb + sub * 8 + 4);
          u32x4 w; w.x = cvt_pk_bf16(k0[0] * rk, k0[1] * rk); w.y = cvt_pk_bf16(k0[2] * rk, k0[3] * rk); w.z = cvt_pk_bf16(k1[0] * rk, k1[1] * rk); w.w = cvt_pk_bf16(k1[2] * rk, k1[3] * rk);
          *(u32x4*)(KF + ob * 192 + 128 + sub * 8) = w; }
        asm volatile("s_waitcnt lgkmcnt(0)" ::: "memory");
    }
#undef PU_LOAD
    __syncthreads();
}

__global__ void __launch_bounds__(512, 2) fwd(Args args) {
    extern __shared__ __attribute__((aligned(16))) unsigned char lds[];
    Frame F;
    F.lds = (LAS unsigned char*)lds; F.ldsg = lds;
    F.tid = threadIdx.x; F.lane = F.tid & 63; F.wave = __builtin_amdgcn_readfirstlane(F.tid >> 6);
    F.G = gridDim.x; F.c = blockIdx.x; F.in = args.in; F.out = args.out; F.ws = args.ws;
    volatile LAS unsigned* MISC = (volatile LAS unsigned*)(F.lds + MISC_OFF);
    if (F.tid < 64) MISC[F.tid] = 0u;
    __syncthreads();
    XcdBarrier bar; bar.bar = (unsigned*)(F.ws + WS_CTL) + 4096; bar.x = 0; bar.st = nullptr;
    const bool single = args.single != 0;
    if (single) bar = xcd_barrier_post((unsigned*)(F.ws + WS_CTL) + 4096, MISC + 8);
    const int q_lo = args.q_lo, q_hi = args.q_hi;
#ifndef ONLY_PHASE
#define ONLY_PHASE -1
#endif
#define PEN(k) (ONLY_PHASE < 0 || ONLY_PHASE == (k))
#ifndef PROBE_MASK
#define PROBE_MASK 0
#endif
#define NREP(k) (((PROBE_MASK >> (k)) & 1) ? 2 : 1)
#define IN(q) (q_lo <= (q) && (q) < q_hi)
#define SEAM(q) do { if (single && (q) + 1 < q_hi) xcd_barrier(bar); } while (0)

    for (int rep_ = 0; rep_ < NREP(0); ++rep_) if (PEN(0) && IN(0)) { refresh_lane(F); phase_prologue(F); SEAM(0); }

    for (int layer = 0; layer < NLAYER; ++layer) {
        const int qb = 1 + layer * NPH;
        if (qb + NPH <= q_lo || qb >= q_hi) continue;
        const bf16_t* wl = (const bf16_t*)(F.ws + WS_W + (size_t)layer * W_LAYER);
        const float* mods_l = (const float*)(F.ws + WS_MODS) + (size_t)layer * 5 * 12288;
        const bool lastl = layer == NLAYER - 1;
        const bool nocopy0 = layer == 0 && F.G == 256;

        for (int rep_ = 0; rep_ < NREP(1); ++rep_) if (PEN(1) && IN(qb + 0)) { refresh_lane(F); phase_norm(F, MT, layer > 0 && F.G == 256, nocopy0 ? F.in[I_X] : (const float*)(F.ws + WS_X), nocopy0 ? F.in[I_CTX] : (const float*)(F.ws + WS_X) + (size_t)ML * DM, F.in[I_N1G] + layer * DM, mods_l, 0, 1); SEAM(qb + 0); }
        for (int rep_ = 0; rep_ < NREP(2); ++rep_) if (PEN(2) && IN(qb + 1)) { refresh_lane(F);
            pg8::Gemm g{(const bf16_t*)(F.ws + WS_H), wl + W_IN / 2, DM, DM}; pg8::SchedPlain S{36, 49, F.G, F.c, 0, 32};
            pg8::EpiZ E{(bf16_t*)(F.ws + WS_Z), (float*)(F.ws + WS_ZT)};
            pg8::gemm_phase<pg8::EpiZ, pg8::SchedPlain>(F.lds, g, S, E);
            SEAM(qb + 1);
        }
        for (int rep_ = 0; rep_ < NREP(3); ++rep_) if (PEN(3) && IN(qb + 2)) { refresh_lane(F);
            { pg8::Gemm g{(const bf16_t*)(F.ws + WS_Z), wl + W_QKV / 2, NZB, 512}; pg8::SchedPlain S{36, 14, F.G, F.c, 1, 8};
              pg8::EpiBf16 E{(bf16_t*)(F.ws + WS_QKVR), NQKV};
              for (int r2_ = 0; r2_ < NREP(24); ++r2_) pg8::gemm_phase<pg8::EpiBf16, pg8::SchedPlain>(F.lds, g, S, E); }
            __syncthreads();
            refresh_lane(F);
            for (int r2_ = 0; r2_ < NREP(21); ++r2_) gla_prep_units(F, layer);
            for (int r2_ = 0; r2_ < NREP(22); ++r2_) pool_rows(F);
            SEAM(qb + 2);
        }
        for (int rep_ = 0; rep_ < NREP(4); ++rep_) if (PEN(4) && IN(qb + 3)) { refresh_lane(F);
            for (int r2_ = 0; r2_ < NREP(20); ++r2_) post_up_rows(F, layer);
            __syncthreads();
            { pg8::Gemm g{(const bf16_t*)(F.ws + WS_POOLED), wl + W_P / 2, 1024, 256}; pg8::SchedPlain S{lastl ? 32 : 36, 4, F.G, F.G - 1 - F.c, 2, 4};
              pg8::EpiBf16 E{(bf16_t*)(F.ws + WS_BR), 1024};
              pg8::gemm_phase<pg8::EpiBf16, pg8::SchedPlain>(F.lds, g, S, E); }
            SEAM(qb + 3);
        }
        for (int rep_ = 0; rep_ < NREP(5); ++rep_) if (PEN(5) && IN(qb + 4)) { refresh_lane(F);
            const bf16_t* QF = (const bf16_t*)(F.ws + WS_QF); const bf16_t* KF = (const bf16_t*)(F.ws + WS_KF); const bf16_t* VF = (const bf16_t*)(F.ws + WS_VF);
            bf16_t* O = (bf16_t*)(F.ws + WS_BR) + (size_t)MT * 1024;
            for (int i = F.c; i < 256 + (lastl ? 0 : 32); i += F.G) {
                int b, h, qpos, orow, seq;
                if (i < 256) { b = i >> 6; h = (i >> 3) & 7; const int qblk = i & 7; qpos = CTXL + qblk * 256; orow = b * SEQ + qblk * 256; seq = KPOS; }
                else { const int j = i - 256; b = j >> 3; h = j & 7; qpos = 0; orow = ML + b * CTXL; seq = CTXL; }
                const size_t hb = (size_t)(b * 8 + h) * KPOS;
                att::attn_body(QF + (hb + qpos) * 192, KF + hb * 192, VF + hb * 128, O + (size_t)orow * 1024 + h * 128, 1024, seq, (char*)lds);
            }
            for (int r2_ = 0; r2_ < NREP(25); ++r2_) for (int u = F.c; u < 256; u += F.G) { const int r8 = u >> 3; gla_scan_unit(F, (((u & 7) * 4 + (r8 >> 3)) << 3) | (r8 & 7), lastl ? 4 : 0, (F.G == 256 && !lastl) ? (layer + 1) * IT_LAYER + F.c * 4 + (F.wave & 3) : 0, (F.G == 256 && !lastl) ? (layer + 2) * IT_LAYER : 0, 1024); }
            SEAM(qb + 4);
        }
        for (int rep_ = 0; rep_ < NREP(6); ++rep_) if (PEN(6) && IN(qb + 5)) { refresh_lane(F); for (int r2_ = 0; r2_ < NREP(23); ++r2_) for (int u = F.c; u < NB * 4 * NCH; u += F.G) { if (lastl && (u % NCH) < 4) continue; gla_o_unit(F, layer, u); }
            SEAM(qb + 5); }
        for (int rep_ = 0; rep_ < NREP(7); ++rep_) if (PEN(7) && IN(qb + 6)) { refresh_lane(F);
            pg8::Gemm g{(const bf16_t*)(F.ws + WS_BR), wl + W_B / 2, 1024, 1024}; pg8::SchedMerge S{F.G, F.c, !lastl};
            pg8::EpiMerge E{(const bf16_t*)(F.ws + WS_Z), (bf16_t*)(F.ws + WS_MERGED), (float*)(F.ws + WS_MSLAB)};
            pg8::gemm_phase<pg8::EpiMerge, pg8::SchedMerge>(F.lds, g, S, E);
            SEAM(qb + 6);
        }
        if (PEN(8) && IN(qb + 7)) { refresh_lane(F);
            if (!lastl && F.G == 256) {
                const int pmc = F.c >> 6, j = F.c & 7; const float* MS = (const float*)(F.ws + WS_MSLAB); bf16_t* MG = (bf16_t*)(F.ws + WS_MERGED);
#pragma unroll 4
                for (int i = 0; i < 32; ++i) { const int idx = F.tid + 512 * i, rowc = pmc * 256 + (idx >> 6), cc = 256 * j + (idx & 63) * 4;
                    f32x4 v = *(const f32x4*)(MS + (size_t)rowc * DM + cc);
#pragma unroll
                    for (int r = 1; r < 6; ++r) v += *(const f32x4*)(MS + ((size_t)r * MC + rowc) * DM + cc);
                    u32x2 w; w.x = cvt_pk_bf16(v[0], v[1]); w.y = cvt_pk_bf16(v[2], v[3]);
                    *(u32x2*)(MG + (size_t)(ML + rowc) * DM + cc) = w; }
                VM_WAIT(); __builtin_amdgcn_fence(__ATOMIC_ACQUIRE, "agent"); VM_WAIT(); __syncthreads();
            }
            pg8::Gemm g{(const bf16_t*)(F.ws + WS_MERGED), wl + W_O / 2, DM, DM}; pg8::SchedTail S{F.G, F.c, 32, !lastl};
            pg8::EpiResid E{(float*)(F.ws + WS_X), nullptr, mods_l + 2 * DM, (float*)(F.ws + WS_RSLAB), nocopy0 ? F.in[I_X] : (const float*)(F.ws + WS_X)};
            pg8::gemm_phase<pg8::EpiResid, pg8::SchedTail>(F.lds, g, S, E);
            SEAM(qb + 7);
        }
        for (int rep_ = 0; rep_ < NREP(9); ++rep_) if (PEN(9) && IN(qb + 8)) { refresh_lane(F); phase_norm(F, lastl ? ML : MT, !lastl && F.G == 256, (const float*)(F.ws + WS_X), nocopy0 ? F.in[I_CTX] : (const float*)(F.ws + WS_X) + (size_t)ML * DM, F.in[I_N2G] + layer * DM, mods_l, 3, 4); SEAM(qb + 8); }
        for (int rep_ = 0; rep_ < NREP(10); ++rep_) if (PEN(10) && IN(qb + 9)) { refresh_lane(F);
            pg8::Gemm g{(const bf16_t*)(F.ws + WS_H), wl + W_13 / 2, DM, DM}; pg8::SchedPlain S{lastl ? 32 : 36, 44, F.G, F.c, 0, 32};
            pg8::EpiSwiGLU E{(bf16_t*)(F.ws + WS_ACT)};
            pg8::gemm_phase<pg8::EpiSwiGLU, pg8::SchedPlain>(F.lds, g, S, E);
            SEAM(qb + 9);
        }
        if (PEN(11) && IN(qb + 10)) { refresh_lane(F);
            pg8::Gemm g{(const bf16_t*)(F.ws + WS_ACT), wl + W_2 / 2, FF, FF}; pg8::SchedTail S{F.G, F.c, 88, !lastl};
            pg8::EpiResid E{(float*)(F.ws + WS_X), lastl ? F.out : nullptr, mods_l + 5 * DM, (float*)(F.ws + WS_RSLAB), (const float*)(F.ws + WS_X)};
            pg8::gemm_phase<pg8::EpiResid, pg8::SchedTail>(F.lds, g, S, E);
            SEAM(qb + 10);
        }
    }
#undef IN
#undef SEAM
}

extern "C" void kernel_launch(void* const* d_in, const int* in_sizes, int n_in, void* d_out, int out_size, void* d_ws, size_t ws_size, hipStream_t stream) {
    static int grid = 0;
    if (grid == 0) {
        if (n_in != 25 || out_size != ML * DM || ws_size < WS_END) {
            fprintf(stderr, "kernel_launch: built for 25 inputs, out of %d floats, >= %zu bytes of workspace; got n_in %d, out %d, ws %zu; nothing launched\n", ML * DM, (size_t)WS_END, n_in, out_size, ws_size);
            grid = -1; return; }
        int dev = 0, cus = 0, per_cu = 0;
        if (hipGetDevice(&dev) != hipSuccess || hipDeviceGetAttribute(&cus, hipDeviceAttributeMultiprocessorCount, dev) != hipSuccess) { grid = -1; return; }
        if (hipFuncSetAttribute((const void*)fwd, hipFuncAttributeMaxDynamicSharedMemorySize, LDS_BYTES) != hipSuccess) { fprintf(stderr, "kernel_launch: hipFuncSetAttribute failed\n"); grid = -1; return; }
        if (hipOccupancyMaxActiveBlocksPerMultiprocessor(&per_cu, (const void*)fwd, 512, LDS_BYTES) != hipSuccess || per_cu < 1)
            fprintf(stderr, "kernel_launch: note: occupancy query reports %d workgroups per CU\n", per_cu);
        (void)hipGetLastError();
        grid = cus;
    }
    if (grid < 0) return;
    if (hipMemsetAsync((char*)d_ws + WS_CTL, 0, CTL_BYTES, stream) != hipSuccess) return;
    Args a{};
    for (int i = 0; i < 25; ++i) a.in[i] = (const float*)d_in[i];
    a.out = (float*)d_out; a.ws = (unsigned char*)d_ws; a.pad = 0;
    const int NQ = 1 + NLAYER * NPH;
#if MK_SINGLE
    a.q_lo = 0; a.q_hi = NQ; a.single = 1;
    hipLaunchKernelGGL(fwd, dim3(grid), dim3(512), LDS_BYTES, stream, a);
#else
    for (int q = 0; q < NQ; ++q) { a.q_lo = q; a.q_hi = q + 1; a.single = 0;
        hipLaunchKernelGGL(fwd, dim3(grid), dim3(512), LDS_BYTES, stream, a); }
#endif
    const hipError_t le = hipPeekAtLastError();
    if (le != hipSuccess) fprintf(stderr, "kernel_launch: launch failed: %s\n", hipGetErrorName(le));
}
```

```cpp
#include <hip/hip_runtime.h>
#include <cstdio>
#include <cstdint>

#ifndef MK_SINGLE
#define MK_SINGLE 1
#endif

#define LAS __attribute__((address_space(3)))
#define GAS __attribute__((address_space(1)))
typedef unsigned short bf16_t;
typedef short bf16x8 __attribute__((ext_vector_type(8)));
typedef short s16x4 __attribute__((ext_vector_type(4)));
typedef float f32x4 __attribute__((ext_vector_type(4)));
typedef float f32x16 __attribute__((ext_vector_type(16)));
typedef unsigned u32x4 __attribute__((ext_vector_type(4)));
typedef unsigned u32x2 __attribute__((ext_vector_type(2)));

constexpr int DM = 2048, NB = 4, SEQ = 2048, NLAYER = 4, CTXL = 256;
constexpr int ML = NB * SEQ, MC = NB * CTXL, MT = ML + MC;
constexpr int NZB = 12288, NZ = 12544;
constexpr int ZC_CQ = 0, ZC_CKV = 512, ZC_GK = 1024, ZC_GV = 2048, ZC_GQ = 3072, ZC_GG = 4096, ZC_PIN = 5120, ZC_GATE = 6144;
constexpr int ZT_KR = 0, ZT_LR = 64;
constexpr int FF = 5632, NQKV = 3584;
constexpr int KPOS = CTXL + SEQ;
constexpr int NCH = KPOS / 64;
constexpr int NGU = NB * 4 * 2 * NCH;
constexpr float RMS_EPS = 1e-6f;
constexpr int IN_COLS = 12384;

constexpr size_t al256(size_t x) { return (x + 255) / 256 * 256; }
constexpr size_t WS_CTL = 0, CTL_BYTES = 1u << 20;
constexpr size_t W_IN = 0, W_QKV = W_IN + (size_t)NZ * DM * 2, W_P = W_QKV + (size_t)NQKV * 512 * 2, W_B = W_P + (size_t)1024 * 256 * 2,
                 W_O = W_B + (size_t)3 * 2048 * 1024 * 2, W_13 = W_O + (size_t)DM * DM * 2, W_2 = W_13 + (size_t)2 * FF * DM * 2, W_LAYER = W_2 + (size_t)DM * FF * 2;
constexpr size_t WS_W = WS_CTL + CTL_BYTES;
constexpr size_t WS_MODS = WS_W + NLAYER * W_LAYER;
constexpr size_t WS_X = al256(WS_MODS + (size_t)NLAYER * 5 * 12288 * 4);
constexpr size_t WS_H = WS_X + (size_t)MT * DM * 4;
constexpr size_t WS_Z = WS_H + (size_t)MT * DM * 2;
constexpr size_t WS_ZT = WS_Z + (size_t)MT * NZB * 2;
constexpr size_t WS_QKVR = WS_ZT + (size_t)MT * 256 * 4;
constexpr size_t WS_QF = WS_QKVR + (size_t)MT * NQKV * 2;
constexpr size_t WS_KF = WS_QF + (size_t)NB * 8 * KPOS * 192 * 2;
constexpr size_t WS_VF = WS_KF + (size_t)NB * 8 * KPOS * 192 * 2;
constexpr size_t WS_GQ = WS_VF + (size_t)NB * 8 * KPOS * 128 * 2;
constexpr size_t WS_GKT = WS_GQ + (size_t)NGU * 64 * 256 * 2;
constexpr size_t WS_GVT = WS_GKT + (size_t)NGU * 64 * 256 * 2;
constexpr size_t WS_GP = WS_GVT + (size_t)NGU * 64 * 256 * 2;
constexpr size_t WS_GD = WS_GP + (size_t)NGU * 64 * 64 * 2;
constexpr size_t WS_SN = WS_GD + (size_t)NGU * 256 * 4;
constexpr size_t WS_BR = WS_SN + (size_t)NGU * 65536 * 2;
constexpr size_t WS_POOLED = WS_BR + (size_t)3 * MT * 1024 * 2;
constexpr size_t WS_MERGED = WS_POOLED + (size_t)MT * 1024 * 2;
constexpr size_t WS_RSLAB = WS_MERGED + (size_t)MT * DM * 2;
constexpr size_t WS_MSLAB = WS_RSLAB + (size_t)8 * MC * DM * 4;
constexpr size_t WS_ROPE = WS_MSLAB + (size_t)6 * MC * DM * 4;
constexpr size_t WS_END = WS_ROPE + 96 * 16 * 2 * 4;
constexpr size_t WS_MP = WS_GQ, WS_ACT = WS_Z;
static_assert((size_t)MT * DM * 4 <= (size_t)2 * NGU * 64 * 256 * 2, "MP overlay fits");
static_assert((size_t)MT * FF * 2 <= (size_t)MT * NZB * 2, "ACT overlay fits");

constexpr int RING_BYTES = 131072;
constexpr int MISC_OFF = RING_BYTES;
constexpr int LDS_BYTES = 147456;

__device__ __forceinline__ unsigned cvt_pk_bf16(float lo, float hi) { unsigned r; asm("v_cvt_pk_bf16_f32 %0, %1, %2" : "=v"(r) : "v"(lo), "v"(hi)); return r; }
__device__ __forceinline__ float bf2f(unsigned short b) { return __uint_as_float(((unsigned)b) << 16); }
__device__ __forceinline__ float bflo(unsigned w) { return __uint_as_float(w << 16); }
__device__ __forceinline__ float bfhi(unsigned w) { return __uint_as_float(w & 0xffff0000u); }
__device__ __forceinline__ bf16_t f2bf(float f) { return (bf16_t)(cvt_pk_bf16(f, 0.f) & 0xffffu); }
__device__ __forceinline__ float wave_sum(float v) {
#pragma unroll
    for (int o = 1; o < 64; o <<= 1) v += __shfl_xor(v, o);
    return v;
}
__device__ __forceinline__ float fast_sigmoid(float x) { return __builtin_amdgcn_rcpf(1.0f + __builtin_amdgcn_exp2f(-1.4426950408889634f * x)); }
__device__ __forceinline__ float fast_silu(float x) { return x * fast_sigmoid(x); }
__device__ __forceinline__ void atomic_add_f32(float* p, float v) { (void)__builtin_amdgcn_global_atomic_fadd_f32((GAS float*)p, v); }
#define LDS_WAIT() asm volatile("s_waitcnt lgkmcnt(0)" ::: "memory")
#define VM_WAIT() asm volatile("s_waitcnt vmcnt(0)" ::: "memory")

#define XB_TMO      128
#define XB_XCNT(j)  (256  + 64 * (j))
#define XB_XSUB(j)  (1280 + 64 * (j))
#define XB_XGEN(j)  (2304 + 64 * (j))
#define XB_TOP      3328
#define XB_TOPGEN   3392
#define XCD_BAR_WORDS 3456
#define XB_SPIN_CAP (1u << 18)
__device__ __forceinline__ unsigned xb_ld(unsigned* p)              { return __hip_atomic_load(p, __ATOMIC_RELAXED, __HIP_MEMORY_SCOPE_AGENT); }
__device__ __forceinline__ unsigned xb_add(unsigned* p, unsigned v) { return __hip_atomic_fetch_add(p, v, __ATOMIC_RELAXED, __HIP_MEMORY_SCOPE_AGENT); }
__device__ __forceinline__ unsigned xb_xcc_id() { return (unsigned)__builtin_amdgcn_s_getreg((3 << 11) | 20) & 0xFu; }
#define XB_SPIN(cond, bar) do { unsigned _sp = 0; while (cond) { __builtin_amdgcn_s_sleep(1); \
    if ((++_sp & 255u) == 0u) { if (xb_ld(&(bar)[XB_TMO])) break; if (_sp > XB_SPIN_CAP) { atomicAdd(&(bar)[XB_TMO], 1u); break; } } } } while (0)
struct XcdBarrier { unsigned* bar; unsigned x; volatile LAS unsigned* st; };
__device__ __forceinline__ XcdBarrier xcd_barrier_post(unsigned* bar, volatile LAS unsigned* st) {
    XcdBarrier b; b.bar = bar; b.x = xb_xcc_id(); b.st = st;
    if (threadIdx.x == 0) (void)xb_add(&bar[XB_XCNT(b.x)], 1u);
    return b;
}
__device__ __forceinline__ void xcd_barrier_complete(unsigned* bar, unsigned x, unsigned& nloc, unsigned& nx) {
    const unsigned G = gridDim.x * gridDim.y * gridDim.z;
    unsigned sum, cnt, mine, sp = 0u;
    for (;;) {
        sum = 0u; cnt = 0u; mine = 0u;
#pragma unroll
        for (unsigned j = 0; j < 16; ++j) { const unsigned c = xb_ld(&bar[XB_XCNT(j)]); sum += c; cnt += (c > 0u) ? 1u : 0u; mine = (j == x) ? c : mine; }
        if (sum == G) break;
        __builtin_amdgcn_s_sleep(1);
        if ((++sp & 255u) == 0u) { if (xb_ld(&bar[XB_TMO])) break; if (sp > XB_SPIN_CAP) { atomicAdd(&bar[XB_TMO], 1u); break; } }
    }
    nloc = mine > 0u ? mine : 1u; nx = cnt > 0u ? cnt : 1u;
}
__device__ __forceinline__ void xcd_barrier(const XcdBarrier& b) {
    asm volatile("s_waitcnt vmcnt(0)" ::: "memory");
    __syncthreads();
    if (threadIdx.x == 0) {
        unsigned* bar = b.bar;
        __builtin_amdgcn_s_waitcnt(0);
        unsigned nloc = b.st[0], nx = b.st[1];
        if (nloc == 0u) { xcd_barrier_complete(bar, b.x, nloc, nx); b.st[0] = nloc; b.st[1] = nx; }
        const unsigned old = xb_add(&bar[XB_XSUB(b.x)], 1u);
        const unsigned gen = old / nloc;
        if (old + 1u == (gen + 1u) * nloc) {
            __builtin_amdgcn_fence(__ATOMIC_RELEASE, "agent");
            asm volatile("s_waitcnt vmcnt(0)" ::: "memory");
            const unsigned og = xb_add(&bar[XB_TOP], 1u);
            const unsigned tg = og / nx;
            if (og + 1u == (tg + 1u) * nx) xb_add(&bar[XB_TOPGEN], 1u);
            else XB_SPIN(xb_ld(&bar[XB_TOPGEN]) == tg, bar);
            __builtin_amdgcn_fence(__ATOMIC_ACQUIRE, "agent");
            xb_add(&bar[XB_XGEN(b.x)], 1u);
            asm volatile("s_waitcnt vmcnt(0)" ::: "memory");
        } else {
            XB_SPIN(xb_ld(&bar[XB_XGEN(b.x)]) == gen, bar);
            __builtin_amdgcn_fence(__ATOMIC_ACQUIRE, "agent");
            asm volatile("s_waitcnt vmcnt(0)" ::: "memory");
        }
    }
    __syncthreads();
}

namespace pg8 {
constexpr int BM = 256, BK = 64, HALF = 128, HTB = HALF * BK * 2, STAGE_BYTES = 8 * HTB, NXCD = 8, WGM = 8;
__host__ __device__ __forceinline__ int lds_byte(int r, int c) { const int st = (r >> 4) * 2 + (c >> 5), rr = r & 15, cc = c & 31, ob = rr * 64 + cc * 2; return st * 1024 + (ob ^ (((ob >> 9) & 1) << 5)); }
__host__ __device__ __forceinline__ void stage_rc(int b, int& R, int& C) { const int st = b / 1024, sb = b % 1024, swz = sb ^ (((sb >> 9) & 1) << 5); R = (st >> 1) * 16 + swz / 64; C = (st & 1) * 32 + (swz % 64) / 2; }
__host__ __device__ __forceinline__ int perm32(int rho) { const int n = rho >> 4, i = rho & 15; return 8 * (i >> 2) + 4 * n + (i & 3); }

struct Unit { int pm, pn, ka, kb, nt, fl; };
struct Gemm { const bf16_t* A; const bf16_t* Bt; int lda, K; };

__device__ __forceinline__ void tile_of(int L, int nM, int nN, int& pm, int& pn) {
    const int nwg = nM * nN; int wgid = L;
    { const int q = nwg / NXCD, r = nwg % NXCD, xcd = wgid % NXCD, off = wgid / NXCD; wgid = (xcd < r ? xcd * (q + 1) : r * (q + 1) + (xcd - r) * q) + off; }
    const int nig = WGM * nN, gid = wgid / nig, fm = gid * WGM, gsz = (nM - fm) < WGM ? (nM - fm) : WGM;
    pm = fm + ((wgid % nig) % gsz); pn = (wgid % nig) / gsz;
}
struct SchedPlain {
    int nM, nN, G, c, mode, nt;
    __device__ __forceinline__ bool next(int i, Unit& u) const {
        const int L = i * G + c; if (L >= nM * nN) return false;
        tile_of(L, nM, nN, u.pm, u.pn);
        u.ka = (mode == 1) ? (u.pn < 6 ? ZC_CQ : ZC_CKV) : (mode == 2 ? 256 * u.pn : 0);
        u.kb = 0; u.nt = nt; u.fl = 0;
        return true;
    }
    __device__ __forceinline__ void a_ready(const Unit&) const {}
    __device__ __forceinline__ void done(const Unit&) const {}
};
struct SchedTail {
    int G, c, ntf; bool ctx;
    __device__ __forceinline__ bool next(int i, Unit& u) const {
        const bool fast = (G == 256), sub = fast && (i == 1);
        const int nM = fast ? 32 : (ctx ? 36 : 32), L = fast ? c : i * G + c;
        const bool ok = fast ? (i == 0 || (i == 1 && ctx)) : (L < nM * 8);
        int pm, pn; tile_of(ok ? L : 0, nM, 8, pm, pn);
        const int tile = c >> 3, j = c & 7, base = ntf >> 3, odd = base & 1;
        const int snt = odd ? (j < 4 ? base + 1 : base - 1) : base;
        const int skt = odd ? (j < 4 ? j * (base + 1) : 4 * (base + 1) + (j - 4) * (base - 1)) : j * base;
        Unit r; r.pm = sub ? 32 + (tile >> 3) : pm; r.pn = sub ? (tile & 7) : pn; r.ka = 0; r.kb = sub ? 64 * skt : 0; r.nt = sub ? snt : ntf; r.fl = sub ? 1 + j : 0;
        u = r; return ok;
    }
    __device__ __forceinline__ void a_ready(const Unit&) const {}
    __device__ __forceinline__ void done(const Unit&) const {}
};
struct SchedMerge {
    int G, c; bool ctx;
    __device__ __forceinline__ bool next(int i, Unit& u) const {
        const bool fast = (G == 256), sub = fast && (i == 3);
        const int nM = fast ? 32 : (ctx ? 36 : 32), T = fast ? c : (i / 3) * G + c;
        const bool ok = fast ? (i < 3 || (i == 3 && ctx && c < 192)) : (T < nM * 8);
        int pm, pn; tile_of(ok ? T : 0, nM, 8, pm, pn);
        const int tile = c / 6, rr = c - 6 * tile, sseg = rr >> 1, half = rr & 1;
        const int seg = sub ? sseg : (i % 3);
        Unit r; r.pm = seg * 36 + (sub ? 32 + (tile >> 3) : pm); r.pn = seg * 8 + (sub ? (tile & 7) : pn); r.ka = 0; r.kb = sub ? half * 512 : 0; r.nt = sub ? 8 : 16; r.fl = sub ? (4 | seg | (half << 3)) : seg;
        u = r; return ok;
    }
    __device__ __forceinline__ void a_ready(const Unit&) const {}
    __device__ __forceinline__ void done(const Unit&) const {}
};

struct EpiZ {
    static constexpr bool PERM = true, AFTER_DRAIN = false;
    __device__ __forceinline__ bool keep(const Unit&) const { return false; }
    bf16_t* Z; float* ZT;
    __device__ __forceinline__ void operator()(const f32x4 (&acc)[2][2][4][2], const Unit& u, int wr, int wc, int fr, int fq) const {
        const int row0 = u.pm * BM + wr * 64 + fr, cw = wc * 32 + 8 * fq;
        if (u.pn < 48) {
#pragma unroll
            for (int ai = 0; ai < 2; ++ai)
#pragma unroll
                for (int m = 0; m < 4; ++m) { bf16_t* rowp = Z + (size_t)(row0 + ai * HALF + m * 16) * NZB + u.pn * BM + cw;
#pragma unroll
                    for (int bj = 0; bj < 2; ++bj) { f32x4 v0 = acc[ai][bj][m][0], v1 = acc[ai][bj][m][1];
                        if (u.pn >= ZC_GATE / BM) {
#pragma unroll
                            for (int j = 0; j < 4; ++j) { v0[j] = fast_sigmoid(v0[j]); v1[j] = fast_sigmoid(v1[j]); } }
                        u32x4 w; w.x = cvt_pk_bf16(v0[0], v0[1]); w.y = cvt_pk_bf16(v0[2], v0[3]); w.z = cvt_pk_bf16(v1[0], v1[1]); w.w = cvt_pk_bf16(v1[2], v1[3]);
                        *(u32x4*)(rowp + bj * HALF) = w; } }
        } else {
#pragma unroll
            for (int ai = 0; ai < 2; ++ai)
#pragma unroll
                for (int m = 0; m < 4; ++m) { float* rowp = ZT + (size_t)(row0 + ai * HALF + m * 16) * 256 + cw;
#pragma unroll
                    for (int bj = 0; bj < 2; ++bj) { *(f32x4*)(rowp + bj * HALF) = acc[ai][bj][m][0]; *(f32x4*)(rowp + bj * HALF + 4) = acc[ai][bj][m][1]; } }
        }
    }
};
struct EpiBf16 {
    static constexpr bool PERM = true, AFTER_DRAIN = false;
    __device__ __forceinline__ bool keep(const Unit&) const { return false; }
    bf16_t* O; int ldc;
    __device__ __forceinline__ void operator()(const f32x4 (&acc)[2][2][4][2], const Unit& u, int wr, int wc, int fr, int fq) const {
        const int row0 = u.pm * BM + wr * 64 + fr, col0 = u.pn * BM + wc * 32 + 8 * fq;
#pragma unroll
        for (int ai = 0; ai < 2; ++ai)
#pragma unroll
            for (int m = 0; m < 4; ++m) { bf16_t* rowp = O + (size_t)(row0 + ai * HALF + m * 16) * ldc + col0;
#pragma unroll
                for (int bj = 0; bj < 2; ++bj) { const f32x4 v0 = acc[ai][bj][m][0], v1 = acc[ai][bj][m][1];
                    u32x4 w; w.x = cvt_pk_bf16(v0[0], v0[1]); w.y = cvt_pk_bf16(v0[2], v0[3]); w.z = cvt_pk_bf16(v1[0], v1[1]); w.w = cvt_pk_bf16(v1[2], v1[3]);
                    *(u32x4*)(rowp + bj * HALF) = w; } }
    }
};
struct EpiSwiGLU {
    static constexpr bool PERM = true, AFTER_DRAIN = false;
    __device__ __forceinline__ bool keep(const Unit&) const { return false; }
    bf16_t* ACT;
    __device__ __forceinline__ void operator()(const f32x4 (&acc)[2][2][4][2], const Unit& u, int wr, int wc, int fr, int fq) const {
        const int row0 = u.pm * BM + wr * 64 + fr, col0 = u.pn * HALF + wc * 32 + 8 * fq;
#pragma unroll
        for (int ai = 0; ai < 2; ++ai)
#pragma unroll
            for (int m = 0; m < 4; ++m) {
                float o[8];
#pragma unroll
                for (int n = 0; n < 2; ++n)
#pragma unroll
                    for (int j = 0; j < 4; ++j) o[4 * n + j] = fast_silu(acc[ai][0][m][n][j]) * acc[ai][1][m][n][j];
                u32x4 w; w.x = cvt_pk_bf16(o[0], o[1]); w.y = cvt_pk_bf16(o[2], o[3]); w.z = cvt_pk_bf16(o[4], o[5]); w.w = cvt_pk_bf16(o[6], o[7]);
                *(u32x4*)(ACT + (size_t)(row0 + ai * HALF + m * 16) * FF + col0) = w; }
    }
};
struct EpiResid {
    static constexpr bool PERM = true, AFTER_DRAIN = false;
    __device__ __forceinline__ bool keep(const Unit&) const { return false; }
    float* X; float* OUT; const float* gate; float* SLAB; const float* XS;
    __device__ __forceinline__ void operator()(const f32x4 (&acc)[2][2][4][2], const Unit& u, int wr, int wc, int fr, int fq) const {
        const int row0 = u.pm * BM + wr * 64 + fr, col0 = u.pn * BM + wc * 32 + 8 * fq;
        const int mr = u.pm < 32 ? (u.pm >> 3) : 4;
        const float* gp = gate + (size_t)mr * 12288 + col0;
        float* dst = (OUT != nullptr && u.pm < 32) ? OUT : X;
        f32x4 g[2][2];
#pragma unroll
        for (int bj = 0; bj < 2; ++bj)
#pragma unroll
            for (int n = 0; n < 2; ++n) g[bj][n] = *(const f32x4*)(gp + bj * HALF + 4 * n);
        if (u.fl) {
            float* sl = SLAB + (size_t)(u.fl - 1) * MC * DM;
#pragma unroll
            for (int ai = 0; ai < 2; ++ai)
#pragma unroll
                for (int m = 0; m < 4; ++m) { float* xp = sl + (size_t)(row0 - ML + ai * HALF + m * 16) * DM + col0;
#pragma unroll
                    for (int bj = 0; bj < 2; ++bj)
#pragma unroll
                        for (int n = 0; n < 2; ++n) *(f32x4*)(xp + bj * HALF + 4 * n) = g[bj][n] * acc[ai][bj][m][n]; }
            return;
        }
#pragma unroll
        for (int ai = 0; ai < 2; ++ai)
#pragma unroll
            for (int m = 0; m < 4; ++m) { const size_t off = (size_t)(row0 + ai * HALF + m * 16) * DM + col0;
#pragma unroll
                for (int bj = 0; bj < 2; ++bj)
#pragma unroll
                    for (int n = 0; n < 2; ++n) { const f32x4 x = *(const f32x4*)(XS + off + bj * HALF + 4 * n);
                        *(f32x4*)(dst + off + bj * HALF + 4 * n) = x + g[bj][n] * acc[ai][bj][m][n]; } }
    }
};
struct EpiMerge {
    static constexpr bool PERM = true, AFTER_DRAIN = false;
    const bf16_t* Z; bf16_t* MERGED; float* MSLAB;
    __device__ __forceinline__ bool keep(const Unit& u) const { return u.fl < 2; }
    __device__ __forceinline__ void operator()(f32x4 (&acc)[2][2][4][2], const Unit& u, int wr, int wc, int fr, int fq) const {
        const int seg = u.fl & 3, pm = u.pm - seg * 36, pn = u.pn - seg * 8; const bool sub = (u.fl & 4) != 0;
        const int row0 = pm * BM + wr * 64 + fr, col0 = pn * BM + wc * 32 + 8 * fq;
#pragma unroll
        for (int ai = 0; ai < 2; ++ai)
#pragma unroll
            for (int m = 0; m < 4; ++m) { const int row = row0 + ai * HALF + m * 16;
#pragma unroll
                for (int bj = 0; bj < 2; ++bj) {
                    const bf16_t* gp = Z + (size_t)row * NZB + ZC_GATE + seg * DM + col0 + bj * HALF;
                    const u32x4 gw = *(const u32x4*)gp;
                    const unsigned gv[4] = {gw.x, gw.y, gw.z, gw.w};
                    float f[8];
#pragma unroll
                    for (int j = 0; j < 4; ++j) { f[2 * j] = bflo(gv[j]); f[2 * j + 1] = bfhi(gv[j]); }
                    if (seg < 2 && !sub) {
                        const u32x4 hw = *(const u32x4*)(gp + DM); const unsigned hv[4] = {hw.x, hw.y, hw.z, hw.w};
#pragma unroll
                        for (int j = 0; j < 4; ++j) { f[2 * j] *= __builtin_amdgcn_rcpf(bflo(hv[j])); f[2 * j + 1] *= __builtin_amdgcn_rcpf(bfhi(hv[j])); }
                    }
                    f32x4 v0 = acc[ai][bj][m][0], v1 = acc[ai][bj][m][1];
#pragma unroll
                    for (int j = 0; j < 4; ++j) { v0[j] *= f[j]; v1[j] *= f[4 + j]; }
                    if (sub) { float* sp = MSLAB + ((size_t)(seg * 2 + ((u.fl >> 3) & 1)) * MC + (row - ML)) * DM + col0 + bj * HALF;
                        *(f32x4*)sp = v0; *(f32x4*)(sp + 4) = v1; }
                    else if (seg < 2) { acc[ai][bj][m][0] = v0; acc[ai][bj][m][1] = v1; }
                    else { u32x4 w; w.x = cvt_pk_bf16(v0[0], v0[1]); w.y = cvt_pk_bf16(v0[2], v0[3]); w.z = cvt_pk_bf16(v1[0], v1[1]); w.w = cvt_pk_bf16(v1[2], v1[3]);
                        *(u32x4*)(MERGED + (size_t)row * DM + col0 + bj * HALF) = w; } } }
    }
};

template <class Epi, class Sched, bool ALIGN_EPI = true>
__device__ __forceinline__ void gemm_phase(LAS unsigned char* lds, const Gemm g, const Sched& S, const Epi& E) {
    int tid = threadIdx.x; asm volatile("" : "+v"(tid));
    const int wid = __builtin_amdgcn_readfirstlane(tid >> 6), lane = tid & 63, wr = wid >> 2, wc = wid & 3, fr = lane & 15, fq = lane >> 4;
    int K = g.K, lda = g.lda; asm volatile("" : "+s"(K), "+s"(lda));
    unsigned voffA[2], voffB[2];
#pragma unroll
    for (int i = 0; i < 2; ++i) { int R, C; stage_rc(tid * 16 + i * 8192, R, C); const int Rb = Epi::PERM ? ((R & ~31) + perm32(R & 31)) : R;
        voffA[i] = (unsigned)(R * lda + C) * 2u; voffB[i] = (unsigned)(Rb * K + C) * 2u; }
    const size_t kstep = (size_t)(BK * 2);
    const size_t hstepA = (size_t)HALF * lda * 2, hstepB = (size_t)HALF * K * 2;
    const size_t tstepA = 2 * hstepA, tstepB = 2 * hstepB;
    const unsigned ldsw = (unsigned)wid * 1024u;
    const int aoff = lds_byte(wr * 64 + fr, fq * 8), boff = lds_byte(wc * 32 + fr, fq * 8);
#define PG8_SA(b, h) (((b) * 2 + (h)) * HTB)
#define PG8_SB(b, h) ((4 + (b) * 2 + (h)) * HTB)
#define PG8_STAGE(bufoff, gbase, voff) do { _Pragma("unroll") for (int _i = 0; _i < 2; ++_i) \
        __builtin_amdgcn_global_load_lds((const unsigned*)((const char*)(gbase) + (voff)[_i]), (LAS unsigned*)(lds + (bufoff) + ldsw + _i * 8192), 16, 0, 0); } while (0)
#define PG8_LDA(dst, b, h) do { _Pragma("unroll") for (int m = 0; m < 4; ++m) _Pragma("unroll") for (int k = 0; k < 2; ++k) dst[m][k] = *(const LAS bf16x8*)(lds + PG8_SA(b, h) + aoff + m * 2048 + k * 1024); } while (0)
#define PG8_LDB(dst, b, h) do { _Pragma("unroll") for (int n = 0; n < 2; ++n) _Pragma("unroll") for (int k = 0; k < 2; ++k) dst[n][k] = *(const LAS bf16x8*)(lds + PG8_SB(b, h) + boff + n * 2048 + k * 1024); } while (0)
#define PG8_MMA(ai, bj, At, Bt) do { __builtin_amdgcn_s_setprio(1); _Pragma("unroll") for (int m = 0; m < 4; ++m) _Pragma("unroll") for (int n = 0; n < 2; ++n) _Pragma("unroll") for (int k = 0; k < 2; ++k) \
        acc[ai][bj][m][n] = __builtin_amdgcn_mfma_f32_16x16x32_bf16(Bt[n][k], At[m][k], acc[ai][bj][m][n], 0, 0, 0); __builtin_amdgcn_s_setprio(0); } while (0)
#define PG8_WAIT_V(n) asm volatile("s_waitcnt vmcnt(" #n ")" ::: "memory")
#define PG8_WAIT_L(n) asm volatile("s_waitcnt lgkmcnt(" #n ")" ::: "memory")
#define PG8_BAR __builtin_amdgcn_s_barrier()
#define PG8_SCHED __builtin_amdgcn_sched_barrier(0)
    Unit cur, nxt; int ui = 0;
    if (!S.next(0, cur)) return;
    f32x4 acc[2][2][4][2];
#pragma unroll
    for (int a = 0; a < 2; ++a)
#pragma unroll
        for (int b = 0; b < 2; ++b)
#pragma unroll
            for (int m = 0; m < 4; ++m)
#pragma unroll
                for (int n = 0; n < 2; ++n) acc[a][b][m][n] = (f32x4){0.f, 0.f, 0.f, 0.f};
    bf16x8 At[4][2], B0[2][2], B1[2][2];
    const char* cA = (const char*)g.A + (size_t)cur.pm * tstepA + (size_t)(cur.ka + cur.kb) * 2; const char* cB = (const char*)g.Bt + (size_t)cur.pn * tstepB + (size_t)cur.kb * 2;
    S.a_ready(cur);
    PG8_STAGE(PG8_SB(0, 0), cB, voffB); PG8_STAGE(PG8_SB(0, 1), cB + hstepB, voffB); PG8_STAGE(PG8_SA(0, 0), cA, voffA); PG8_STAGE(PG8_SA(0, 1), cA + hstepA, voffA);
    if (wr == 1) PG8_BAR;
    PG8_WAIT_V(2); PG8_BAR;
    PG8_STAGE(PG8_SB(1, 0), cB + kstep, voffB); PG8_STAGE(PG8_SA(1, 0), cA + kstep, voffA); PG8_STAGE(PG8_SB(1, 1), cB + hstepB + kstep, voffB);
    PG8_WAIT_V(6); PG8_BAR;
    for (;;) {
        const bool has_next = S.next(ui + 1, nxt);
        const char* nA = has_next ? (const char*)g.A + (size_t)nxt.pm * tstepA + (size_t)(nxt.ka + nxt.kb) * 2 : cA; const char* nB = has_next ? (const char*)g.Bt + (size_t)nxt.pn * tstepB + (size_t)nxt.kb * 2 : cB;
        const int nt = cur.nt;
        for (int t = 0; t < nt; t += 2) {
            const bool last = (t == nt - 2);
            const char* a1 = cA + (size_t)(t + 1) * kstep;
            const char* a2 = last ? nA : cA + (size_t)(t + 2) * kstep; const char* b2 = last ? nB : cB + (size_t)(t + 2) * kstep;
            const char* a3 = a2 + kstep; const char* b3 = b2 + kstep;
            if (last && has_next) S.a_ready(nxt);
            PG8_LDB(B0, 0, 0); PG8_LDB(B1, 0, 1); PG8_SCHED; PG8_LDA(At, 0, 0); PG8_STAGE(PG8_SA(1, 1), a1 + hstepA, voffA);
            PG8_WAIT_V(8); PG8_WAIT_L(0); PG8_BAR; PG8_MMA(0, 0, At, B0); PG8_MMA(0, 1, At, B1); PG8_BAR; PG8_SCHED;
            PG8_LDA(At, 0, 1); PG8_STAGE(PG8_SB(0, 0), b2, voffB); PG8_STAGE(PG8_SB(0, 1), b2 + hstepB, voffB); PG8_STAGE(PG8_SA(0, 0), a2, voffA);
            PG8_WAIT_V(8); PG8_WAIT_L(0); PG8_BAR; PG8_MMA(1, 0, At, B0); PG8_MMA(1, 1, At, B1); PG8_BAR; PG8_SCHED;
            PG8_LDB(B0, 1, 0); PG8_LDB(B1, 1, 1); PG8_SCHED; PG8_LDA(At, 1, 0); PG8_STAGE(PG8_SA(0, 1), a2 + hstepA, voffA);
            PG8_WAIT_V(8); PG8_WAIT_L(0); PG8_BAR; PG8_MMA(0, 0, At, B0); PG8_MMA(0, 1, At, B1); PG8_BAR; PG8_SCHED;
            PG8_LDA(At, 1, 1); PG8_STAGE(PG8_SB(1, 0), b3, voffB); PG8_STAGE(PG8_SB(1, 1), b3 + hstepB, voffB); PG8_STAGE(PG8_SA(1, 0), a3, voffA);
            PG8_WAIT_V(8); PG8_WAIT_L(0); PG8_BAR; PG8_MMA(1, 0, At, B0); PG8_MMA(1, 1, At, B1); PG8_BAR; PG8_SCHED;
        }
        if constexpr (ALIGN_EPI) { if (wr == 0) PG8_BAR; }
        E(acc, cur, wr, wc, fr, fq); S.done(cur);
        if (!has_next) break;
        if (!E.keep(cur))
#pragma unroll
        for (int a = 0; a < 2; ++a)
#pragma unroll
            for (int b = 0; b < 2; ++b)
#pragma unroll
                for (int m = 0; m < 4; ++m)
#pragma unroll
                    for (int n = 0; n < 2; ++n) acc[a][b][m][n] = (f32x4){0.f, 0.f, 0.f, 0.f};
        cur = nxt; cA = nA; cB = nB; ++ui;
        if constexpr (ALIGN_EPI) { if (wr == 1) PG8_BAR; }
    }
    PG8_WAIT_V(0);
    if constexpr (!ALIGN_EPI) { if (wr == 0) PG8_BAR; }
    PG8_BAR;
#undef PG8_SA
#undef PG8_SB
#undef PG8_STAGE
#undef PG8_LDA
#undef PG8_LDB
#undef PG8_MMA
#undef PG8_WAIT_V
#undef PG8_WAIT_L
#undef PG8_BAR
#undef PG8_SCHED
}
}

namespace att {
constexpr int DQ = 192, DV = 128, NW = 8, QBLK = 32, KVBLK = 64;
constexpr float SCALE = 0.07216878364870322f;
constexpr float THR = 8.f;
constexpr int SHM_V = KVBLK * DV * 2, SHM_K = KVBLK * 400, SHM_ATTN = 2 * SHM_V + 2 * SHM_K + NW * 64 * 4;
#define KSWZ(row, colB) ((row) * 400 + (colB))
#define SBAR() __builtin_amdgcn_sched_barrier(0)
__device__ __forceinline__ int crow(int r, int hi) { return (r & 3) + 8 * (r >> 2) + 4 * hi; }
__device__ __forceinline__ unsigned cvtpk(float lo, float hi) { unsigned r; asm volatile("v_cvt_pk_bf16_f32 %0, %1, %2" : "=v"(r) : "v"(lo), "v"(hi)); return r; }
__device__ __forceinline__ void partialSM(f32x16& p0, f32x16& p1, float& m_reg, float& mn, float& alpha) {
    constexpr float C = SCALE * 1.4426950408889634f;
    float pmax = p0[0];
#pragma unroll
    for (int r = 1; r < 16; ++r) pmax = fmaxf(pmax, p0[r]);
#pragma unroll
    for (int r = 0; r < 16; ++r) pmax = fmaxf(pmax, p1[r]);
    { auto rr = __builtin_amdgcn_permlane32_swap(__float_as_uint(pmax), __float_as_uint(pmax), false, false);
      pmax = fmaxf(__uint_as_float(rr[0]), __uint_as_float(rr[1])); }
    if (__builtin_expect(__all(pmax - m_reg <= THR / SCALE), 1)) { mn = m_reg; alpha = 1.f; }
    else { mn = fmaxf(m_reg, pmax); alpha = __builtin_amdgcn_exp2f((m_reg - mn) * C); m_reg = mn; }
    const float mnC = -mn * C;
#pragma unroll
    for (int r = 0; r < 16; ++r) p0[r] = fmaf(p0[r], C, mnC);
#pragma unroll
    for (int r = 0; r < 16; ++r) p1[r] = fmaf(p1[r], C, mnC);
#pragma unroll
    for (int r = 0; r < 16; ++r) p0[r] = __builtin_amdgcn_exp2f(p0[r]);
}
__device__ __forceinline__ void finishSM(f32x16& p0, f32x16& p1, float alpha, float& l_reg, bf16x8& pa0, bf16x8& pa1, bf16x8& pa2, bf16x8& pa3) {
#pragma unroll
    for (int r = 0; r < 16; ++r) p1[r] = __builtin_amdgcn_exp2f(p1[r]);
    float ps = 0;
#pragma unroll
    for (int r = 0; r < 16; ++r) ps += p0[r];
#pragma unroll
    for (int r = 0; r < 16; ++r) ps += p1[r];
    { auto rr = __builtin_amdgcn_permlane32_swap(__float_as_uint(ps), __float_as_uint(ps), false, false);
      ps = __uint_as_float(rr[0]) + __uint_as_float(rr[1]); }
    l_reg = l_reg * alpha + ps;
#define PK4(P, BASE, OUT) do { unsigned a0 = cvtpk(P[BASE + 0], P[BASE + 1]), a1 = cvtpk(P[BASE + 2], P[BASE + 3]);   \
    unsigned b0 = cvtpk(P[BASE + 4], P[BASE + 5]), b1 = cvtpk(P[BASE + 6], P[BASE + 7]);                              \
    auto r0 = __builtin_amdgcn_permlane32_swap(a0, b0, false, false); auto r1 = __builtin_amdgcn_permlane32_swap(a1, b1, false, false); \
    u32x4 w = {r0[0], r1[0], r0[1], r1[1]}; OUT = *reinterpret_cast<bf16x8*>(&w); } while (0)
    PK4(p0, 0, pa0); PK4(p0, 8, pa1); PK4(p1, 0, pa2); PK4(p1, 8, pa3);
#undef PK4
}
__device__ __forceinline__ void qkt(f32x16& p0, f32x16& p1, const char* Ks, const bf16x8* qr, int r32, int hi) {
    p0 = f32x16{}; p1 = f32x16{};
    const char* k0p = Ks + KSWZ(r32, hi * 16); const char* k1p = Ks + KSWZ(32 + r32, hi * 16);
    bf16x8 a0 = *reinterpret_cast<const bf16x8*>(k0p), a1 = *reinterpret_cast<const bf16x8*>(k1p);
    bf16x8 b0 = *reinterpret_cast<const bf16x8*>(k0p + 32), b1 = *reinterpret_cast<const bf16x8*>(k1p + 32);
    bf16x8 c0 = *reinterpret_cast<const bf16x8*>(k0p + 64), c1 = *reinterpret_cast<const bf16x8*>(k1p + 64);
#pragma unroll
    for (int d0 = 0; d0 < DQ / 16; d0 += 3) {
        SBAR();
        p0 = __builtin_amdgcn_mfma_f32_32x32x16_bf16(a0, qr[d0], p0, 0, 0, 0); p1 = __builtin_amdgcn_mfma_f32_32x32x16_bf16(a1, qr[d0], p1, 0, 0, 0);
        if (d0 + 3 < DQ / 16) { a0 = *reinterpret_cast<const bf16x8*>(k0p + (d0 + 3) * 32); a1 = *reinterpret_cast<const bf16x8*>(k1p + (d0 + 3) * 32); }
        SBAR();
        p0 = __builtin_amdgcn_mfma_f32_32x32x16_bf16(b0, qr[d0 + 1], p0, 0, 0, 0); p1 = __builtin_amdgcn_mfma_f32_32x32x16_bf16(b1, qr[d0 + 1], p1, 0, 0, 0);
        if (d0 + 4 < DQ / 16) { b0 = *reinterpret_cast<const bf16x8*>(k0p + (d0 + 4) * 32); b1 = *reinterpret_cast<const bf16x8*>(k1p + (d0 + 4) * 32); }
        SBAR();
        p0 = __builtin_amdgcn_mfma_f32_32x32x16_bf16(c0, qr[d0 + 2], p0, 0, 0, 0); p1 = __builtin_amdgcn_mfma_f32_32x32x16_bf16(c1, qr[d0 + 2], p1, 0, 0, 0);
        if (d0 + 5 < DQ / 16) { c0 = *reinterpret_cast<const bf16x8*>(k0p + (d0 + 5) * 32); c1 = *reinterpret_cast<const bf16x8*>(k1p + (d0 + 5) * 32); }
    }
}
__device__ __forceinline__ int v_st(int k, int c) { const int kk = (k & ~0xC) | ((k & 4) << 1) | ((k & 8) >> 1); return ((kk >> 3) * 4 + (c >> 5)) * 512 + ((kk & 7) * 32 + (c & 31)) * 2; }
__device__ __forceinline__ int v_rd_base(int lane) { return ((lane & 3) << 3) | (((lane >> 2) & 3) << 6) | (((lane >> 4) & 1) << 5) | (((lane >> 5) & 1) << 8); }
constexpr int v_rd_off(int d0, int ks, int half) { return d0 * 512 + ks * 4096 + half * 2048; }
template <int OFF> __device__ __forceinline__ s16x4 tr_read(int vb) {
    s16x4 r; asm volatile("ds_read_b64_tr_b16 %0, %1 offset:%2" : "=&v"(r) : "v"(vb), "i"(OFF) : "memory"); return r;
}
template <int D0> __device__ __forceinline__ void pv_one(f32x16& od, int vb, bf16x8 pa0, bf16x8 pa1, bf16x8 pa2, bf16x8 pa3) {
    const s16x4 l0 = tr_read<v_rd_off(D0, 0, 0)>(vb), h0 = tr_read<v_rd_off(D0, 0, 1)>(vb), l1 = tr_read<v_rd_off(D0, 1, 0)>(vb), h1 = tr_read<v_rd_off(D0, 1, 1)>(vb);
    const s16x4 l2 = tr_read<v_rd_off(D0, 2, 0)>(vb), h2 = tr_read<v_rd_off(D0, 2, 1)>(vb), l3 = tr_read<v_rd_off(D0, 3, 0)>(vb), h3 = tr_read<v_rd_off(D0, 3, 1)>(vb);
    asm volatile("s_waitcnt lgkmcnt(0)" ::: "memory"); SBAR();
#define PK(L, H) (bf16x8){L[0], L[1], L[2], L[3], H[0], H[1], H[2], H[3]}
    od = __builtin_amdgcn_mfma_f32_32x32x16_bf16(pa0, PK(l0, h0), od, 0, 0, 0);
    od = __builtin_amdgcn_mfma_f32_32x32x16_bf16(pa1, PK(l1, h1), od, 0, 0, 0);
    od = __builtin_amdgcn_mfma_f32_32x32x16_bf16(pa2, PK(l2, h2), od, 0, 0, 0);
    od = __builtin_amdgcn_mfma_f32_32x32x16_bf16(pa3, PK(l3, h3), od, 0, 0, 0);
#undef PK
}
__device__ __forceinline__ void pv_d0(f32x16* o, int vb, bf16x8 pa0, bf16x8 pa1, bf16x8 pa2, bf16x8 pa3) {
    pv_one<0>(o[0], vb, pa0, pa1, pa2, pa3); pv_one<1>(o[1], vb, pa0, pa1, pa2, pa3); pv_one<2>(o[2], vb, pa0, pa1, pa2, pa3); pv_one<3>(o[3], vb, pa0, pa1, pa2, pa3);
}
__device__ __forceinline__ void attn_body(const bf16_t* __restrict__ Qb, const bf16_t* __restrict__ Kh, const bf16_t* __restrict__ Vh, bf16_t* __restrict__ Ob, int ldo, int seq, char* lds) {
    int tid = threadIdx.x; asm volatile("" : "+v"(tid));
    const int wid = tid >> 6, lane = tid & 63, r32 = lane & 31, hi = lane >> 5;
    char* V_lds = lds; char* K_lds = lds + 2 * SHM_V;
    float* ws = (float*)(lds + 2 * SHM_V + 2 * SHM_K) + wid * 64; float* li_l = ws; float* al_l = ws + 32;
    float m_reg = -1e30f, l_reg = 0; f32x16 o[4] = {}; bf16x8 qr[DQ / 16];
    const bf16_t* Qw = Qb + (size_t)(wid * QBLK + r32) * DQ + hi * 8;
#pragma unroll
    for (int d0 = 0; d0 < DQ / 16; ++d0) qr[d0] = *reinterpret_cast<const bf16x8*>(Qw + d0 * 16);
    const int sr = tid >> 4, sc = (tid & 15) * 8, vst0 = v_st(sr, sc), vst1 = v_st(32 + sr, sc);
    const int krow = tid >> 3, kseg = (tid & 7) * 16;
    const int kgo = krow * 384 + kseg, klo = krow * 400 + kseg;
    const int vb0 = (int)(uintptr_t)V_lds + v_rd_base(lane);
    bf16x8 vs0, vs1, ks0, ks1, ks2;
#define SLOAD(k0) do { vs0 = *reinterpret_cast<const bf16x8*>(&Vh[(size_t)((k0) + sr) * DV + sc]); vs1 = *reinterpret_cast<const bf16x8*>(&Vh[(size_t)((k0) + 32 + sr) * DV + sc]); \
    { const char* kp_ = (const char*)Kh + (size_t)(k0) * 384 + kgo; ks0 = *reinterpret_cast<const bf16x8*>(kp_); ks1 = *reinterpret_cast<const bf16x8*>(kp_ + 128); ks2 = *reinterpret_cast<const bf16x8*>(kp_ + 256); } } while (0)
#define SWRITE(b) do { *(bf16x8*)(V_lds + (b) * SHM_V + vst0) = vs0; *(bf16x8*)(V_lds + (b) * SHM_V + vst1) = vs1; \
    *(bf16x8*)(K_lds + (b) * SHM_K + klo) = ks0; *(bf16x8*)(K_lds + (b) * SHM_K + klo + 128) = ks1; *(bf16x8*)(K_lds + (b) * SHM_K + klo + 256) = ks2; } while (0)
#define SWAIT() asm volatile("s_waitcnt vmcnt(0)" ::: "memory")
#define RESC(a) do { if (__any((a) < 1.f)) { if (hi == 0) al_l[r32] = (a); asm volatile("s_waitcnt lgkmcnt(0)" ::: "memory"); \
    _Pragma("unroll") for (int d = 0; d < 4; ++d) _Pragma("unroll") for (int r = 0; r < 16; ++r) o[d][r] *= al_l[crow(r, hi)]; } } while (0)
    f32x16 p0, p1; float mn, al; bf16x8 pa0, pa1, pa2, pa3; const int NT = seq / KVBLK;
    const bool grpB = wid >= 4;
#define DO_QK(b) do { SBAR(); qkt(p0, p1, K_lds + (b) * SHM_K, qr, r32, hi); SBAR(); } while (0)
#define DO_SMPV(b) do { partialSM(p0, p1, m_reg, mn, al); RESC(al); finishSM(p0, p1, al, l_reg, pa0, pa1, pa2, pa3); SBAR(); pv_d0(o, vb0 + (b) * SHM_V, pa0, pa1, pa2, pa3); } while (0)
    SLOAD(0); SWAIT(); SWRITE(0);
    if (NT > 1) SLOAD(KVBLK);
    __syncthreads();
#pragma unroll 1
    for (int j = 0; j < NT; ++j) {
        const int bsel = j & 1;
        if (!grpB) DO_QK(bsel); else if (j > 0) DO_SMPV(bsel ^ 1);
        __syncthreads();
        if (j + 1 < NT) { SWAIT(); SWRITE(bsel ^ 1); if (j + 2 < NT) SLOAD((j + 2) * KVBLK); }
        if (!grpB) DO_SMPV(bsel); else DO_QK(bsel);
        __syncthreads();
    }
    if (grpB) DO_SMPV((NT - 1) & 1);
#undef DO_QK
#undef DO_SMPV
    if (hi == 0) li_l[r32] = l_reg; asm volatile("s_waitcnt lgkmcnt(0)" ::: "memory");
    float rli[16];
#pragma unroll
    for (int r = 0; r < 16; ++r) rli[r] = __builtin_amdgcn_rcpf(li_l[crow(r, hi)]);
    bf16_t* Ow = Ob + (size_t)(wid * QBLK) * ldo;
#pragma unroll
    for (int r = 0; r < 16; ++r) { const int orow = crow(r, hi);
#pragma unroll
        for (int d0 = 0; d0 < 4; ++d0) Ow[(size_t)orow * ldo + d0 * 32 + r32] = f2bf(o[d0][r] * rli[r]); }
    __syncthreads();
#undef SLOAD
#undef SWRITE
#undef SWAIT
#undef RESC
}
}

struct Args { const float* in[25]; float* out; unsigned char* ws; int q_lo, q_hi, single, pad; };
enum { I_X = 0, I_C, I_CTX, I_CCTX, I_WMOD, I_BMOD, I_N1G, I_N2G, I_WIN, I_QNG, I_WQUP, I_KVNG, I_WKVUP, I_QHG, I_KHG, I_GWG, I_GBG, I_GONG, I_PW, I_PS, I_WBR, I_WOUT, I_W1, I_W3, I_W2 };
constexpr int NPH = 11;

struct Frame {
    LAS unsigned char* lds; unsigned char* ldsg;
    int tid, lane, wave, G, c;
    const float* const* in; float* out; unsigned char* ws;
};

__device__ __forceinline__ void refresh_lane(Frame& F) { int t = threadIdx.x; asm volatile("" : "+v"(t)); F.tid = t; F.lane = t & 63;
    unsigned char* w = F.ws; int c = F.c, wv = F.wave; asm volatile("" : "+s"(w), "+s"(c), "+s"(wv)); F.ws = w; F.c = c; F.wave = wv; }
__device__ __forceinline__ int mod_row(int row) { return row < ML ? (row >> 11) : 4; }

__device__ __forceinline__ int win_dst_row(int n) {
    if (n < 512) return ZC_CKV + n;
    if (n < 576) return NZB + ZT_KR + (n - 512);
    if (n < 1600) return ZC_GK + (n - 576);
    if (n < 2624) return ZC_GV + (n - 1600);
    if (n < 2656) return NZB + ZT_LR + (n - 2624);
    if (n < 3168) return ZC_CQ + (n - 2656);
    if (n < 4192) return ZC_GQ + (n - 3168);
    if (n < 5216) return ZC_GG + (n - 4192);
    if (n < 6240) return ZC_PIN + (n - 5216);
    return ZC_GATE + (n - 6240);
}
constexpr int IT_IN = 32 * 387, IT_Q = 8 * 48, IT_KV = 8 * 64, IT_P = 4 * 4 * 8, IT_B = 3 * 16 * 64, IT_O = 32 * 64, IT_1 = 32 * 176, IT_2 = 88 * 64;
constexpr int IT_LAYER = IT_IN + IT_Q + IT_KV + IT_P + IT_B + IT_O + 2 * IT_1 + IT_2;
__device__ __forceinline__ void item_decode(const Frame& F, int it, const float*& src, int& ldsrc, int& c0, int& k0, bf16_t*& dst, int& lddst, int& r0, const float*& kscale, const float*& nscale) {
    const int l = it / IT_LAYER; int r = it % IT_LAYER;
    bf16_t* wl = (bf16_t*)(F.ws + WS_W + (size_t)l * W_LAYER);
    kscale = nullptr; nscale = nullptr;
    if (r < IT_IN) { const int kb = r / 387, nb = r % 387;
        src = F.in[I_WIN] + (size_t)l * DM * IN_COLS; ldsrc = IN_COLS; c0 = 32 * nb; k0 = 64 * kb; dst = wl + W_IN / 2; lddst = DM; r0 = win_dst_row(32 * nb); return; } r -= IT_IN;
    if (r < IT_Q) { const int kb = r / 48, nb = r % 48;
        src = F.in[I_WQUP] + (size_t)l * 512 * 1536; ldsrc = 1536; c0 = 32 * nb; k0 = 64 * kb; dst = wl + W_QKV / 2; lddst = 512; r0 = 32 * nb; kscale = F.in[I_QNG] + l * 512; return; } r -= IT_Q;
    if (r < IT_KV) { const int kb = r / 64, nb = r % 64;
        src = F.in[I_WKVUP] + (size_t)l * 512 * 2048; ldsrc = 2048; c0 = 32 * nb; k0 = 64 * kb; dst = wl + W_QKV / 2; lddst = 512; r0 = 1536 + 32 * nb; kscale = F.in[I_KVNG] + l * 512; return; } r -= IT_KV;
    if (r < IT_P) { const int g = r / 32, kb = (r % 32) / 8, nb = r % 8;
        src = F.in[I_PW] + ((size_t)l * 4 + g) * 65536; ldsrc = 256; c0 = 32 * nb; k0 = 64 * kb; dst = wl + W_P / 2; lddst = 256; r0 = g * 256 + 32 * nb; nscale = F.in[I_PS] + l * 1024 + g * 256 + 32 * nb; return; } r -= IT_P;
    if (r < IT_B) { const int n = r / 1024, kb = (r % 1024) / 64, nb = r % 64;
        src = F.in[I_WBR] + ((size_t)l * 3 + n) * 1024 * 2048; ldsrc = 2048; c0 = 32 * nb; k0 = 64 * kb; dst = wl + W_B / 2; lddst = 1024; r0 = n * 2048 + 32 * nb; return; } r -= IT_B;
    if (r < IT_O) { const int kb = r / 64, nb = r % 64;
        src = F.in[I_WOUT] + (size_t)l * DM * DM; ldsrc = DM; c0 = 32 * nb; k0 = 64 * kb; dst = wl + W_O / 2; lddst = DM; r0 = 32 * nb; return; } r -= IT_O;
    if (r < 2 * IT_1) { const int which = r / IT_1; r %= IT_1; const int kb = r / 176, nb = r % 176, n0 = 32 * nb;
        src = F.in[which ? I_W3 : I_W1] + (size_t)l * DM * FF; ldsrc = FF; c0 = n0; k0 = 64 * kb; dst = wl + W_13 / 2; lddst = DM; r0 = (n0 >> 7) * 256 + which * 128 + (n0 & 127); return; } r -= 2 * IT_1;
    { const int kb = r / 64, nb = r % 64;
        src = F.in[I_W2] + (size_t)l * FF * DM; ldsrc = DM; c0 = 32 * nb; k0 = 64 * kb; dst = wl + W_2 / 2; lddst = FF; r0 = 32 * nb; }
}
__device__ __forceinline__ void item_load(float (&v)[32], const float* src, int ldsrc, int c0, int k0, int lane) {
    const float* p = src + (size_t)(k0 + (lane >> 5)) * ldsrc + c0 + (lane & 31);
#pragma unroll
    for (int i = 0; i < 32; ++i) v[i] = p[(size_t)(2 * i) * ldsrc];
}
__device__ __forceinline__ void item_finish(const float (&v)[32], int k0, bf16_t* dst, int lddst, int r0, const float* kscale, const float* nscale, LAS float* scr, int lane) {
#pragma unroll
    for (int i = 0; i < 32; ++i) scr[(2 * i + (lane >> 5)) * 33 + (lane & 31)] = v[i];
    LDS_WAIT(); asm volatile("" ::: "memory");
    const int c = lane & 7;
    float ks[8];
#pragma unroll
    for (int i = 0; i < 8; ++i) ks[i] = kscale ? kscale[k0 + 8 * c + i] : 1.0f;
#pragma unroll
    for (int j = 0; j < 4; ++j) { const int n = (lane >> 3) + 8 * j; const LAS float* s = scr + (8 * c) * 33 + n; const float ns = nscale ? nscale[n] : 1.0f;
        u32x4 o; o.x = cvt_pk_bf16(s[0 * 33] * ks[0] * ns, s[1 * 33] * ks[1] * ns); o.y = cvt_pk_bf16(s[2 * 33] * ks[2] * ns, s[3 * 33] * ks[3] * ns);
        o.z = cvt_pk_bf16(s[4 * 33] * ks[4] * ns, s[5 * 33] * ks[5] * ns); o.w = cvt_pk_bf16(s[6 * 33] * ks[6] * ns, s[7 * 33] * ks[7] * ns);
        *(u32x4*)(dst + (size_t)(r0 + n) * lddst + k0 + 8 * c) = o; }
    LDS_WAIT(); asm volatile("" ::: "memory");
}
__device__ __forceinline__ void prologue_item(const Frame& F, int it, LAS float* scr) {
    const float* src; int ldsrc, c0, k0; bf16_t* dst; int lddst, r0; const float* kscale; const float* nscale;
    item_decode(F, it, src, ldsrc, c0, k0, dst, lddst, r0, kscale, nscale);
    float v[32];
    item_load(v, src, ldsrc, c0, k0, F.lane);
    item_finish(v, k0, dst, lddst, r0, kscale, nscale, scr, F.lane);
}
__device__ __forceinline__ void phase_prologue(const Frame& F) {
    { LAS float* scr = (LAS float*)(F.lds + F.wave * 8448);
      const int gw = F.c * 8 + F.wave, NGW = F.G * 8;
      for (int it = gw; it < (F.G == 256 ? 1 : NLAYER) * IT_LAYER; it += NGW) prologue_item(F, it, scr);
      const int gt = F.c * 512 + F.tid, NT = F.G * 512;
      for (int i = gt; i < NLAYER * 160 * (DM / 8); i += NT) { const int l = i / (160 * 256), rr = (i % (160 * 256)) / 256, cc = i % 256;
          *(u32x4*)((bf16_t*)(F.ws + WS_W + (size_t)l * W_LAYER + W_IN) + (size_t)(IN_COLS + rr) * DM + cc * 8) = (u32x4){0u, 0u, 0u, 0u}; } }
    __syncthreads();
    { float* sc = (float*)F.ldsg;
      float* red = (float*)(F.ldsg + 40960);
      for (int i = F.tid; i < 5 * DM; i += 512) { const int r = i >> 11, k = i & 2047; const float v = r < 4 ? F.in[I_C][r * DM + k] : F.in[I_CCTX][k]; sc[i] = v / (1.0f + __expf(-v)); }
      __syncthreads();
      float* mods = (float*)(F.ws + WS_MODS);
      for (int wb = F.c; wb < 256; wb += F.G) {
          const int l = wb >> 6, col0 = (wb & 63) * 192;
          const int cg = F.tid % 48, ksl = F.tid / 48;
          if (ksl < 10) {
              f32x4 a[5];
#pragma unroll
              for (int r = 0; r < 5; ++r) a[r] = (f32x4){0.f, 0.f, 0.f, 0.f};
              const float* wp = F.in[I_WMOD] + (size_t)l * DM * 12288 + col0 + 4 * cg;
#pragma unroll 8
              for (int k = ksl; k < DM; k += 10) { const f32x4 w = *(const f32x4*)(wp + (size_t)k * 12288);
#pragma unroll
                  for (int r = 0; r < 5; ++r) a[r] += w * sc[r * DM + k]; }
#pragma unroll
              for (int r = 0; r < 5; ++r) *(f32x4*)(red + (ksl * 5 + r) * 192 + 4 * cg) = a[r];
          }
          __syncthreads();
          for (int i = F.tid; i < 960; i += 512) { const int r = i / 192, j = i % 192; float s = F.in[I_BMOD][l * 12288 + col0 + j];
#pragma unroll
              for (int q = 0; q < 10; ++q) s += red[(q * 5 + r) * 192 + j];
              mods[((size_t)l * 5 + r) * 12288 + col0 + j] = s; }
          __syncthreads();
      } }
    { const int gt = F.c * 512 + F.tid;
      if (gt < 96 * 16) { const int pi = gt >> 4, i = gt & 15; const float invf = 1.0f / powf(10000.0f, (float)(2 * i) / 32.0f);
          const float ang = (float)(pi < 32 ? pi : pi - 32) * invf; float* rt = (float*)(F.ws + WS_ROPE) + gt * 2; rt[0] = cosf(ang); rt[1] = sinf(ang); } }
    if (F.G != 256) { const int gt = F.c * 512 + F.tid, NT = F.G * 512; f32x4* X = (f32x4*)(F.ws + WS_X);
      const f32x4* x = (const f32x4*)F.in[I_X]; const f32x4* cx = (const f32x4*)F.in[I_CTX];
      for (int i = gt; i < ML * DM / 4; i += NT) X[i] = x[i];
      for (int i = gt; i < MC * DM / 4; i += NT) X[ML * DM / 4 + i] = cx[i]; }
}

__device__ __forceinline__ void phase_norm(const Frame& F, int nrows, bool slabs, const float* xl, const float* xc, const float* ng, const float* mods_l, int ch_shift, int ch_scale) {
    float* X = (float*)(F.ws + WS_X); const float* SL = (const float*)(F.ws + WS_RSLAB); bf16_t* H = (bf16_t*)(F.ws + WS_H);
    const int step = F.G * 8;
    for (int rowA = F.c * 8 + F.wave; rowA < nrows; rowA += 2 * step) {
        const int rowB = rowA + step; const bool vb = rowB < nrows;
        const f32x4* xa = (const f32x4*)(rowA < ML ? xl + (size_t)rowA * DM : xc + (size_t)(rowA - ML) * DM) + F.lane;
        const f32x4* xb = (const f32x4*)(rowB < ML ? xl + (size_t)rowB * DM : xc + (size_t)(rowB - ML) * DM) + F.lane;
        f32x4 va[8], vbv[8];
#pragma unroll
        for (int j = 0; j < 8; ++j) va[j] = xa[64 * j];
        if (vb) {
#pragma unroll
            for (int j = 0; j < 8; ++j) vbv[j] = xb[64 * j];
        }
#pragma unroll
        for (int which = 0; which < 2; ++which) {
            if (which == 1 && !vb) break;
            const int row = which ? rowB : rowA;
            f32x4 v[8];
#pragma unroll
            for (int j = 0; j < 8; ++j) v[j] = which ? vbv[j] : va[j];
            if (slabs && row >= ML) {
#pragma unroll
                for (int q = 0; q < 8; ++q) { const f32x4* sr = (const f32x4*)(SL + ((size_t)q * MC + (row - ML)) * DM) + F.lane;
#pragma unroll
                    for (int j = 0; j < 8; ++j) v[j] += sr[64 * j]; }
                f32x4* xw = (f32x4*)(X + (size_t)row * DM) + F.lane;
#pragma unroll
                for (int j = 0; j < 8; ++j) xw[64 * j] = v[j];
            }
            float s = 0.f;
#pragma unroll
            for (int j = 0; j < 8; ++j) { s += (v[j][0] * v[j][0] + v[j][1] * v[j][1]) + (v[j][2] * v[j][2] + v[j][3] * v[j][3]); }
            const float rstd = rsqrtf(wave_sum(s) * (1.0f / DM) + RMS_EPS);
            const float* mp = mods_l + (size_t)mod_row(row) * 12288;
#pragma unroll
            for (int j = 0; j < 8; ++j) { const int col = 4 * (F.lane + 64 * j);
                const f32x4 g = *(const f32x4*)(ng + col), sh = *(const f32x4*)(mp + ch_shift * DM + col), sc = *(const f32x4*)(mp + ch_scale * DM + col);
                const f32x4 h = (v[j] * rstd * g) * (sc + 1.0f) + sh;
                u32x2 w; w.x = cvt_pk_bf16(h[0], h[1]); w.y = cvt_pk_bf16(h[2], h[3]);
                *(u32x2*)(H + (size_t)row * DM + col) = w; }
        }
    }
}

__device__ __forceinline__ int gla_row(int b, int dir, int n, int p) {
    if (n < 4) { const int s = 64 * n + p, t = dir ? (CTXL - 1 - s) : s; return ML + b * CTXL + t; }
    const int s = 64 * (n - 4) + p, t = dir ? (SEQ - 1 - s) : s; return b * SEQ + t;
}
__device__ __forceinline__ void gla_prep_units(const Frame& F, int layer) {
  const int tid = F.tid;
  u32x4 tq[4], tk[4], tv[4]; f32x4 tlr = (f32x4){0.f, 0.f, 0.f, 0.f};
#define PREP_LOAD(uu) do { const int n_ = (uu) % NCH, cd_ = (uu) / NCH, dir_ = cd_ & 1, h_ = (cd_ >> 1) & 3, b_ = cd_ >> 3; \
      _Pragma("unroll") for (int i = 0; i < 4; ++i) { const int idx = tid + 512 * i, p = idx >> 5, sg = (idx & 31) * 8; const bf16_t* zr = (const bf16_t*)(F.ws + WS_Z) + (size_t)gla_row(b_, dir_, n_, p) * NZB + h_ * 256 + sg; \
          tq[i] = *(const u32x4*)(zr + ZC_GQ); tk[i] = *(const u32x4*)(zr + ZC_GK); tv[i] = *(const u32x4*)(zr + ZC_GV); } \
      if (tid < 256) { const int p = tid >> 2, q4 = tid & 3; tlr = *(const f32x4*)((const float*)(F.ws + WS_ZT) + (size_t)gla_row(b_, dir_, n_, p) * 256 + ZT_LR + dir_ * 16 + q4 * 4); } } while (0)
  int u = F.c; if (u >= NGU) return;
  PREP_LOAD(u);
  for (; u < NGU; u += F.G) {
    const int n = u % NCH, cd = u / NCH, dir = cd & 1, bh = cd >> 1, h = bh & 3, b = bh >> 2;
    bf16_t* Ql = (bf16_t*)F.ldsg; bf16_t* Kl = (bf16_t*)(F.ldsg + 33792); bf16_t* Vl = (bf16_t*)(F.ldsg + 2 * 33792); float* lrs = (float*)(F.ldsg + 3 * 33792); float* hs = lrs + 1024;
    const bf16_t* Z = (const bf16_t*)(F.ws + WS_Z); const float* ZT = (const float*)(F.ws + WS_ZT);
    bf16_t* GQ = (bf16_t*)(F.ws + WS_GQ) + (size_t)u * 16384; bf16_t* GKT = (bf16_t*)(F.ws + WS_GKT) + (size_t)u * 16384; bf16_t* GVT = (bf16_t*)(F.ws + WS_GVT) + (size_t)u * 16384;
    bf16_t* GP = (bf16_t*)(F.ws + WS_GP) + (size_t)u * 4096; float* GD = (float*)(F.ws + WS_GD) + (size_t)u * 256;
    { if (tid < 256) { const int p = tid >> 2, q4 = tid & 3; *(f32x4*)(lrs + p * 16 + q4 * 4) = tlr; }
#pragma unroll
      for (int i = 0; i < 4; ++i) { const int idx = tid + 512 * i, p = idx >> 5, sg = (idx & 31) * 8;
          *(u32x4*)(Ql + p * 264 + sg) = tq[i]; *(u32x4*)(Kl + p * 264 + sg) = tk[i]; *(u32x4*)(Vl + p * 264 + sg) = tv[i]; } }
    const int d = tid & 255, hf = tid >> 8, col = h * 256 + d;
    float w[16];
#pragma unroll
    for (int r = 0; r < 16; ++r) w[r] = F.in[I_GWG][((size_t)(layer * 2 + dir) * 16 + r) * 1024 + col];
    const float bias = F.in[I_GBG][(layer * 2 + dir) * 1024 + col];
    __syncthreads();
    if (u + F.G < NGU) PREP_LOAD(u + F.G);
    float cum[32]; float run = 0.f;
#pragma unroll
    for (int i = 0; i < 32; ++i) { const int p = 32 * hf + i; float lg = bias;
#pragma unroll
        for (int r = 0; r < 16; ++r) lg += lrs[p * 16 + r] * w[r];
        const float ls = fminf(lg, 0.f) - __logf(1.0f + __expf(-fabsf(lg)));
        run += ls * (1.0f / 16.0f); cum[i] = run; }
    hs[hf * 256 + d] = run; __syncthreads();
    const float tot0 = hs[d], tot1 = hs[256 + d], last = tot0 + tot1, off = hf ? tot0 : 0.f, elast = __expf(last);
    unsigned khp[16], vvp[16];
#pragma unroll
    for (int i = 0; i < 32; i += 2) {
        float kh2[2]; unsigned short vv2[2];
#pragma unroll
        for (int e = 0; e < 2; ++e) { const int p = 32 * hf + i + e; const float cc = cum[i + e] + off;
            const float q = bf2f(Ql[p * 264 + d]), k = bf2f(Kl[p * 264 + d]); vv2[e] = Vl[p * 264 + d];
            const float ec = __expf(cc), kt = k * __builtin_amdgcn_rcpf(ec);
            Ql[p * 264 + d] = f2bf(q * 0.0625f * ec); Kl[p * 264 + d] = f2bf(kt);
            kh2[e] = kt * elast; }
        khp[i >> 1] = cvt_pk_bf16(kh2[0], kh2[1]); vvp[i >> 1] = (unsigned)vv2[0] | ((unsigned)vv2[1] << 16); }
#pragma unroll
    for (int q = 0; q < 4; ++q) { *(u32x4*)(GKT + d * 64 + 32 * hf + 8 * q) = (u32x4){khp[4 * q], khp[4 * q + 1], khp[4 * q + 2], khp[4 * q + 3]};
                                  *(u32x4*)(GVT + d * 64 + 32 * hf + 8 * q) = (u32x4){vvp[4 * q], vvp[4 * q + 1], vvp[4 * q + 2], vvp[4 * q + 3]}; }
    if (hf == 0) GD[d] = elast;
    __syncthreads();
#pragma unroll
    for (int i = 0; i < 4; ++i) { const int idx = tid + 512 * i, p = idx >> 5, sg = (idx & 31) * 8; *(u32x4*)(GQ + p * 256 + sg) = *(const u32x4*)(Ql + p * 264 + sg); }
    { const int l15 = F.lane & 15, l4 = F.lane >> 4, tb = F.wave >> 1;
#pragma unroll
      for (int q = 0; q < 2; ++q) { const int sb = 2 * (F.wave & 1) + q; f32x4 acc = (f32x4){0.f, 0.f, 0.f, 0.f};
          if (sb <= tb) {
#pragma unroll
              for (int kk = 0; kk < 8; ++kk) { const bf16x8 a = *(const bf16x8*)(Kl + (sb * 16 + l15) * 264 + kk * 32 + 8 * l4), bq = *(const bf16x8*)(Ql + (tb * 16 + l15) * 264 + kk * 32 + 8 * l4);
                  acc = __builtin_amdgcn_mfma_f32_16x16x32_bf16(a, bq, acc, 0, 0, 0); } }
          const int t = tb * 16 + l15, s0 = sb * 16 + 4 * l4;
          float o[4];
#pragma unroll
          for (int j = 0; j < 4; ++j) o[j] = (s0 + j <= t) ? acc[j] : 0.f;
          u32x2 wv; wv.x = cvt_pk_bf16(o[0], o[1]); wv.y = cvt_pk_bf16(o[2], o[3]);
          *(u32x2*)(GP + t * 64 + s0) = wv; } }
    __syncthreads();
  }
#undef PREP_LOAD
}

__device__ __forceinline__ void gla_scan_unit(const Frame& F, int unit, int snap_from, int it0, int it_end, int it_stride) {
    const int es = unit & 7, cd = unit >> 3;
    const int u0 = cd * NCH;
    const int l15 = F.lane & 15, l4 = F.lane >> 4, w = F.wave;
    bf16_t* Sl = (bf16_t*)(F.ldsg + 4 * 8448);
    if (w < 4) {
        const unsigned o64 = (unsigned)(l15 * 64 + 8 * l4) * 2u, od = (unsigned)(4 * l4) * 4u;
        const f32x4 z4 = (f32x4){0.f, 0.f, 0.f, 0.f};
        f32x4 S00 = z4, S01 = z4, S10 = z4, S11 = z4, S20 = z4, S21 = z4, S30 = z4, S31 = z4;
        bf16x8 vA00, vA01, vA10, vA11, kA00, kA01, kA10, kA11, kA20, kA21, kA30, kA31; f32x4 dA0, dA1, dA2, dA3;
        bf16x8 vB00, vB01, vB10, vB11, kB00, kB01, kB10, kB11, kB20, kB21, kB30, kB31; f32x4 dB0, dB1, dB2, dB3;
#define SCAN_LOAD(X, u) do { \
    const char* gv_ = (const char*)(F.ws + WS_GVT) + ((size_t)(u) * 16384 + es * 32 * 64) * 2 + o64; \
    v##X##00 = *(const bf16x8*)(gv_); v##X##01 = *(const bf16x8*)(gv_ + 64); v##X##10 = *(const bf16x8*)(gv_ + 2048); v##X##11 = *(const bf16x8*)(gv_ + 2048 + 64); \
    const char* gk_ = (const char*)(F.ws + WS_GKT) + ((size_t)(u) * 16384 + 64 * w * 64) * 2 + o64; \
    k##X##00 = *(const bf16x8*)(gk_); k##X##01 = *(const bf16x8*)(gk_ + 64); k##X##10 = *(const bf16x8*)(gk_ + 2048); k##X##11 = *(const bf16x8*)(gk_ + 2048 + 64); \
    k##X##20 = *(const bf16x8*)(gk_ + 4096); k##X##21 = *(const bf16x8*)(gk_ + 4096 + 64); k##X##30 = *(const bf16x8*)(gk_ + 6144); k##X##31 = *(const bf16x8*)(gk_ + 6144 + 64); \
    const char* gd_ = (const char*)(F.ws + WS_GD) + ((size_t)(u) * 256 + 64 * w) * 4 + od; \
    d##X##0 = *(const f32x4*)(gd_); d##X##1 = *(const f32x4*)(gd_ + 64); d##X##2 = *(const f32x4*)(gd_ + 128); d##X##3 = *(const f32x4*)(gd_ + 192); } while (0)
#define MF16(a, b, c) __builtin_amdgcn_mfma_f32_16x16x32_bf16(a, b, c, 0, 0, 0)
#define SCAN_PUT(sp, T) do { u32x2 wv_; wv_.x = cvt_pk_bf16(T[0], T[1]); wv_.y = cvt_pk_bf16(T[2], T[3]); *(u32x2*)(sp) = wv_; } while (0)
#define SCAN_STEP(X, n) do { \
    { bf16_t* sp = Sl + ((n) & 1) * (32 * 264) + l15 * 264 + 64 * w + 4 * l4; \
      SCAN_PUT(sp, S00); SCAN_PUT(sp + 16 * 264, S01); SCAN_PUT(sp + 16, S10); SCAN_PUT(sp + 16 * 264 + 16, S11); \
      SCAN_PUT(sp + 32, S20); SCAN_PUT(sp + 16 * 264 + 32, S21); SCAN_PUT(sp + 48, S30); SCAN_PUT(sp + 16 * 264 + 48, S31); } \
    asm volatile("s_waitcnt lgkmcnt(0)" ::: "memory"); __builtin_amdgcn_s_barrier(); asm volatile("" ::: "memory"); \
    S00 = S00 * d##X##0; S01 = S01 * d##X##0; S10 = S10 * d##X##1; S11 = S11 * d##X##1; S20 = S20 * d##X##2; S21 = S21 * d##X##2; S30 = S30 * d##X##3; S31 = S31 * d##X##3; \
    S00 = MF16(k##X##00, v##X##00, S00); S01 = MF16(k##X##00, v##X##10, S01); S10 = MF16(k##X##10, v##X##00, S10); S11 = MF16(k##X##10, v##X##10, S11); \
    S20 = MF16(k##X##20, v##X##00, S20); S21 = MF16(k##X##20, v##X##10, S21); S30 = MF16(k##X##30, v##X##00, S30); S31 = MF16(k##X##30, v##X##10, S31); \
    S00 = MF16(k##X##01, v##X##01, S00); S01 = MF16(k##X##01, v##X##11, S01); S10 = MF16(k##X##11, v##X##01, S10); S11 = MF16(k##X##11, v##X##11, S11); \
    S20 = MF16(k##X##21, v##X##01, S20); S21 = MF16(k##X##21, v##X##11, S21); S30 = MF16(k##X##31, v##X##01, S30); S31 = MF16(k##X##31, v##X##11, S31); } while (0)
        SCAN_LOAD(A, u0);
#pragma unroll 1
        for (int n = 0; n < NCH; n += 2) {
            SCAN_LOAD(B, u0 + n + 1);
            SCAN_STEP(A, n);
            SCAN_LOAD(A, u0 + (n + 2 < NCH ? n + 2 : NCH - 1));
            SCAN_STEP(B, n + 1);
        }
#undef SCAN_LOAD
#undef SCAN_STEP
#undef SCAN_PUT
#undef MF16
    } else {
        const int i = w - 4;
        LAS float* scr = (LAS float*)(F.lds + i * 8448);
        float cv[32], cw[32]; const float* c_src; int c_ld, c_c0, c_k0, c_ldd, c_r0; bf16_t* c_dst; const float* c_ks; const float* c_ns;
        const float* e_src; int e_ld, e_c0, e_k0, e_ldd, e_r0; bf16_t* e_dst; const float* e_ks; const float* e_ns; int it = it0;
        bool a_on = false, b_on = false;
#define CONV_ISSUE() do { a_on = it < it_end; b_on = it + it_stride < it_end; \
        if (a_on) { item_decode(F, it, c_src, c_ld, c_c0, c_k0, c_dst, c_ldd, c_r0, c_ks, c_ns); item_load(cv, c_src, c_ld, c_c0, c_k0, F.lane); } \
        if (b_on) { item_decode(F, it + it_stride, e_src, e_ld, e_c0, e_k0, e_dst, e_ldd, e_r0, e_ks, e_ns); item_load(cw, e_src, e_ld, e_c0, e_k0, F.lane); } \
        it += 2 * it_stride; } while (0)
#define CONV_FINISH() do { if (a_on) item_finish(cv, c_k0, c_dst, c_ldd, c_r0, c_ks, c_ns, scr, F.lane); \
        if (b_on) item_finish(cw, e_k0, e_dst, e_ldd, e_r0, e_ks, e_ns, scr, F.lane); a_on = false; b_on = false; } while (0)
#pragma unroll 1
        for (int n = 0; n < NCH; ++n) {
            asm volatile("" ::: "memory"); __builtin_amdgcn_s_barrier(); asm volatile("" ::: "memory");
            if (n >= snap_from) {
                const bf16_t* sl = Sl + (n & 1) * (32 * 264);
                bf16_t* sn = (bf16_t*)(F.ws + WS_SN) + ((size_t)(u0 + n) * 256 + es * 32) * 256;
                u32x4 t[4];
#pragma unroll
                for (int j = 0; j < 4; ++j) { const int c = i * 64 + F.lane + 256 * j; t[j] = *(const u32x4*)(sl + (c >> 5) * 264 + (c & 31) * 8); }
                asm volatile("s_waitcnt lgkmcnt(0)" ::: "memory");
#pragma unroll
                for (int j = 0; j < 4; ++j) { const int c = i * 64 + F.lane + 256 * j; *(u32x4*)(sn + (c >> 5) * 256 + (c & 31) * 8) = t[j]; }
            }
            if (n & 1) CONV_FINISH(); else CONV_ISSUE();
        }
        CONV_FINISH();
        while (it < it_end) { CONV_ISSUE(); CONV_FINISH(); }
#undef CONV_ISSUE
#undef CONV_FINISH
    }
    __syncthreads();
}
__device__ __forceinline__ void gla_o_unit(const Frame& F, int layer, int unit) {
    const int jj = unit % NCH, bh = unit / NCH, h = bh & 3, b = bh >> 2;
    const int l15 = F.lane & 15, l4 = F.lane >> 4, w = F.wave, tid = F.tid;
    const int row0 = jj < 4 ? (ML + b * CTXL + 64 * jj) : (b * SEQ + 64 * (jj - 4));
    const int nb = jj < 4 ? 3 - jj : 39 - jj;
    const size_t uf = (size_t)((bh * 2 + 0) * NCH + jj), ub = (size_t)((bh * 2 + 1) * NCH + nb);
    bf16_t* Ql = (bf16_t*)F.ldsg;
    bf16_t* Pl = (bf16_t*)(F.ldsg + 2 * 33792);
    float* part = (float*)(F.ldsg + 2 * 33792 + 2 * 9216);
    float* rs = part + 512;
    u32x4 tq[8], tp[2];
#pragma unroll
    for (int i = 0; i < 8; ++i) { const int idx = tid + 512 * i, dir = idx >> 11, r = idx & 2047;
        tq[i] = *(const u32x4*)((const char*)(F.ws + WS_GQ) + (dir ? ub : uf) * 32768 + (size_t)r * 16); }
#pragma unroll
    for (int i = 0; i < 2; ++i) { const int idx = tid + 512 * i, dir = idx >> 9, r = idx & 511;
        tp[i] = *(const u32x4*)((const char*)(F.ws + WS_GP) + (dir ? ub : uf) * 8192 + (size_t)r * 16); }
    const unsigned so = (unsigned)((32 * w + l15) * 512 + 16 * l4), vo = (unsigned)((32 * w + l15) * 128 + 16 * l4);
    bf16x8 sf[2][8], vf[2][2], sbk[2][8], vbk[2][2];
    { const char* sn = (const char*)(F.ws + WS_SN) + uf * 131072 + so; const char* gv = (const char*)(F.ws + WS_GVT) + uf * 32768 + vo;
#pragma unroll
      for (int eb = 0; eb < 2; ++eb) {
#pragma unroll
          for (int kk = 0; kk < 8; ++kk) sf[eb][kk] = *(const bf16x8*)(sn + eb * 8192 + kk * 64);
#pragma unroll
          for (int ss = 0; ss < 2; ++ss) vf[eb][ss] = *(const bf16x8*)(gv + eb * 2048 + ss * 64); } }
#pragma unroll
    for (int i = 0; i < 8; ++i) { const int idx = tid + 512 * i, dir = idx >> 11, r = idx & 2047; *(u32x4*)(Ql + dir * (64 * 264) + (r >> 5) * 264 + (r & 31) * 8) = tq[i]; }
#pragma unroll
    for (int i = 0; i < 2; ++i) { const int idx = tid + 512 * i, dir = idx >> 9, r = idx & 511; *(u32x4*)(Pl + dir * (64 * 72) + (r >> 3) * 72 + (r & 7) * 8) = tp[i]; }
    { const char* sn = (const char*)(F.ws + WS_SN) + ub * 131072 + so; const char* gv = (const char*)(F.ws + WS_GVT) + ub * 32768 + vo;
#pragma unroll
      for (int eb = 0; eb < 2; ++eb) {
#pragma unroll
          for (int kk = 0; kk < 8; ++kk) sbk[eb][kk] = *(const bf16x8*)(sn + eb * 8192 + kk * 64);
#pragma unroll
          for (int ss = 0; ss < 2; ++ss) vbk[eb][ss] = *(const bf16x8*)(gv + eb * 2048 + ss * 64); } }
    __syncthreads();
    f32x4 acc[4][2];
#pragma unroll
    for (int tb = 0; tb < 4; ++tb)
#pragma unroll
        for (int eb = 0; eb < 2; ++eb) acc[tb][eb] = (f32x4){0.f, 0.f, 0.f, 0.f};
#pragma unroll
    for (int dir = 0; dir < 2; ++dir) {
        const bf16_t* ql = Ql + dir * (64 * 264) + 8 * l4; const bf16_t* pl = Pl + dir * (64 * 72) + 8 * l4;
#pragma unroll
        for (int tb = 0; tb < 4; ++tb) { const int t = tb * 16 + l15, p = dir ? 63 - t : t;
#pragma unroll
            for (int kk = 0; kk < 8; ++kk) { const bf16x8 qa = *(const bf16x8*)(ql + p * 264 + kk * 32);
#pragma unroll
                for (int eb = 0; eb < 2; ++eb) acc[tb][eb] = __builtin_amdgcn_mfma_f32_16x16x32_bf16(dir ? sbk[eb][kk] : sf[eb][kk], qa, acc[tb][eb], 0, 0, 0); }
#pragma unroll
            for (int ss = 0; ss < 2; ++ss) { const bf16x8 pa = *(const bf16x8*)(pl + p * 72 + ss * 32);
#pragma unroll
                for (int eb = 0; eb < 2; ++eb) acc[tb][eb] = __builtin_amdgcn_mfma_f32_16x16x32_bf16(dir ? vbk[eb][ss] : vf[eb][ss], pa, acc[tb][eb], 0, 0, 0); } }
    }
#pragma unroll
    for (int tb = 0; tb < 4; ++tb) { float q = 0.f;
#pragma unroll
        for (int eb = 0; eb < 2; ++eb) q += (acc[tb][eb][0] * acc[tb][eb][0] + acc[tb][eb][1] * acc[tb][eb][1]) + (acc[tb][eb][2] * acc[tb][eb][2] + acc[tb][eb][3] * acc[tb][eb][3]);
        q += __shfl_xor(q, 16); q += __shfl_xor(q, 32);
        if (l4 == 0) part[(tb * 16 + l15) * 8 + w] = q; }
    __syncthreads();
    if (tid < 64) { float q = 0.f;
#pragma unroll
        for (int i = 0; i < 8; ++i) q += part[tid * 8 + i];
        rs[tid] = rsqrtf(q * (1.0f / 256.0f) + RMS_EPS); }
    __syncthreads();
    const bf16_t* Z = (const bf16_t*)(F.ws + WS_Z); bf16_t* O = (bf16_t*)(F.ws + WS_BR) + (size_t)2 * MT * 1024;
#pragma unroll
    for (int eb = 0; eb < 2; ++eb) { const int e = 32 * w + 16 * eb + 4 * l4; const f32x4 g = *(const f32x4*)(F.in[I_GONG] + layer * 256 + e);
#pragma unroll
        for (int tb = 0; tb < 4; ++tb) { const int t = tb * 16 + l15; const float r = rs[t]; const size_t row = (size_t)(row0 + t);
            const u32x2 gw = *(const u32x2*)(Z + row * NZB + ZC_GG + h * 256 + e);
            const f32x4 o = acc[tb][eb];
            u32x2 wv; wv.x = cvt_pk_bf16(o[0] * r * g[0] * fast_silu(bflo(gw.x)), o[1] * r * g[1] * fast_silu(bfhi(gw.x)));
            wv.y = cvt_pk_bf16(o[2] * r * g[2] * fast_silu(bflo(gw.y)), o[3] * r * g[3] * fast_silu(bfhi(gw.y)));
            *(u32x2*)(O + row * 1024 + h * 256 + e) = wv; } }
    __syncthreads();
}

__device__ __forceinline__ void pool_rows(const Frame& F) {
    const bf16_t* Z = (const bf16_t*)(F.ws + WS_Z); bf16_t* P = (bf16_t*)(F.ws + WS_POOLED);
    const int gt = F.c * 512 + F.tid, NT = F.G * 512;
    for (int idx = gt; idx < MT * 128; idx += NT) {
        const int row = idx >> 7, c0 = (idx & 127) * 8, gi = c0 >> 8, hw = 1 << gi;
        int base, t, L;
        if (row < ML) { base = row & ~(SEQ - 1); t = row & (SEQ - 1); L = SEQ; } else { const int r = row - ML; base = ML + (r & ~(CTXL - 1)); t = r & (CTXL - 1); L = CTXL; }
        const int lo = max(t - hw, 0), hi = min(t + hw - 1, L - 1);
        float s[8];
#pragma unroll
        for (int j = 0; j < 8; ++j) s[j] = 0.f;
        for (int i = lo; i <= hi; ++i) { const u32x4 v = *(const u32x4*)(Z + (size_t)(base + i) * NZB + ZC_PIN + c0);
            s[0] += bflo(v.x); s[1] += bfhi(v.x); s[2] += bflo(v.y); s[3] += bfhi(v.y); s[4] += bflo(v.z); s[5] += bfhi(v.z); s[6] += bflo(v.w); s[7] += bfhi(v.w); }
        const u32x4 v = *(const u32x4*)(Z + (size_t)row * NZB + ZC_PIN + c0);
        const float ic = 1.0f / (float)(hi - lo + 1);
        u32x4 o; o.x = cvt_pk_bf16(s[0] * ic - bflo(v.x), s[1] * ic - bfhi(v.x)); o.y = cvt_pk_bf16(s[2] * ic - bflo(v.y), s[3] * ic - bfhi(v.y));
        o.z = cvt_pk_bf16(s[4] * ic - bflo(v.z), s[5] * ic - bfhi(v.z)); o.w = cvt_pk_bf16(s[6] * ic - bflo(v.w), s[7] * ic - bfhi(v.w));
        *(u32x4*)(P + (size_t)row * 1024 + c0) = o;
    }
}

__device__ __forceinline__ void post_up_rows(const Frame& F, int layer) {
    const bf16_t* Z = (const bf16_t*)(F.ws + WS_Z); const float* ZT = (const float*)(F.ws + WS_ZT); const bf16_t* R = (const bf16_t*)(F.ws + WS_QKVR);
    bf16_t* QF = (bf16_t*)(F.ws + WS_QF); bf16_t* KF = (bf16_t*)(F.ws + WS_KF); bf16_t* VF = (bf16_t*)(F.ws + WS_VF);
    const float* rope = (const float*)(F.ws + WS_ROPE);
    const int lane = F.lane, h = lane >> 3, sub = lane & 7;
    float* gl = (float*)F.ldsg;
    float* qs = (float*)(F.ldsg + 2048) + F.wave * (8 * 192);
    float* kb = (float*)(F.ldsg + 2048 + 8 * 8 * 192 * 4) + F.wave * 64;
    for (int i = F.tid; i < 384; i += 512) gl[i] = i < 192 ? F.in[I_QHG][layer * 192 + i] : F.in[I_KHG][layer * 192 + (i - 192)];
    __syncthreads();
    for (int row = F.c * 8 + F.wave; row < MT; row += F.G * 8) {
        int b, pos, prow = 0, pcol = 0; const bool lat = row < ML;
        if (lat) { b = row >> 11; const int t = row & (SEQ - 1); pos = CTXL + t; prow = t >> 6; pcol = 32 + (t & 63); }
        else { const int r = row - ML; b = r >> 8; pos = r & (CTXL - 1); }
        const bf16_t* rr = R + (size_t)row * NQKV;
        const u32x4 ca = *(const u32x4*)(Z + (size_t)row * NZB + ZC_CQ + 8 * lane), cc = *(const u32x4*)(Z + (size_t)row * NZB + ZC_CKV + 8 * lane);
        const float kr = ZT[(size_t)row * 256 + ZT_KR + lane];
        u32x4 qw[3], kw[4];
#pragma unroll
        for (int j = 0; j < 3; ++j) qw[j] = *(const u32x4*)(rr + h * 192 + sub * 24 + 8 * j);
#pragma unroll
        for (int j = 0; j < 4; ++j) kw[j] = *(const u32x4*)(rr + 1536 + h * 256 + sub * 32 + 8 * j);
        float sq = 0.f, skv = 0.f;
        { const unsigned aw[4] = {ca.x, ca.y, ca.z, ca.w}, cw[4] = {cc.x, cc.y, cc.z, cc.w};
#pragma unroll
          for (int j = 0; j < 4; ++j) { sq += bflo(aw[j]) * bflo(aw[j]) + bfhi(aw[j]) * bfhi(aw[j]); skv += bflo(cw[j]) * bflo(cw[j]) + bfhi(cw[j]) * bfhi(cw[j]); } }
        const float rq = rsqrtf(wave_sum(sq) * (1.0f / 512.0f) + RMS_EPS), rkv = rsqrtf(wave_sum(skv) * (1.0f / 512.0f) + RMS_EPS);
        const float kr2 = wave_sum(kr * kr);
        { float x = kr * gl[192 + 128 + lane];
          if (lat) { const float* cs = rope + ((lane < 32 ? prow : pcol) * 16 + (lane & 15)) * 2; const float pr = __shfl_xor(x, 16);
              x = (lane & 16) ? (x * cs[0] + pr * cs[1]) : (x * cs[0] - pr * cs[1]); }
          kb[lane] = x; }
        float q[24]; float ss = 0.f;
#pragma unroll
        for (int j = 0; j < 3; ++j) { const unsigned w4[4] = {qw[j].x, qw[j].y, qw[j].z, qw[j].w};
#pragma unroll
            for (int e = 0; e < 4; ++e) { q[8 * j + 2 * e] = bflo(w4[e]) * rq; q[8 * j + 2 * e + 1] = bfhi(w4[e]) * rq; } }
#pragma unroll
        for (int i = 0; i < 24; ++i) ss += q[i] * q[i];
        ss += __shfl_xor(ss, 1); ss += __shfl_xor(ss, 2); ss += __shfl_xor(ss, 4);
        const float rh = rsqrtf(ss * (1.0f / 192.0f) + RMS_EPS);
#pragma unroll
        for (int i = 0; i < 24; ++i) q[i] *= rh * gl[sub * 24 + i];
        if (lat) {
            float* qh = qs + h * 192 + sub * 24;
#pragma unroll
            for (int j = 0; j < 6; ++j) *(f32x4*)(qh + 4 * j) = (f32x4){q[4 * j], q[4 * j + 1], q[4 * j + 2], q[4 * j + 3]};
            LDS_WAIT(); asm volatile("" ::: "memory");
            if (sub >= 5) {
#pragma unroll
                for (int i = 0; i < 24; ++i) { const int dd = sub * 24 + i;
                    if (dd >= 128) { const int r = dd - 128; const float pr = qs[h * 192 + 128 + (r ^ 16)];
                        const float* cs = rope + ((r < 32 ? prow : pcol) * 16 + (r & 15)) * 2;
                        q[i] = (r & 16) ? (q[i] * cs[0] + pr * cs[1]) : (q[i] * cs[0] - pr * cs[1]); } }
            }
        }
        const size_t ob = ((size_t)(b * 8 + h) * KPOS + pos);
#pragma unroll
        for (int j = 0; j < 3; ++j) { u32x4 w; w.x = cvt_pk_bf16(q[8 * j], q[8 * j + 1]); w.y = cvt_pk_bf16(q[8 * j + 2], q[8 * j + 3]); w.z = cvt_pk_bf16(q[8 * j + 4], q[8 * j + 5]); w.w = cvt_pk_bf16(q[8 * j + 6], q[8 * j + 7]);
            *(u32x4*)(QF + ob * 192 + sub * 24 + 8 * j) = w; }
        float kv[32]; float sk = 0.f;
#pragma unroll
        for (int j = 0; j < 4; ++j) { const unsigned w4[4] = {kw[j].x, kw[j].y, kw[j].z, kw[j].w};
#pragma unroll
            for (int e = 0; e < 4; ++e) { kv[8 * j + 2 * e] = bflo(w4[e]) * rkv; kv[8 * j + 2 * e + 1] = bfhi(w4[e]) * rkv; } }
        if (sub < 4) {
#pragma unroll
            for (int i = 0; i < 32; ++i) sk += kv[i] * kv[i]; }
        sk += __shfl_xor(sk, 1); sk += __shfl_xor(sk, 2); sk += __shfl_xor(sk, 4);
        const float rk = rsqrtf((sk + kr2) * (1.0f / 192.0f) + RMS_EPS);
        if (sub < 4) {
#pragma unroll
            for (int i = 0; i < 32; ++i) kv[i] *= rk * gl[192 + sub * 32 + i]; }
        bf16_t* kvp = sub < 4 ? KF + ob * 192 + sub * 32 : VF + ob * 128 + (sub - 4) * 32;
#pragma unroll
        for (int j = 0; j < 4; ++j) { u32x4 w; w.x = cvt_pk_bf16(kv[8 * j], kv[8 * j + 1]); w.y = cvt_pk_bf16(kv[8 * j + 2], kv[8 * j + 3]); w.z = cvt_pk_bf16(kv[8 * j + 4], kv[8 * j + 5]); w.w = cvt_pk_bf16(kv[8 * j + 6], kv[8 * j + 7]);
            *(u32x4*)(kvp + 8 * j) = w; }
        { LDS_WAIT(); asm volatile("" ::: "memory");
          const f32x4 k0 = *(const f32x4*)(kb + sub * 8), k1 = *(const f32x4*)(kb + sub * 8 + 4);
          u32x4 w; w.x = cvt_pk_bf16(k0[0] * rk, k0[1] * rk); w.y = cvt_pk_bf16(k0[2] * rk, k0[3] * rk); w.z = cvt_pk_bf16(k1[0] * rk, k1[1] * rk); w.w = cvt_pk_bf16(k1[2] * rk, k1[3] * rk);
          *(u32x4*)(KF + ob * 192 + 128 + sub * 8) = w; }
        asm volatile("s_waitcnt lgkmcnt(0)" ::: "memory");
    }
    __syncthreads();
}

__global__ void __launch_bounds__(512, 2) fwd(Args args) {
    extern __shared__ __attribute__((aligned(16))) unsigned char lds[];
    Frame F;
    F.lds = (LAS unsigned char*)lds; F.ldsg = lds;
    F.tid = threadIdx.x; F.lane = F.tid & 63; F.wave = __builtin_amdgcn_readfirstlane(F.tid >> 6);
    F.G = gridDim.x; F.c = blockIdx.x; F.in = args.in; F.out = args.out; F.ws = args.ws;
    volatile LAS unsigned* MISC = (volatile LAS unsigned*)(F.lds + MISC_OFF);
    if (F.tid < 64) MISC[F.tid] = 0u;
    __syncthreads();
    XcdBarrier bar; bar.bar = (unsigned*)(F.ws + WS_CTL) + 4096; bar.x = 0; bar.st = nullptr;
    const bool single = args.single != 0;
    if (single) bar = xcd_barrier_post((unsigned*)(F.ws + WS_CTL) + 4096, MISC + 8);
    const int q_lo = args.q_lo, q_hi = args.q_hi;
#ifndef ONLY_PHASE
#define ONLY_PHASE -1
#endif
#define PEN(k) (ONLY_PHASE < 0 || ONLY_PHASE == (k))
#ifndef PROBE_MASK
#define PROBE_MASK 0
#endif
#define NREP(k) (((PROBE_MASK >> (k)) & 1) ? 2 : 1)
#define IN(q) (q_lo <= (q) && (q) < q_hi)
#define SEAM(q) do { if (single && (q) + 1 < q_hi) xcd_barrier(bar); } while (0)

    for (int rep_ = 0; rep_ < NREP(0); ++rep_) if (PEN(0) && IN(0)) { refresh_lane(F); phase_prologue(F); SEAM(0); }

    for (int layer = 0; layer < NLAYER; ++layer) {
        const int qb = 1 + layer * NPH;
        if (qb + NPH <= q_lo || qb >= q_hi) continue;
        const bf16_t* wl = (const bf16_t*)(F.ws + WS_W + (size_t)layer * W_LAYER);
        const float* mods_l = (const float*)(F.ws + WS_MODS) + (size_t)layer * 5 * 12288;
        const bool lastl = layer == NLAYER - 1;
        const bool nocopy0 = layer == 0 && F.G == 256;

        for (int rep_ = 0; rep_ < NREP(1); ++rep_) if (PEN(1) && IN(qb + 0)) { refresh_lane(F); phase_norm(F, MT, layer > 0 && F.G == 256, nocopy0 ? F.in[I_X] : (const float*)(F.ws + WS_X), nocopy0 ? F.in[I_CTX] : (const float*)(F.ws + WS_X) + (size_t)ML * DM, F.in[I_N1G] + layer * DM, mods_l, 0, 1); SEAM(qb + 0); }
        for (int rep_ = 0; rep_ < NREP(2); ++rep_) if (PEN(2) && IN(qb + 1)) { refresh_lane(F);
            pg8::Gemm g{(const bf16_t*)(F.ws + WS_H), wl + W_IN / 2, DM, DM}; pg8::SchedPlain S{36, 49, F.G, F.c, 0, 32};
            pg8::EpiZ E{(bf16_t*)(F.ws + WS_Z), (float*)(F.ws + WS_ZT)};
            pg8::gemm_phase<pg8::EpiZ, pg8::SchedPlain>(F.lds, g, S, E);
            SEAM(qb + 1);
        }
        for (int rep_ = 0; rep_ < NREP(3); ++rep_) if (PEN(3) && IN(qb + 2)) { refresh_lane(F);
            { pg8::Gemm g{(const bf16_t*)(F.ws + WS_Z), wl + W_QKV / 2, NZB, 512}; pg8::SchedPlain S{36, 14, F.G, F.c, 1, 8};
              pg8::EpiBf16 E{(bf16_t*)(F.ws + WS_QKVR), NQKV};
              for (int r2_ = 0; r2_ < NREP(24); ++r2_) pg8::gemm_phase<pg8::EpiBf16, pg8::SchedPlain>(F.lds, g, S, E); }
            __syncthreads();
            refresh_lane(F);
            for (int r2_ = 0; r2_ < NREP(21); ++r2_) gla_prep_units(F, layer);
            for (int r2_ = 0; r2_ < NREP(22); ++r2_) pool_rows(F);
            SEAM(qb + 2);
        }
        for (int rep_ = 0; rep_ < NREP(4); ++rep_) if (PEN(4) && IN(qb + 3)) { refresh_lane(F);
            for (int r2_ = 0; r2_ < NREP(20); ++r2_) post_up_rows(F, layer);
            __syncthreads();
            { pg8::Gemm g{(const bf16_t*)(F.ws + WS_POOLED), wl + W_P / 2, 1024, 256}; pg8::SchedPlain S{lastl ? 32 : 36, 4, F.G, F.G - 1 - F.c, 2, 4};
              pg8::EpiBf16 E{(bf16_t*)(F.ws + WS_BR), 1024};
              pg8::gemm_phase<pg8::EpiBf16, pg8::SchedPlain>(F.lds, g, S, E); }
            SEAM(qb + 3);
        }
        for (int rep_ = 0; rep_ < NREP(5); ++rep_) if (PEN(5) && IN(qb + 4)) { refresh_lane(F);
            const bf16_t* QF = (const bf16_t*)(F.ws + WS_QF); const bf16_t* KF = (const bf16_t*)(F.ws + WS_KF); const bf16_t* VF = (const bf16_t*)(F.ws + WS_VF);
            bf16_t* O = (bf16_t*)(F.ws + WS_BR) + (size_t)MT * 1024;
            for (int i = F.c; i < 256 + (lastl ? 0 : 32); i += F.G) {
                int b, h, qpos, orow, seq;
                if (i < 256) { b = i >> 6; h = (i >> 3) & 7; const int qblk = i & 7; qpos = CTXL + qblk * 256; orow = b * SEQ + qblk * 256; seq = KPOS; }
                else { const int j = i - 256; b = j >> 3; h = j & 7; qpos = 0; orow = ML + b * CTXL; seq = CTXL; }
                const size_t hb = (size_t)(b * 8 + h) * KPOS;
                att::attn_body(QF + (hb + qpos) * 192, KF + hb * 192, VF + hb * 128, O + (size_t)orow * 1024 + h * 128, 1024, seq, (char*)lds);
            }
            for (int r2_ = 0; r2_ < NREP(25); ++r2_) for (int u = F.c; u < 256; u += F.G) { const int r8 = u >> 3; gla_scan_unit(F, (((u & 7) * 4 + (r8 >> 3)) << 3) | (r8 & 7), lastl ? 4 : 0, (F.G == 256 && !lastl) ? (layer + 1) * IT_LAYER + F.c * 4 + (F.wave & 3) : 0, (F.G == 256 && !lastl) ? (layer + 2) * IT_LAYER : 0, 1024); }
            SEAM(qb + 4);
        }
        for (int rep_ = 0; rep_ < NREP(6); ++rep_) if (PEN(6) && IN(qb + 5)) { refresh_lane(F); for (int r2_ = 0; r2_ < NREP(23); ++r2_) for (int u = F.c; u < NB * 4 * NCH; u += F.G) { if (lastl && (u % NCH) < 4) continue; gla_o_unit(F, layer, u); }
            SEAM(qb + 5); }
        for (int rep_ = 0; rep_ < NREP(7); ++rep_) if (PEN(7) && IN(qb + 6)) { refresh_lane(F);
            pg8::Gemm g{(const bf16_t*)(F.ws + WS_BR), wl + W_B / 2, 1024, 1024}; pg8::SchedMerge S{F.G, F.c, !lastl};
            pg8::EpiMerge E{(const bf16_t*)(F.ws + WS_Z), (bf16_t*)(F.ws + WS_MERGED), (float*)(F.ws + WS_MSLAB)};
            pg8::gemm_phase<pg8::EpiMerge, pg8::SchedMerge>(F.lds, g, S, E);
            SEAM(qb + 6);
        }
        if (PEN(8) && IN(qb + 7)) { refresh_lane(F);
            if (!lastl && F.G == 256) {
                const int pmc = F.c >> 6, j = F.c & 7; const float* MS = (const float*)(F.ws + WS_MSLAB); bf16_t* MG = (bf16_t*)(F.ws + WS_MERGED);
#pragma unroll 4
                for (int i = 0; i < 32; ++i) { const int idx = F.tid + 512 * i, rowc = pmc * 256 + (idx >> 6), cc = 256 * j + (idx & 63) * 4;
                    f32x4 v = *(const f32x4*)(MS + (size_t)rowc * DM + cc);
#pragma unroll
                    for (int r = 1; r < 6; ++r) v += *(const f32x4*)(MS + ((size_t)r * MC + rowc) * DM + cc);
                    u32x2 w; w.x = cvt_pk_bf16(v[0], v[1]); w.y = cvt_pk_bf16(v[2], v[3]);
                    *(u32x2*)(MG + (size_t)(ML + rowc) * DM + cc) = w; }
                VM_WAIT(); __builtin_amdgcn_fence(__ATOMIC_ACQUIRE, "agent"); VM_WAIT(); __syncthreads();
            }
            pg8::Gemm g{(const bf16_t*)(F.ws + WS_MERGED), wl + W_O / 2, DM, DM}; pg8::SchedTail S{F.G, F.c, 32, !lastl};
            pg8::EpiResid E{(float*)(F.ws + WS_X), nullptr, mods_l + 2 * DM, (float*)(F.ws + WS_RSLAB), nocopy0 ? F.in[I_X] : (const float*)(F.ws + WS_X)};
            pg8::gemm_phase<pg8::EpiResid, pg8::SchedTail>(F.lds, g, S, E);
            SEAM(qb + 7);
        }
        for (int rep_ = 0; rep_ < NREP(9); ++rep_) if (PEN(9) && IN(qb + 8)) { refresh_lane(F); phase_norm(F, lastl ? ML : MT, !lastl && F.G == 256, (const float*)(F.ws + WS_X), nocopy0 ? F.in[I_CTX] : (const float*)(F.ws + WS_X) + (size_t)ML * DM, F.in[I_N2G] + layer * DM, mods_l, 3, 4); SEAM(qb + 8); }
        for (int rep_ = 0; rep_ < NREP(10); ++rep_) if (PEN(10) && IN(qb + 9)) { refresh_lane(F);
            pg8::Gemm g{(const bf16_t*)(F.ws + WS_H), wl + W_13 / 2, DM, DM}; pg8::SchedPlain S{lastl ? 32 : 36, 44, F.G, F.c, 0, 32};
            pg8::EpiSwiGLU E{(bf16_t*)(F.ws + WS_ACT)};
            pg8::gemm_phase<pg8::EpiSwiGLU, pg8::SchedPlain>(F.lds, g, S, E);
            SEAM(qb + 9);
        }
        if (PEN(11) && IN(qb + 10)) { refresh_lane(F);
            pg8::Gemm g{(const bf16_t*)(F.ws + WS_ACT), wl + W_2 / 2, FF, FF}; pg8::SchedTail S{F.G, F.c, 88, !lastl};
            pg8::EpiResid E{(float*)(F.ws + WS_X), lastl ? F.out : nullptr, mods_l + 5 * DM, (float*)(F.ws + WS_RSLAB), (const float*)(F.ws + WS_X)};
            pg8::gemm_phase<pg8::EpiResid, pg8::SchedTail>(F.lds, g, S, E);
            SEAM(qb + 10);
        }
    }
#undef IN
#undef SEAM
}

extern "C" void kernel_launch(void* const* d_in, const int* in_sizes, int n_in, void* d_out, int out_size, void* d_ws, size_t ws_size, hipStream_t stream) {
    static int grid = 0;
    if (grid == 0) {
        if (n_in != 25 || out_size != ML * DM || ws_size < WS_END) {
            fprintf(stderr, "kernel_launch: built for 25 inputs, out of %d floats, >= %zu bytes of workspace; got n_in %d, out %d, ws %zu; nothing launched\n", ML * DM, (size_t)WS_END, n_in, out_size, ws_size);
            grid = -1; return; }
        int dev = 0, cus = 0, per_cu = 0;
        if (hipGetDevice(&dev) != hipSuccess || hipDeviceGetAttribute(&cus, hipDeviceAttributeMultiprocessorCount, dev) != hipSuccess) { grid = -1; return; }
        if (hipFuncSetAttribute((const void*)fwd, hipFuncAttributeMaxDynamicSharedMemorySize, LDS_BYTES) != hipSuccess) { fprintf(stderr, "kernel_launch: hipFuncSetAttribute failed\n"); grid = -1; return; }
        if (hipOccupancyMaxActiveBlocksPerMultiprocessor(&per_cu, (const void*)fwd, 512, LDS_BYTES) != hipSuccess || per_cu < 1)
            fprintf(stderr, "kernel_launch: note: occupancy query reports %d workgroups per CU\n", per_cu);
        (void)hipGetLastError();
        grid = cus;
    }
    if (grid < 0) return;
    if (hipMemsetAsync((char*)d_ws + WS_CTL, 0, CTL_BYTES, stream) != hipSuccess) return;
    Args a{};
    for (int i = 0; i < 25; ++i) a.in[i] = (const float*)d_in[i];
    a.out = (float*)d_out; a.ws = (unsigned char*)d_ws; a.pad = 0;
    const int NQ = 1 + NLAYER * NPH;
#if MK_SINGLE
    a.q_lo = 0; a.q_hi = NQ; a.single = 1;
    hipLaunchKernelGGL(fwd, dim3(grid), dim3(512), LDS_BYTES, stream, a);
#else
    for (int q = 0; q < NQ; ++q) { a.q_lo = q; a.q_hi = q + 1; a.single = 0;
        hipLaunchKernelGGL(fwd, dim3(grid), dim3(512), LDS_BYTES, stream, a); }
#endif
    const hipError_t le = hipPeekAtLastError();
    if (le != hipSuccess) fprintf(stderr, "kernel_launch: launch failed: %s\n", hipGetErrorName(le));
}
```
